# Optimizing an MI355X kernel written in HIP

```python
import math
import jax, jax.numpy as jnp
from jax import lax
import numpy as np

D_MODEL = 1024
BATCH = 4
SEQ = 8192
DEPTH = 2

CHUNK = 64
Q_BLOCK = 128
HEAD_DIM = 64
A_HEADS = 4
A_VDIM = 2 * HEAD_DIM
B_HEADS = 8
B_LEFT_CHUNKS = 8
REL_CLIP = 128
C_HEADS = 4
C_QK_DIM = 64
C_V_DIM = 128
D_CHUNK = 128
D_GROUPS = 4
D_WIDTH = 512
D_FF = -(-(8 * D_MODEL) // (3 * 256)) * 256

A_W = A_HEADS * A_VDIM
B_W = B_HEADS * HEAD_DIM
C_W = C_HEADS * C_V_DIM
C_QK_W = C_HEADS * C_QK_DIM
IN_EVEN = 3 * A_W + 3 * B_W
IN_ODD = 2 * C_QK_W + 2 * C_W + 2 * D_WIDTH
MIX_EVEN = A_W + B_W
MIX_ODD = C_W + D_WIDTH
N_EVEN = (DEPTH + 1) // 2
N_ODD = DEPTH // 2
ALPHA = (2.0 * DEPTH) ** 0.25
BETA = (8.0 * DEPTH) ** -0.25
LN_EPS = 1e-5
NEG_INF = -1e30

kernel_name = 'hybrid_streaming_diffattn_band_retnet_sgu'


def layer_norm(x, g, b):
    xf = x.astype(jnp.float32)
    mu = jnp.mean(xf, -1, keepdims=True)
    var = jnp.mean(jnp.square(xf - mu), -1, keepdims=True)
    return ((xf - mu) * lax.rsqrt(var + LN_EPS)).astype(x.dtype) * g + b


def rms_norm(x, g):
    xf = x.astype(jnp.float32)
    return (xf * lax.rsqrt(jnp.mean(xf * xf, -1, keepdims=True) + LN_EPS)).astype(x.dtype) * g


def group_norm_heads(x, g, b):
    xf = x.astype(jnp.float32)
    mu = jnp.mean(xf, -1, keepdims=True)
    var = jnp.mean(jnp.square(xf - mu), -1, keepdims=True)
    y = ((xf - mu) * lax.rsqrt(var + LN_EPS)).astype(x.dtype)
    return y.reshape(x.shape[0], x.shape[1], -1) * g + b


def alibi_slopes(n_heads):
    return 2.0 ** (-8.0 * jnp.arange(1, n_heads + 1, dtype=jnp.float32) / n_heads)


def diff_attention(q, k, v, lam, lam_init, subln_g):
    bsz, seq, h, _, d = q.shape
    nb = seq // Q_BLOCK
    kpos = jnp.arange(seq)
    slopes = alibi_slopes(h)
    scale = d ** -0.5

    def one_block(args):
        qb, i = args
        tq = i * Q_BLOCK + jnp.arange(Q_BLOCK)
        s = jnp.einsum('bqhmd,bkhmd->bhmqk', qb, k).astype(jnp.float32) * scale
        dist = jnp.abs(tq[:, None] - kpos[None, :]).astype(jnp.float32)
        allowed = (kpos[None, :] // CHUNK) <= (tq[:, None] // CHUNK)
        bias = jnp.where(allowed[None], -slopes[:, None, None] * dist[None], NEG_INF)
        p = jax.nn.softmax(s + bias[None, :, None], axis=-1)
        w = (p[:, :, 0] - lam * p[:, :, 1]).astype(v.dtype)
        return jnp.einsum('bhqk,bkhe->bqhe', w, v)

    qbs = q.reshape(bsz, nb, Q_BLOCK, h, 2, d).swapaxes(0, 1)
    o = lax.map(one_block, (qbs, jnp.arange(nb)))
    o = o.swapaxes(0, 1).reshape(bsz, seq, h, 2 * d)
    o = rms_norm(o, subln_g) * (1.0 - lam_init)
    return o.reshape(bsz, seq, h * 2 * d)


def band_attention(q, k, v, rel_bias):
    bsz, seq, h, d = q.shape
    nc = seq // CHUNK
    nband = B_LEFT_CHUNKS + 1
    pad = B_LEFT_CHUNKS * CHUNK
    band = nband * CHUNK
    rel = pad + jnp.arange(CHUNK)[:, None] - jnp.arange(band)[None, :]
    bias = rel_bias.astype(jnp.float32)[:, jnp.clip(rel, -REL_CLIP, REL_CLIP) + REL_CLIP]
    key_pos = (jnp.arange(nc)[:, None] - B_LEFT_CHUNKS) * CHUNK + jnp.arange(band)[None, :]
    valid = key_pos >= 0
    scale = d ** -0.5

    def one_seq(args):
        qs, ks, vs = args
        qc = qs.reshape(nc, CHUNK, h, d)
        kp = jnp.pad(ks, ((pad, 0), (0, 0), (0, 0))).reshape(nc + B_LEFT_CHUNKS, CHUNK, h, d)
        vp = jnp.pad(vs, ((pad, 0), (0, 0), (0, 0))).reshape(nc + B_LEFT_CHUNKS, CHUNK, h, d)
        kb = jnp.concatenate([kp[j:j + nc] for j in range(nband)], axis=1)
        vb = jnp.concatenate([vp[j:j + nc] for j in range(nband)], axis=1)
        s = jnp.einsum('cqhd,ckhd->hcqk', qc, kb).astype(jnp.float32) * scale + bias[:, None]
        s = jnp.where(valid[None, :, None, :], s, NEG_INF)
        p = jax.nn.softmax(s, axis=-1).astype(vs.dtype)
        return jnp.einsum('hcqk,ckhd->cqhd', p, vb).reshape(seq, h * d)

    return lax.map(one_seq, (q, k, v))


def retention(q, k, v):
    bsz, seq, h, dk = q.shape
    dv = v.shape[-1]
    nc = seq // CHUNK
    log_gamma = jnp.log(1.0 - 2.0 ** (-5.0 - jnp.arange(h, dtype=jnp.float32)))
    idx = jnp.arange(CHUNK, dtype=jnp.float32)
    diff = idx[:, None] - idx[None, :]
    decay_mask = jnp.where(diff >= 0, jnp.exp(log_gamma[:, None, None] * jnp.maximum(diff, 0.0)), 0.0)
    q_decay = jnp.exp(log_gamma[:, None] * (idx + 1.0))
    k_decay = jnp.exp(log_gamma[:, None] * (CHUNK - 1.0 - idx))
    chunk_decay = jnp.exp(log_gamma * CHUNK)

    def to_chunks(t):
        return t.astype(jnp.float32).reshape(bsz, nc, CHUNK, h, t.shape[-1]).transpose(1, 0, 3, 2, 4)

    qc, kc, vc = to_chunks(q), to_chunks(k * dk ** -0.5), to_chunks(v)
    scores = jnp.einsum('cbhld,cbhmd->cbhlm', qc, kc) * decay_mask
    inner = jnp.einsum('cbhlm,cbhme->cbhle', scores, vc)
    kv = jnp.einsum('cbhmd,hm,cbhme->cbhde', kc, k_decay, vc)

    def step(state, kv_c):
        return chunk_decay[None, :, None, None] * state + kv_c, state

    _, prev = lax.scan(step, jnp.zeros((bsz, h, dk, dv), jnp.float32), kv)
    cross = jnp.einsum('cbhld,cbhde->cbhle', qc, prev) * q_decay[:, :, None]
    o = (inner + cross).transpose(1, 0, 3, 2, 4).reshape(bsz, seq, h, dv)
    return o.astype(q.dtype)


def spatial_gating(z, w_s, b_s, ln_g, ln_b):
    bsz, seq, _ = z.shape
    u, v = jnp.split(z, 2, axis=-1)
    v = layer_norm(v, ln_g, ln_b)
    gw = D_WIDTH // D_GROUPS
    vc = v.reshape(bsz, seq // D_CHUNK, D_CHUNK, D_GROUPS, gw)
    causal = jnp.tril(jnp.ones((D_CHUNK, D_CHUNK), dtype=bool))
    ws = jnp.where(causal[None], w_s, 0)
    mixed = jnp.einsum('gts,bnsgc->bntgc', ws, vc) + b_s.T[:, :, None]
    return u * mixed.reshape(bsz, seq, D_WIDTH)


def swiglu(x, w_gate, w_up, w_down):
    return (jax.nn.silu(x @ w_gate) * (x @ w_up)) @ w_down


def setup_inputs(seed: int = 0) -> dict:
    key = jax.random.key(seed)
    ks = jax.random.split(key, 26)
    f32 = jnp.float32

    def nrm(k, shape, std):
        return jax.random.normal(k, shape, f32) * std

    ne, no = N_EVEN, N_ODD
    return {
        'x': nrm(ks[0], (BATCH, SEQ, D_MODEL), 1.0),
        'w_in_even': nrm(ks[1], (ne, D_MODEL, IN_EVEN), D_MODEL ** -0.5),
        'lam_q1': nrm(ks[2], (ne, HEAD_DIM), 0.1),
        'lam_k1': nrm(ks[3], (ne, HEAD_DIM), 0.1),
        'lam_q2': nrm(ks[4], (ne, HEAD_DIM), 0.1),
        'lam_k2': nrm(ks[5], (ne, HEAD_DIM), 0.1),
        'diff_subln_g': 1.0 + nrm(ks[6], (ne, A_VDIM), 0.02),
        'rel_bias': nrm(ks[7], (ne, B_HEADS, 2 * REL_CLIP + 1), 0.1),
        'w_out_even': nrm(ks[8], (ne, MIX_EVEN, D_MODEL), BETA * MIX_EVEN ** -0.5),
        'w_in_odd': nrm(ks[9], (no, D_MODEL, IN_ODD), D_MODEL ** -0.5),
        'ret_gn_g': 1.0 + nrm(ks[10], (no, C_W), 0.02),
        'ret_gn_b': nrm(ks[11], (no, C_W), 0.02),
        'sgu_ln_g': 1.0 + nrm(ks[12], (no, D_WIDTH), 0.02),
        'sgu_ln_b': nrm(ks[13], (no, D_WIDTH), 0.02),
        'sgu_w': nrm(ks[14], (no, D_GROUPS, D_CHUNK, D_CHUNK), D_CHUNK ** -0.5),
        'sgu_b': 1.0 + nrm(ks[15], (no, D_GROUPS, D_CHUNK), 0.02),
        'w_out_odd': nrm(ks[16], (no, MIX_ODD, D_MODEL), BETA * MIX_ODD ** -0.5),
        'ln_mix_g': 1.0 + nrm(ks[17], (DEPTH, D_MODEL), 0.02),
        'ln_mix_b': nrm(ks[18], (DEPTH, D_MODEL), 0.02),
        'ffn_w_gate': nrm(ks[19], (DEPTH, D_MODEL, D_FF), D_MODEL ** -0.5),
        'ffn_w_up': nrm(ks[20], (DEPTH, D_MODEL, D_FF), D_MODEL ** -0.5),
        'ffn_w_down': nrm(ks[21], (DEPTH, D_FF, D_MODEL), BETA * D_FF ** -0.5),
        'ln_ffn_g': 1.0 + nrm(ks[22], (DEPTH, D_MODEL), 0.02),
        'ln_ffn_b': nrm(ks[23], (DEPTH, D_MODEL), 0.02),
    }


def reference(x, w_in_even, lam_q1, lam_k1, lam_q2, lam_k2, diff_subln_g, rel_bias, w_out_even,
              w_in_odd, ret_gn_g, ret_gn_b, sgu_ln_g, sgu_ln_b, sgu_w, sgu_b, w_out_odd,
              ln_mix_g, ln_mix_b, ffn_w_gate, ffn_w_up, ffn_w_down, ln_ffn_g, ln_ffn_b):
    bsz, seq, _ = x.shape
    for l in range(DEPTH):
        j = l // 2
        if l % 2 == 0:
            hproj = x @ w_in_even[j]
            qa, ka, va, qb, kb, vb = jnp.split(
                hproj, [A_W, 2 * A_W, 3 * A_W, 3 * A_W + B_W, 3 * A_W + 2 * B_W], axis=-1)
            lam_init = 0.8 - 0.6 * math.exp(-0.3 * l)
            lam = (jnp.exp(jnp.sum(lam_q1[j].astype(jnp.float32) * lam_k1[j].astype(jnp.float32)))
                   - jnp.exp(jnp.sum(lam_q2[j].astype(jnp.float32) * lam_k2[j].astype(jnp.float32)))
                   + lam_init)
            o_a = diff_attention(qa.reshape(bsz, seq, A_HEADS, 2, HEAD_DIM),
                                 ka.reshape(bsz, seq, A_HEADS, 2, HEAD_DIM),
                                 va.reshape(bsz, seq, A_HEADS, A_VDIM),
                                 lam, lam_init, diff_subln_g[j])
            o_b = band_attention(qb.reshape(bsz, seq, B_HEADS, HEAD_DIM),
                                 kb.reshape(bsz, seq, B_HEADS, HEAD_DIM),
                                 vb.reshape(bsz, seq, B_HEADS, HEAD_DIM),
                                 rel_bias[j])
            mix = jnp.concatenate([o_a, o_b], axis=-1) @ w_out_even[j]
        else:
            hproj = x @ w_in_odd[j]
            qc, kc, vc, gc, zd = jnp.split(
                hproj, [C_QK_W, 2 * C_QK_W, 2 * C_QK_W + C_W, 2 * C_QK_W + 2 * C_W], axis=-1)
            o_c = retention(qc.reshape(bsz, seq, C_HEADS, C_QK_DIM),
                            kc.reshape(bsz, seq, C_HEADS, C_QK_DIM),
                            vc.reshape(bsz, seq, C_HEADS, C_V_DIM))
            o_c = group_norm_heads(o_c, ret_gn_g[j], ret_gn_b[j]) * jax.nn.silu(gc)
            o_d = spatial_gating(jax.nn.gelu(zd), sgu_w[j], sgu_b[j], sgu_ln_g[j], sgu_ln_b[j])
            mix = jnp.concatenate([o_c, o_d], axis=-1) @ w_out_odd[j]
        x = layer_norm(ALPHA * x + mix, ln_mix_g[l], ln_mix_b[l])
        x = layer_norm(ALPHA * x + swiglu(x, ffn_w_gate[l], ffn_w_up[l], ffn_w_down[l]),
                       ln_ffn_g[l], ln_ffn_b[l])
    return x
```

```cpp
#include <hip/hip_runtime.h>
#include <cstdio>
#include <cstdint>

typedef unsigned short bf16_t;
#define DEV __device__ __forceinline__

constexpr int BATCH = 4, SEQ = 8192, DM = 1024, MTOK = BATCH * SEQ;
constexpr int IN_EVEN = 3072, IN_ODD = 2560, DFF = 2816;
constexpr float ALPHA = 1.4142135623730951f, LN_EPS = 1e-5f;

constexpr size_t MiB = 1u << 20;
constexpr size_t WS_CTL = 0;
constexpr size_t WS_WINE = 1 * MiB;
constexpr size_t WS_WOUTE = 7 * MiB;
constexpr size_t WS_WINO = 9 * MiB;
constexpr size_t WS_WOUTO = 14 * MiB;
constexpr size_t WS_WGU0 = 16 * MiB;
constexpr size_t WS_WDN0 = 27 * MiB;
constexpr size_t WS_WGU1 = 33 * MiB;
constexpr size_t WS_WDN1 = 44 * MiB;
constexpr size_t WS_XB = 52 * MiB;
constexpr size_t WS_HP = 116 * MiB;
constexpr size_t WS_MC = 308 * MiB;
constexpr size_t WS_Y = 372 * MiB;
constexpr size_t WS_END = 500 * MiB;

DEV float bf2f(bf16_t v) { return __uint_as_float(((unsigned)v) << 16); }
DEV bf16_t f2bf(float f) { unsigned u = __float_as_uint(f); return (bf16_t)((u + 0x7fffu + ((u >> 16) & 1u)) >> 16); }
DEV float gelu_tanh(float x) { const float u = 0.7978845608028654f * (x + 0.044715f * x * x * x); return x / (1.f + __expf(-2.f * u)); }
DEV float silu(float x) { return x / (1.f + __expf(-x)); }

__global__ void __launch_bounds__(256) nv_wt(const float* W, int K, int N, bf16_t* WT, int mode) {
    __shared__ float t[32][33];
    const int n0 = blockIdx.x * 32, k0 = blockIdx.y * 32, tx = threadIdx.x & 31, ty = threadIdx.x >> 5;
    for (int i = ty; i < 32; i += 8) t[i][tx] = W[(size_t)(k0 + i) * N + n0 + tx];
    __syncthreads();
    for (int i = ty; i < 32; i += 8) { const int n = n0 + i; const int r = mode == 0 ? n : (256 * (n >> 7) + (n & 127) + (mode == 2 ? 128 : 0));
        WT[(size_t)r * K + k0 + tx] = f2bf(t[tx][i]); }
}
__global__ void __launch_bounds__(256) nv_cvt(const float* x, bf16_t* o, size_t n) {
    size_t i = (size_t)blockIdx.x * 256 + threadIdx.x; const size_t st = (size_t)gridDim.x * 256;
    for (; i < n; i += st) o[i] = f2bf(x[i]);
}
struct GE { int mode; bf16_t* outb; float* outf; const float* resid; int ldc; int gelu_from; };
__global__ void __launch_bounds__(256) nv_gemm(const bf16_t* A, const bf16_t* Bt, int K, GE e) {
    __shared__ float As[64][33], Bs[64][33], Bs2[64][33];
    const int tid = threadIdx.x, tx = tid & 15, ty = tid >> 4, row0 = blockIdx.y * 64, col0 = blockIdx.x * 64;
    const bool dual = e.mode == 1;
    float acc[4][4], acc2[4][4];
#pragma unroll
    for (int i = 0; i < 4; ++i)
#pragma unroll
        for (int j = 0; j < 4; ++j) { acc[i][j] = 0.f; acc2[i][j] = 0.f; }
    for (int k0 = 0; k0 < K; k0 += 32) {
        for (int i = tid; i < 2048; i += 256) { const int r = i >> 5, c = i & 31;
            As[r][c] = bf2f(A[(size_t)(row0 + r) * K + k0 + c]);
            const int col = col0 + r, br = dual ? (256 * (col >> 7) + (col & 127)) : col;
            Bs[r][c] = bf2f(Bt[(size_t)br * K + k0 + c]);
            if (dual) Bs2[r][c] = bf2f(Bt[(size_t)(br + 128) * K + k0 + c]); }
        __syncthreads();
#pragma unroll 4
        for (int kk = 0; kk < 32; ++kk) {
            float a[4], b[4], b2[4];
#pragma unroll
            for (int i = 0; i < 4; ++i) { a[i] = As[ty * 4 + i][kk]; b[i] = Bs[tx * 4 + i][kk]; b2[i] = dual ? Bs2[tx * 4 + i][kk] : 0.f; }
#pragma unroll
            for (int i = 0; i < 4; ++i)
#pragma unroll
                for (int j = 0; j < 4; ++j) { acc[i][j] += a[i] * b[j]; acc2[i][j] += a[i] * b2[j]; }
        }
        __syncthreads();
    }
#pragma unroll
    for (int i = 0; i < 4; ++i)
#pragma unroll
        for (int j = 0; j < 4; ++j) {
            const int r = row0 + ty * 4 + i, c = col0 + tx * 4 + j; const size_t o = (size_t)r * e.ldc + c;
            if (e.mode == 0) { float v = acc[i][j]; if (c >= e.gelu_from) v = gelu_tanh(v); e.outb[o] = f2bf(v); }
            else if (e.mode == 1) { e.outb[o] = f2bf(silu(acc[i][j]) * acc2[i][j]); }
            else { e.outf[o] = ALPHA * e.resid[o] + acc[i][j]; }
        }
}
__global__ void __launch_bounds__(256) nv_ln(const float* Y, const float* g, const float* b, float* XF, bf16_t* XB) {
    const int row = blockIdx.x * 4 + (threadIdx.x >> 6), lane = threadIdx.x & 63;
    const float* y = Y + (size_t)row * DM; float v[16]; float s = 0.f;
#pragma unroll
    for (int j = 0; j < 16; ++j) { v[j] = y[lane + 64 * j]; s += v[j]; }
#pragma unroll
    for (int o = 1; o < 64; o <<= 1) s += __shfl_xor(s, o);
    const float mean = s * (1.f / DM); float q = 0.f;
#pragma unroll
    for (int j = 0; j < 16; ++j) { v[j] -= mean; q += v[j] * v[j]; }
#pragma unroll
    for (int o = 1; o < 64; o <<= 1) q += __shfl_xor(q, o);
    const float rstd = rsqrtf(q * (1.f / DM) + LN_EPS);
#pragma unroll
    for (int j = 0; j < 16; ++j) { const int c = lane + 64 * j; const float o = v[j] * rstd * g[c] + b[c]; XF[(size_t)row * DM + c] = o; XB[(size_t)row * DM + c] = f2bf(o); }
}
template <int MODE, int DVS> __global__ void __launch_bounds__(256) nv_attn(const bf16_t* HP, float* OT, bf16_t* MC, const float* relb) {
    const int tid = threadIdx.x, qi = tid & 63, es = tid >> 6, c = blockIdx.x;
    int b, h, m = 0;
    if (MODE == 0) { m = blockIdx.y & 1; h = (blockIdx.y >> 1) & 3; b = blockIdx.y >> 3; } else { h = blockIdx.y & 7; b = blockIdx.y >> 3; }
    const int tq = c * 64 + qi;
    const bf16_t* base = HP + (size_t)b * SEQ * IN_EVEN;
    int qcol, kcol, vcol;
    if (MODE == 0) { qcol = h * 128 + m * 64; kcol = 512 + h * 128 + m * 64; vcol = 1024 + h * 128 + es * DVS; }
    else { qcol = 1536 + h * 64; kcol = 2048 + h * 64; vcol = 2560 + h * 64 + es * DVS; }
    float q[64];
#pragma unroll
    for (int d = 0; d < 64; ++d) q[d] = bf2f(base[(size_t)tq * IN_EVEN + qcol + d]) * 0.125f;
    float o[DVS];
#pragma unroll
    for (int e = 0; e < DVS; ++e) o[e] = 0.f;
    float mx = -1e30f, l = 0.f;
    const int k_lo = MODE == 0 ? 0 : ((c - 8) * 64 > 0 ? (c - 8) * 64 : 0), k_hi = (c + 1) * 64;
    const float slope = exp2f(-2.0f * (float)(h + 1));
    for (int key = k_lo; key < k_hi; ++key) {
        const bf16_t* kr = base + (size_t)key * IN_EVEN + kcol;
        float s = 0.f;
#pragma unroll
        for (int d = 0; d < 64; ++d) s += q[d] * bf2f(kr[d]);
        if (MODE == 0) s -= slope * fabsf((float)(tq - key));
        else { int rel = tq - key; rel = rel < -128 ? -128 : (rel > 128 ? 128 : rel); s += relb[h * 257 + rel + 128]; }
        if (s > mx) { const float f = expf(mx - s); l *= f;
#pragma unroll
            for (int e = 0; e < DVS; ++e) o[e] *= f;
            mx = s; }
        const float p = expf(s - mx); l += p;
        const bf16_t* vr = base + (size_t)key * IN_EVEN + vcol;
#pragma unroll
        for (int e = 0; e < DVS; ++e) o[e] += p * bf2f(vr[e]);
    }
    const float inv = 1.f / l; const size_t tok = (size_t)b * SEQ + tq;
#pragma unroll
    for (int e = 0; e < DVS; ++e) {
        if (MODE == 0) OT[((size_t)m * MTOK + tok) * 512 + h * 128 + es * DVS + e] = o[e] * inv;
        else MC[tok * DM + 512 + h * 64 + es * DVS + e] = f2bf(o[e] * inv);
    }
}
__global__ void __launch_bounds__(256) nv_diff_combine(const float* OT, const float* lq1, const float* lk1, const float* lq2, const float* lk2, const float* g, bf16_t* MC) {
    const int i = blockIdx.x * 256 + threadIdx.x; const int tok = i >> 2, h = i & 3;
    float s1 = 0.f, s2 = 0.f;
    for (int d = 0; d < 64; ++d) { s1 += lq1[d] * lk1[d]; s2 += lq2[d] * lk2[d]; }
    const float lam = expf(s1) - expf(s2) + 0.2f;
    const float* o1 = OT + (size_t)tok * 512 + h * 128; const float* o2 = o1 + (size_t)MTOK * 512;
    float ss = 0.f;
    for (int e = 0; e < 128; ++e) { const float d = o1[e] - lam * o2[e]; ss += d * d; }
    const float r = rsqrtf(ss * (1.f / 128.f) + LN_EPS) * 0.8f;
    for (int e = 0; e < 128; ++e) { const float d = o1[e] - lam * o2[e]; MC[(size_t)tok * DM + h * 128 + e] = f2bf(d * r * g[e]); }
}
__global__ void __launch_bounds__(128) nv_ret(const bf16_t* HP, float* OT) {
    const int b = blockIdx.x >> 2, h = blockIdx.x & 3, e = threadIdx.x;
    const float gamma = 1.f - exp2f(-5.f - (float)h);
    float S[64];
#pragma unroll
    for (int d = 0; d < 64; ++d) S[d] = 0.f;
    for (int t = 0; t < SEQ; ++t) {
        const bf16_t* row = HP + ((size_t)b * SEQ + t) * IN_ODD;
        const float v = bf2f(row[512 + h * 128 + e]); float o = 0.f;
#pragma unroll
        for (int d = 0; d < 64; ++d) { const float kd = bf2f(row[256 + h * 64 + d]) * 0.125f; S[d] = gamma * S[d] + kd * v; o += bf2f(row[h * 64 + d]) * S[d]; }
        OT[((size_t)b * SEQ + t) * 512 + h * 128 + e] = o;
    }
}
__global__ void __launch_bounds__(256) nv_gn_gate(const float* OT, const bf16_t* HP, const float* g, const float* bb, bf16_t* MC) {
    const int i = blockIdx.x * 256 + threadIdx.x; const int tok = i >> 2, h = i & 3;
    const float* o = OT + (size_t)tok * 512 + h * 128; float s = 0.f;
    for (int e = 0; e < 128; ++e) s += o[e];
    const float mu = s * (1.f / 128.f); float q = 0.f;
    for (int e = 0; e < 128; ++e) { const float d = o[e] - mu; q += d * d; }
    const float r = rsqrtf(q * (1.f / 128.f) + LN_EPS);
    for (int e = 0; e < 128; ++e) { const int c = h * 128 + e; const float y = (o[e] - mu) * r * g[c] + bb[c]; const float gt = bf2f(HP[(size_t)tok * IN_ODD + 1024 + c]);
        MC[(size_t)tok * DM + c] = f2bf(y * silu(gt)); }
}
__global__ void __launch_bounds__(256) nv_sgu_ln(const bf16_t* HP, const float* g, const float* bb, float* VN) {
    const int tok = blockIdx.x * 256 + threadIdx.x; const bf16_t* v = HP + (size_t)tok * IN_ODD + 2048; float s = 0.f;
    for (int c = 0; c < 512; ++c) s += bf2f(v[c]);
    const float mu = s * (1.f / 512.f); float q = 0.f;
    for (int c = 0; c < 512; ++c) { const float d = bf2f(v[c]) - mu; q += d * d; }
    const float r = rsqrtf(q * (1.f / 512.f) + LN_EPS);
    for (int c = 0; c < 512; ++c) VN[(size_t)tok * 512 + c] = (bf2f(v[c]) - mu) * r * g[c] + bb[c];
}
__global__ void __launch_bounds__(256) nv_sgu_mix(const float* VN, const bf16_t* HP, const float* W, const float* bs, bf16_t* MC) {
    const int chunk = blockIdx.x, g = blockIdx.y, c = threadIdx.x & 127, th = threadIdx.x >> 7;
    for (int t = th * 64; t < th * 64 + 64; ++t) {
        float acc = 0.f; const float* w = W + ((size_t)g * 128 + t) * 128;
        for (int s = 0; s <= t; ++s) acc += w[s] * VN[((size_t)chunk * 128 + s) * 512 + g * 128 + c];
        const size_t tok = (size_t)chunk * 128 + t; const float u = bf2f(HP[tok * IN_ODD + 1536 + g * 128 + c]);
        MC[tok * DM + 512 + g * 128 + c] = f2bf(u * (acc + bs[g * 128 + t]));
    }
}

extern "C" void kernel_launch(void* const* d_in, const int* in_sizes, int n_in, void* d_out, int out_size, void* d_ws, size_t ws_size, hipStream_t stream) {
    if (n_in != 24 || ws_size < WS_END || out_size != MTOK * DM) { fprintf(stderr, "kernel_launch: unexpected shapes (n_in %d ws %zu out %d)\n", n_in, ws_size, out_size); return; }
    const float* const* in = (const float* const*)d_in;
    unsigned char* ws = (unsigned char*)d_ws;
    bf16_t* WINE = (bf16_t*)(ws + WS_WINE); bf16_t* WOUTE = (bf16_t*)(ws + WS_WOUTE); bf16_t* WINO = (bf16_t*)(ws + WS_WINO); bf16_t* WOUTO = (bf16_t*)(ws + WS_WOUTO);
    bf16_t* WGU[2] = {(bf16_t*)(ws + WS_WGU0), (bf16_t*)(ws + WS_WGU1)}; bf16_t* WDN[2] = {(bf16_t*)(ws + WS_WDN0), (bf16_t*)(ws + WS_WDN1)};
    bf16_t* XB = (bf16_t*)(ws + WS_XB); bf16_t* HP = (bf16_t*)(ws + WS_HP); bf16_t* HH = HP; bf16_t* MC = (bf16_t*)(ws + WS_MC); float* Y = (float*)(ws + WS_Y);
    float* XF = (float*)d_out;
    nv_wt<<<dim3(IN_EVEN / 32, DM / 32), 256, 0, stream>>>(in[1], DM, IN_EVEN, WINE, 0);
    nv_wt<<<dim3(DM / 32, DM / 32), 256, 0, stream>>>(in[8], DM, DM, WOUTE, 0);
    nv_wt<<<dim3(IN_ODD / 32, DM / 32), 256, 0, stream>>>(in[9], DM, IN_ODD, WINO, 0);
    nv_wt<<<dim3(DM / 32, DM / 32), 256, 0, stream>>>(in[16], DM, DM, WOUTO, 0);
    for (int l = 0; l < 2; ++l) {
        nv_wt<<<dim3(DFF / 32, DM / 32), 256, 0, stream>>>(in[19] + (size_t)l * DM * DFF, DM, DFF, WGU[l], 1);
        nv_wt<<<dim3(DFF / 32, DM / 32), 256, 0, stream>>>(in[20] + (size_t)l * DM * DFF, DM, DFF, WGU[l], 2);
        nv_wt<<<dim3(DM / 32, DFF / 32), 256, 0, stream>>>(in[21] + (size_t)l * DM * DFF, DFF, DM, WDN[l], 0);
    }
    nv_cvt<<<4096, 256, 0, stream>>>(in[0], XB, (size_t)MTOK * DM);
    for (int l = 0; l < 2; ++l) {
        const float* xres = l == 0 ? in[0] : XF;
        if (l == 0) {
            nv_gemm<<<dim3(IN_EVEN / 64, MTOK / 64), 256, 0, stream>>>(XB, WINE, DM, GE{0, HP, nullptr, nullptr, IN_EVEN, 1 << 30});
            nv_attn<0, 32><<<dim3(SEQ / 64, BATCH * 4 * 2), 256, 0, stream>>>(HP, Y, MC, nullptr);
            nv_diff_combine<<<MTOK * 4 / 256, 256, 0, stream>>>(Y, in[2], in[3], in[4], in[5], in[6], MC);
            nv_attn<1, 16><<<dim3(SEQ / 64, BATCH * 8), 256, 0, stream>>>(HP, nullptr, MC, in[7]);
            nv_gemm<<<dim3(DM / 64, MTOK / 64), 256, 0, stream>>>(MC, WOUTE, DM, GE{2, nullptr, Y, xres, DM, 0});
        } else {
            nv_gemm<<<dim3(IN_ODD / 64, MTOK / 64), 256, 0, stream>>>(XB, WINO, DM, GE{0, HP, nullptr, nullptr, IN_ODD, 1536});
            float* OT = Y; float* VN = Y + (size_t)MTOK * 512;
            nv_ret<<<BATCH * 4, 128, 0, stream>>>(HP, OT);
            nv_gn_gate<<<MTOK * 4 / 256, 256, 0, stream>>>(OT, HP, in[10], in[11], MC);
            nv_sgu_ln<<<MTOK / 256, 256, 0, stream>>>(HP, in[12], in[13], VN);
            nv_sgu_mix<<<dim3(MTOK / 128, 4), 256, 0, stream>>>(VN, HP, in[14], in[15], MC);
            nv_gemm<<<dim3(DM / 64, MTOK / 64), 256, 0, stream>>>(MC, WOUTO, DM, GE{2, nullptr, Y, xres, DM, 0});
        }
        nv_ln<<<MTOK / 4, 256, 0, stream>>>(Y, in[17] + l * DM, in[18] + l * DM, XF, XB);
        nv_gemm<<<dim3(DFF / 64, MTOK / 64), 256, 0, stream>>>(XB, WGU[l], DM, GE{1, HH, nullptr, nullptr, DFF, 0});
        nv_gemm<<<dim3(DM / 64, MTOK / 64), 256, 0, stream>>>(HH, WDN[l], DFF, GE{2, nullptr, Y, XF, DM, 0});
        nv_ln<<<MTOK / 4, 256, 0, stream>>>(Y, in[22] + l * DM, in[23] + l * DM, XF, XB);
    }
}
```

```cpp
#include <hip/hip_runtime.h>
#include <hip/hip_cooperative_groups.h>
namespace cg = cooperative_groups;
#include <cstdio>
#include <cstdint>

typedef unsigned short bf16_t;
#define DEV __device__ __forceinline__

constexpr int BATCH = 4, SEQ = 8192, DM = 1024, MTOK = BATCH * SEQ;
constexpr int IN_EVEN = 3072, IN_ODD = 2560, DFF = 2816;
constexpr float ALPHA = 1.4142135623730951f, LN_EPS = 1e-5f;

constexpr size_t MiB = 1u << 20;
constexpr size_t WS_CTL = 0;
constexpr size_t WS_WINE = 1 * MiB;
constexpr size_t WS_WOUTE = 7 * MiB;
constexpr size_t WS_WINO = 9 * MiB;
constexpr size_t WS_WOUTO = 14 * MiB;
constexpr size_t WS_WGU0 = 16 * MiB;
constexpr size_t WS_WDN0 = 27 * MiB;
constexpr size_t WS_WGU1 = 33 * MiB;
constexpr size_t WS_WDN1 = 44 * MiB;
constexpr size_t WS_SGUW = 50 * MiB;
constexpr size_t WS_XB = 52 * MiB;
constexpr size_t WS_HP = 116 * MiB;
constexpr size_t WS_MC = 308 * MiB;
constexpr size_t WS_Y = 372 * MiB;
constexpr size_t WS_END = 500 * MiB;

DEV float bf2f(bf16_t v) { return __uint_as_float(((unsigned)v) << 16); }
DEV bf16_t f2bf(float f) { unsigned u = __float_as_uint(f); return (bf16_t)((u + 0x7fffu + ((u >> 16) & 1u)) >> 16); }
DEV float gelu_tanh(float x) { const float u = 0.7978845608028654f * (x + 0.044715f * x * x * x); return x / (1.f + __expf(-2.f * u)); }
DEV float silu(float x) { return x / (1.f + __expf(-x)); }

__global__ void __launch_bounds__(256) nv_wt(const float* W, int K, int N, bf16_t* WT, int mode) {
    __shared__ float t[32][33];
    const int n0 = blockIdx.x * 32, k0 = blockIdx.y * 32, tx = threadIdx.x & 31, ty = threadIdx.x >> 5;
    for (int i = ty; i < 32; i += 8) t[i][tx] = W[(size_t)(k0 + i) * N + n0 + tx];
    __syncthreads();
    for (int i = ty; i < 32; i += 8) { const int n = n0 + i; const int r = mode == 0 ? n : (256 * (n >> 7) + (n & 127) + (mode == 2 ? 128 : 0));
        WT[(size_t)r * K + k0 + tx] = f2bf(t[tx][i]); }
}
__global__ void __launch_bounds__(256) nv_cvt(const float* x, bf16_t* o, size_t n) {
    size_t i = (size_t)blockIdx.x * 256 + threadIdx.x; const size_t st = (size_t)gridDim.x * 256;
    for (; i < n; i += st) o[i] = f2bf(x[i]);
}
struct GE { int mode; bf16_t* outb; float* outf; const float* resid; int ldc; int gelu_from; };
__global__ void __launch_bounds__(256) nv_gemm(const bf16_t* A, const bf16_t* Bt, int K, GE e) {
    __shared__ float As[64][33], Bs[64][33], Bs2[64][33];
    const int tid = threadIdx.x, tx = tid & 15, ty = tid >> 4, row0 = blockIdx.y * 64, col0 = blockIdx.x * 64;
    const bool dual = e.mode == 1;
    float acc[4][4], acc2[4][4];
#pragma unroll
    for (int i = 0; i < 4; ++i)
#pragma unroll
        for (int j = 0; j < 4; ++j) { acc[i][j] = 0.f; acc2[i][j] = 0.f; }
    for (int k0 = 0; k0 < K; k0 += 32) {
        for (int i = tid; i < 2048; i += 256) { const int r = i >> 5, c = i & 31;
            As[r][c] = bf2f(A[(size_t)(row0 + r) * K + k0 + c]);
            const int col = col0 + r, br = dual ? (256 * (col >> 7) + (col & 127)) : col;
            Bs[r][c] = bf2f(Bt[(size_t)br * K + k0 + c]);
            if (dual) Bs2[r][c] = bf2f(Bt[(size_t)(br + 128) * K + k0 + c]); }
        __syncthreads();
#pragma unroll 4
        for (int kk = 0; kk < 32; ++kk) {
            float a[4], b[4], b2[4];
#pragma unroll
            for (int i = 0; i < 4; ++i) { a[i] = As[ty * 4 + i][kk]; b[i] = Bs[tx * 4 + i][kk]; b2[i] = dual ? Bs2[tx * 4 + i][kk] : 0.f; }
#pragma unroll
            for (int i = 0; i < 4; ++i)
#pragma unroll
                for (int j = 0; j < 4; ++j) { acc[i][j] += a[i] * b[j]; acc2[i][j] += a[i] * b2[j]; }
        }
        __syncthreads();
    }
#pragma unroll
    for (int i = 0; i < 4; ++i)
#pragma unroll
        for (int j = 0; j < 4; ++j) {
            const int r = row0 + ty * 4 + i, c = col0 + tx * 4 + j; const size_t o = (size_t)r * e.ldc + c;
            if (e.mode == 0) { float v = acc[i][j]; if (c >= e.gelu_from) v = gelu_tanh(v); e.outb[o] = f2bf(v); }
            else if (e.mode == 1) { e.outb[o] = f2bf(silu(acc[i][j]) * acc2[i][j]); }
            else { e.outf[o] = ALPHA * e.resid[o] + acc[i][j]; }
        }
}
__global__ void __launch_bounds__(256) nv_ln(const float* Y, const float* g, const float* b, float* XF, bf16_t* XB) {
    const int row = blockIdx.x * 4 + (threadIdx.x >> 6), lane = threadIdx.x & 63;
    const float* y = Y + (size_t)row * DM; float v[16]; float s = 0.f;
#pragma unroll
    for (int j = 0; j < 16; ++j) { v[j] = y[lane + 64 * j]; s += v[j]; }
#pragma unroll
    for (int o = 1; o < 64; o <<= 1) s += __shfl_xor(s, o);
    const float mean = s * (1.f / DM); float q = 0.f;
#pragma unroll
    for (int j = 0; j < 16; ++j) { v[j] -= mean; q += v[j] * v[j]; }
#pragma unroll
    for (int o = 1; o < 64; o <<= 1) q += __shfl_xor(q, o);
    const float rstd = rsqrtf(q * (1.f / DM) + LN_EPS);
#pragma unroll
    for (int j = 0; j < 16; ++j) { const int c = lane + 64 * j; const float o = v[j] * rstd * g[c] + b[c]; XF[(size_t)row * DM + c] = o; XB[(size_t)row * DM + c] = f2bf(o); }
}
template <int MODE, int DVS> __global__ void __launch_bounds__(256) nv_attn(const bf16_t* HP, float* OT, bf16_t* MC, const float* relb) {
    const int tid = threadIdx.x, qi = tid & 63, es = tid >> 6, c = blockIdx.x;
    int b, h, m = 0;
    if (MODE == 0) { m = blockIdx.y & 1; h = (blockIdx.y >> 1) & 3; b = blockIdx.y >> 3; } else { h = blockIdx.y & 7; b = blockIdx.y >> 3; }
    const int tq = c * 64 + qi;
    const bf16_t* base = HP + (size_t)b * SEQ * IN_EVEN;
    int qcol, kcol, vcol;
    if (MODE == 0) { qcol = h * 128 + m * 64; kcol = 512 + h * 128 + m * 64; vcol = 1024 + h * 128 + es * DVS; }
    else { qcol = 1536 + h * 64; kcol = 2048 + h * 64; vcol = 2560 + h * 64 + es * DVS; }
    float q[64];
#pragma unroll
    for (int d = 0; d < 64; ++d) q[d] = bf2f(base[(size_t)tq * IN_EVEN + qcol + d]) * 0.125f;
    float o[DVS];
#pragma unroll
    for (int e = 0; e < DVS; ++e) o[e] = 0.f;
    float mx = -1e30f, l = 0.f;
    const int k_lo = MODE == 0 ? 0 : ((c - 8) * 64 > 0 ? (c - 8) * 64 : 0), k_hi = (c + 1) * 64;
    const float slope = exp2f(-2.0f * (float)(h + 1));
    for (int key = k_lo; key < k_hi; ++key) {
        const bf16_t* kr = base + (size_t)key * IN_EVEN + kcol;
        float s = 0.f;
#pragma unroll
        for (int d = 0; d < 64; ++d) s += q[d] * bf2f(kr[d]);
        if (MODE == 0) s -= slope * fabsf((float)(tq - key));
        else { int rel = tq - key; rel = rel < -128 ? -128 : (rel > 128 ? 128 : rel); s += relb[h * 257 + rel + 128]; }
        if (s > mx) { const float f = expf(mx - s); l *= f;
#pragma unroll
            for (int e = 0; e < DVS; ++e) o[e] *= f;
            mx = s; }
        const float p = expf(s - mx); l += p;
        const bf16_t* vr = base + (size_t)key * IN_EVEN + vcol;
#pragma unroll
        for (int e = 0; e < DVS; ++e) o[e] += p * bf2f(vr[e]);
    }
    const float inv = 1.f / l; const size_t tok = (size_t)b * SEQ + tq;
#pragma unroll
    for (int e = 0; e < DVS; ++e) {
        if (MODE == 0) OT[((size_t)m * MTOK + tok) * 512 + h * 128 + es * DVS + e] = o[e] * inv;
        else MC[tok * DM + 512 + h * 64 + es * DVS + e] = f2bf(o[e] * inv);
    }
}
__global__ void __launch_bounds__(256) nv_diff_combine(const float* OT, const float* lq1, const float* lk1, const float* lq2, const float* lk2, const float* g, bf16_t* MC) {
    const int i = blockIdx.x * 256 + threadIdx.x; const int tok = i >> 2, h = i & 3;
    float s1 = 0.f, s2 = 0.f;
    for (int d = 0; d < 64; ++d) { s1 += lq1[d] * lk1[d]; s2 += lq2[d] * lk2[d]; }
    const float lam = expf(s1) - expf(s2) + 0.2f;
    const float* o1 = OT + (size_t)tok * 512 + h * 128; const float* o2 = o1 + (size_t)MTOK * 512;
    float ss = 0.f;
    for (int e = 0; e < 128; ++e) { const float d = o1[e] - lam * o2[e]; ss += d * d; }
    const float r = rsqrtf(ss * (1.f / 128.f) + LN_EPS) * 0.8f;
    for (int e = 0; e < 128; ++e) { const float d = o1[e] - lam * o2[e]; MC[(size_t)tok * DM + h * 128 + e] = f2bf(d * r * g[e]); }
}
__global__ void __launch_bounds__(128) nv_ret(const bf16_t* HP, float* OT) {
    const int b = blockIdx.x >> 2, h = blockIdx.x & 3, e = threadIdx.x;
    const float gamma = 1.f - exp2f(-5.f - (float)h);
    float S[64];
#pragma unroll
    for (int d = 0; d < 64; ++d) S[d] = 0.f;
    for (int t = 0; t < SEQ; ++t) {
        const bf16_t* row = HP + ((size_t)b * SEQ + t) * IN_ODD;
        const float v = bf2f(row[512 + h * 128 + e]); float o = 0.f;
#pragma unroll
        for (int d = 0; d < 64; ++d) { const float kd = bf2f(row[256 + h * 64 + d]) * 0.125f; S[d] = gamma * S[d] + kd * v; o += bf2f(row[h * 64 + d]) * S[d]; }
        OT[((size_t)b * SEQ + t) * 512 + h * 128 + e] = o;
    }
}
__global__ void __launch_bounds__(256) nv_gn_gate(const float* OT, const bf16_t* HP, const float* g, const float* bb, bf16_t* MC) {
    const int i = blockIdx.x * 256 + threadIdx.x; const int tok = i >> 2, h = i & 3;
    const float* o = OT + (size_t)tok * 512 + h * 128; float s = 0.f;
    for (int e = 0; e < 128; ++e) s += o[e];
    const float mu = s * (1.f / 128.f); float q = 0.f;
    for (int e = 0; e < 128; ++e) { const float d = o[e] - mu; q += d * d; }
    const float r = rsqrtf(q * (1.f / 128.f) + LN_EPS);
    for (int e = 0; e < 128; ++e) { const int c = h * 128 + e; const float y = (o[e] - mu) * r * g[c] + bb[c]; const float gt = bf2f(HP[(size_t)tok * IN_ODD + 1024 + c]);
        MC[(size_t)tok * DM + c] = f2bf(y * silu(gt)); }
}
__global__ void __launch_bounds__(256) nv_sgu_ln(const bf16_t* HP, const float* g, const float* bb, float* VN) {
    const int tok = blockIdx.x * 256 + threadIdx.x; const bf16_t* v = HP + (size_t)tok * IN_ODD + 2048; float s = 0.f;
    for (int c = 0; c < 512; ++c) s += bf2f(v[c]);
    const float mu = s * (1.f / 512.f); float q = 0.f;
    for (int c = 0; c < 512; ++c) { const float d = bf2f(v[c]) - mu; q += d * d; }
    const float r = rsqrtf(q * (1.f / 512.f) + LN_EPS);
    for (int c = 0; c < 512; ++c) VN[(size_t)tok * 512 + c] = (bf2f(v[c]) - mu) * r * g[c] + bb[c];
}
__global__ void __launch_bounds__(256) nv_sgu_mix(const float* VN, const bf16_t* HP, const float* W, const float* bs, bf16_t* MC) {
    const int chunk = blockIdx.x, g = blockIdx.y, c = threadIdx.x & 127, th = threadIdx.x >> 7;
    for (int t = th * 64; t < th * 64 + 64; ++t) {
        float acc = 0.f; const float* w = W + ((size_t)g * 128 + t) * 128;
        for (int s = 0; s <= t; ++s) acc += w[s] * VN[((size_t)chunk * 128 + s) * 512 + g * 128 + c];
        const size_t tok = (size_t)chunk * 128 + t; const float u = bf2f(HP[tok * IN_ODD + 1536 + g * 128 + c]);
        MC[tok * DM + 512 + g * 128 + c] = f2bf(u * (acc + bs[g * 128 + t]));
    }
}

namespace pg8 {
#define PG8_LAS __attribute__((address_space(3)))
typedef unsigned short bf16_t;
typedef short bf16x8 __attribute__((ext_vector_type(8)));
typedef float f32x4 __attribute__((ext_vector_type(4)));
typedef unsigned u32x4 __attribute__((ext_vector_type(4)));
constexpr int BM = 256, BK = 64, HALF = 128, HTB = HALF * BK * 2  , STAGE_BYTES = 8 * HTB, NXCD = 8, WGM = 8;

__host__ __device__ __forceinline__ int lds_byte(int r, int c) { const int st = (r >> 4) * 2 + (c >> 5), rr = r & 15, cc = c & 31, ob = rr * 64 + cc * 2; return st * 1024 + (ob ^ (((ob >> 9) & 1) << 5)); }
__host__ __device__ __forceinline__ void stage_rc(int b, int& R, int& C) { const int st = b / 1024, sb = b % 1024, swz = sb ^ (((sb >> 9) & 1) << 5); R = (st >> 1) * 16 + swz / 64; C = (st & 1) * 32 + (swz % 64) / 2; }
__host__ __device__ __forceinline__ int perm32(int rho) { const int n = rho >> 4, i = rho & 15; return 8 * (i >> 2) + 4 * n + (i & 3); }

struct Unit { int pm, pn; };
struct Gemm { const bf16_t* A; const bf16_t* Bt; int M, N, K; };

struct StaticOrder {
    int nM, nN, nwg, G, c;
    __host__ __device__ void init(int M, int N, int G_, int c_) { nM = M / BM; nN = N / BM; nwg = nM * nN; G = G_; c = c_; }
    __host__ __device__ bool next(int i, Unit& u) const {
        const long L = (long)i * G + c; if (L >= nwg) return false;
        int wgid = (int)L; { const int q = nwg / NXCD, r = nwg % NXCD, xcd = wgid % NXCD, off = wgid / NXCD; wgid = (xcd < r ? xcd * (q + 1) : r * (q + 1) + (xcd - r) * q) + off; }
        const int nig = WGM * nN, gid = wgid / nig, fm = gid * WGM, gsz = (nM - fm) < WGM ? (nM - fm) : WGM;
        u.pm = fm + ((wgid % nig) % gsz); u.pn = (wgid % nig) / gsz; return true;
    }
    __device__ __forceinline__ void a_ready(const Unit&) const {}
    __device__ __forceinline__ void done(const Unit&) const {}
};

__device__ __forceinline__ unsigned cvt_pk_bf16(float lo, float hi) { unsigned r; asm volatile("v_cvt_pk_bf16_f32 %0, %1, %2" : "=v"(r) : "v"(lo), "v"(hi)); return r; }
__device__ __forceinline__ float e_gelu(float x) { const float u = 0.7978845608028654f * (x + 0.044715f * x * x * x); return x * __builtin_amdgcn_rcpf(1.f + __builtin_amdgcn_exp2f(-2.885390081777927f * u)); }
__device__ __forceinline__ float e_silu(float x) { return x * __builtin_amdgcn_rcpf(1.f + __builtin_amdgcn_exp2f(-1.4426950408889634f * x)); }
struct EpiBf16G {
    static constexpr bool PERM = true, AFTER_DRAIN = false;
    bf16_t* O; int ldc; int gelu_from_tile;
    __device__ __forceinline__ void operator()(const f32x4 (&acc)[2][2][4][2], const Unit& u, int wr, int wc, int fr, int fq) const {
        const int row0 = u.pm * BM + wr * 64 + fr, col0 = u.pn * BM + wc * 32 + 8 * fq; const bool g = u.pn >= gelu_from_tile;
#pragma unroll
        for (int ai = 0; ai < 2; ++ai)
#pragma unroll
            for (int m = 0; m < 4; ++m) { bf16_t* rowp = O + (size_t)(row0 + ai * HALF + m * 16) * ldc + col0;
#pragma unroll
                for (int bj = 0; bj < 2; ++bj) { f32x4 v0 = acc[ai][bj][m][0], v1 = acc[ai][bj][m][1];
                    if (g) {
#pragma unroll
                        for (int i = 0; i < 4; ++i) { v0[i] = e_gelu(v0[i]); v1[i] = e_gelu(v1[i]); } }
                    u32x4 w; w.x = cvt_pk_bf16(v0[0], v0[1]); w.y = cvt_pk_bf16(v0[2], v0[3]); w.z = cvt_pk_bf16(v1[0], v1[1]); w.w = cvt_pk_bf16(v1[2], v1[3]);
                    *(u32x4*)(rowp + bj * HALF) = w; } }
    }
};
struct EpiSwiglu {
    static constexpr bool PERM = true, AFTER_DRAIN = false;
    bf16_t* O; int ldc;
    __device__ __forceinline__ void operator()(const f32x4 (&acc)[2][2][4][2], const Unit& u, int wr, int wc, int fr, int fq) const {
        const int row0 = u.pm * BM + wr * 64 + fr, col0 = u.pn * HALF + wc * 32 + 8 * fq;
#pragma unroll
        for (int ai = 0; ai < 2; ++ai)
#pragma unroll
            for (int m = 0; m < 4; ++m) { bf16_t* rowp = O + (size_t)(row0 + ai * HALF + m * 16) * ldc + col0;
                f32x4 h0, h1;
#pragma unroll
                for (int i = 0; i < 4; ++i) { h0[i] = e_silu(acc[ai][0][m][0][i]) * acc[ai][1][m][0][i]; h1[i] = e_silu(acc[ai][0][m][1][i]) * acc[ai][1][m][1][i]; }
                u32x4 w; w.x = cvt_pk_bf16(h0[0], h0[1]); w.y = cvt_pk_bf16(h0[2], h0[3]); w.z = cvt_pk_bf16(h1[0], h1[1]); w.w = cvt_pk_bf16(h1[2], h1[3]);
                *(u32x4*)rowp = w; }
    }
};
struct EpiResid {
    static constexpr bool PERM = false, AFTER_DRAIN = false;
    const float* R; float* Y; int ldc; float alpha;
    __device__ __forceinline__ void operator()(const f32x4 (&acc)[2][2][4][2], const Unit& u, int wr, int wc, int fr, int fq) const {
        const int row0 = u.pm * BM + wr * 64 + fr, col0 = u.pn * BM + wc * 32 + 4 * fq;
#pragma unroll
        for (int ai = 0; ai < 2; ++ai)
#pragma unroll
            for (int m = 0; m < 4; ++m) { const size_t off = (size_t)(row0 + ai * HALF + m * 16) * ldc + col0;
#pragma unroll
                for (int bj = 0; bj < 2; ++bj)
#pragma unroll
                    for (int n = 0; n < 2; ++n) { const f32x4 r = *(const f32x4*)(R + off + bj * HALF + n * 16); *(f32x4*)(Y + off + bj * HALF + n * 16) = r * alpha + acc[ai][bj][m][n]; }
                if (m & 1) asm volatile("" ::: "memory"); }
    }
};
template <class Epi, class Sched, bool ALIGN_EPI = false, bool SP2 = false>
__device__ __forceinline__ void gemm_phase(PG8_LAS unsigned char* lds, const Gemm g, const Sched& S, const Epi& E, const int tid) {
    const int wid = __builtin_amdgcn_readfirstlane(tid >> 6), lane = tid & 63, wr = wid >> 2, wc = wid & 3, fr = lane & 15, fq = lane >> 4;
    const int K = g.K, nt = K / BK;
    unsigned voffA[2], voffB[2];
#pragma unroll
    for (int i = 0; i < 2; ++i) { int R, C; stage_rc(tid * 16 + i * 8192, R, C); const int Rb = Epi::PERM ? ((R & ~31) + perm32(R & 31)) : R;
        voffA[i] = (unsigned)(R * K + C) * 2u; voffB[i] = (unsigned)(Rb * K + C) * 2u; }
    const size_t kstep = (size_t)(BK * 2);
    const size_t hstep = (size_t)HALF * K * 2;
    const size_t tstep = 2 * hstep;
    const unsigned ldsw = (unsigned)wid * 1024u;
    const int aoff = lds_byte(wr * 64 + fr, fq * 8), boff = lds_byte(wc * 32 + fr, fq * 8);
#define PG8_SA(b, h) (((b) * 2 + (h)) * HTB)
#define PG8_SB(b, h) ((4 + (b) * 2 + (h)) * HTB)
#define PG8_STAGE(bufoff, gbase, voff) do { _Pragma("unroll") for (int _i = 0; _i < 2; ++_i) \
        __builtin_amdgcn_global_load_lds((const unsigned*)((const char*)(gbase) + (voff)[_i]), (PG8_LAS unsigned*)(lds + (bufoff) + ldsw + _i * 8192), 16, 0, 0); } while (0)
#define PG8_LDA(dst, b, h) do { _Pragma("unroll") for (int m = 0; m < 4; ++m) _Pragma("unroll") for (int k = 0; k < 2; ++k) dst[m][k] = *(const PG8_LAS bf16x8*)(lds + PG8_SA(b, h) + aoff + m * 2048 + k * 1024); } while (0)
#define PG8_LDB(dst, b, h) do { _Pragma("unroll") for (int n = 0; n < 2; ++n) _Pragma("unroll") for (int k = 0; k < 2; ++k) dst[n][k] = *(const PG8_LAS bf16x8*)(lds + PG8_SB(b, h) + boff + n * 2048 + k * 1024); } while (0)
#define PG8_MMA(ai, bj, At, Bt) do { __builtin_amdgcn_s_setprio(1); _Pragma("unroll") for (int m = 0; m < 4; ++m) _Pragma("unroll") for (int n = 0; n < 2; ++n) _Pragma("unroll") for (int k = 0; k < 2; ++k) \
        acc[ai][bj][m][n] = __builtin_amdgcn_mfma_f32_16x16x32_bf16(Bt[n][k], At[m][k], acc[ai][bj][m][n], 0, 0, 0); __builtin_amdgcn_s_setprio(0); } while (0)
#define PG8_WAIT_V(n) asm volatile("s_waitcnt vmcnt(" #n ")" ::: "memory")
#define PG8_WAIT_L(n) asm volatile("s_waitcnt lgkmcnt(" #n ")" ::: "memory")
#define PG8_BAR __builtin_amdgcn_s_barrier()
#define PG8_SCHED __builtin_amdgcn_sched_barrier(0)
    Unit cur, nxt; int ui = 0;
    if (!S.next(0, cur)) return;
    f32x4 acc[2][2][4][2];
#pragma unroll
    for (int a = 0; a < 2; ++a)
#pragma unroll
        for (int b = 0; b < 2; ++b)
#pragma unroll
            for (int m = 0; m < 4; ++m)
#pragma unroll
                for (int n = 0; n < 2; ++n) acc[a][b][m][n] = (f32x4){0.f, 0.f, 0.f, 0.f};
    bf16x8 At[4][2], B0[2][2], B1[2][2];
    const char* cA = (const char*)g.A + (size_t)cur.pm * tstep; const char* cB = (const char*)g.Bt + (size_t)cur.pn * tstep;
    S.a_ready(cur);
    if constexpr (SP2) {
        PG8_STAGE(PG8_SB(0, 0), cB, voffB); PG8_STAGE(PG8_SB(0, 1), cB + hstep, voffB); PG8_STAGE(PG8_SA(0, 0), cA, voffA); PG8_STAGE(PG8_SA(0, 1), cA + hstep, voffA);
        if (wr == 1) PG8_BAR;
        PG8_WAIT_V(2); PG8_BAR;
        PG8_STAGE(PG8_SB(1, 0), cB + kstep, voffB); PG8_STAGE(PG8_SA(1, 0), cA + kstep, voffA); PG8_STAGE(PG8_SB(1, 1), cB + hstep + kstep, voffB);
        PG8_WAIT_V(6); PG8_BAR;
    } else {
        PG8_STAGE(PG8_SB(0, 0), cB, voffB); PG8_STAGE(PG8_SA(0, 0), cA, voffA); PG8_STAGE(PG8_SB(0, 1), cB + hstep, voffB); PG8_STAGE(PG8_SA(0, 1), cA + hstep, voffA);
        if (wr == 1) PG8_BAR;
        PG8_WAIT_V(4); PG8_BAR;
        PG8_STAGE(PG8_SB(1, 0), cB + kstep, voffB); PG8_STAGE(PG8_SA(1, 0), cA + kstep, voffA); PG8_STAGE(PG8_SB(1, 1), cB + hstep + kstep, voffB);
        PG8_WAIT_V(6); PG8_BAR;
    }
    for (;;) {
        const bool has_next = S.next(ui + 1, nxt);
        const char* nA = has_next ? (const char*)g.A + (size_t)nxt.pm * tstep : cA; const char* nB = has_next ? (const char*)g.Bt + (size_t)nxt.pn * tstep : cB;
        for (int t = 0; t < nt; t += 2) {
            const bool last = (t == nt - 2);
            const char* a1 = cA + (size_t)(t + 1) * kstep;
            const char* a2 = last ? nA : cA + (size_t)(t + 2) * kstep; const char* b2 = last ? nB : cB + (size_t)(t + 2) * kstep;
            const char* a3 = a2 + kstep; const char* b3 = b2 + kstep;
            if (last && has_next) S.a_ready(nxt);
            if constexpr (SP2) {
            PG8_LDB(B0, 0, 0); PG8_LDB(B1, 0, 1); PG8_SCHED; PG8_LDA(At, 0, 0); PG8_STAGE(PG8_SA(1, 1), a1 + hstep, voffA);
            PG8_WAIT_V(8); PG8_WAIT_L(0); PG8_BAR; PG8_MMA(0, 0, At, B0); PG8_MMA(0, 1, At, B1); PG8_BAR; PG8_SCHED;
            PG8_LDA(At, 0, 1); PG8_STAGE(PG8_SB(0, 0), b2, voffB); PG8_STAGE(PG8_SB(0, 1), b2 + hstep, voffB); PG8_STAGE(PG8_SA(0, 0), a2, voffA);
            PG8_WAIT_V(8); PG8_WAIT_L(0); PG8_BAR; PG8_MMA(1, 0, At, B0); PG8_MMA(1, 1, At, B1); PG8_BAR; PG8_SCHED;
            PG8_LDB(B0, 1, 0); PG8_LDB(B1, 1, 1); PG8_SCHED; PG8_LDA(At, 1, 0); PG8_STAGE(PG8_SA(0, 1), a2 + hstep, voffA);
            PG8_WAIT_V(8); PG8_WAIT_L(0); PG8_BAR; PG8_MMA(0, 0, At, B0); PG8_MMA(0, 1, At, B1); PG8_BAR; PG8_SCHED;
            PG8_LDA(At, 1, 1); PG8_STAGE(PG8_SB(1, 0), b3, voffB); PG8_STAGE(PG8_SB(1, 1), b3 + hstep, voffB); PG8_STAGE(PG8_SA(1, 0), a3, voffA);
            PG8_WAIT_V(8); PG8_WAIT_L(0); PG8_BAR; PG8_MMA(1, 0, At, B0); PG8_MMA(1, 1, At, B1); PG8_BAR; PG8_SCHED;
            } else {
            PG8_LDB(B0, 0, 0); PG8_SCHED; PG8_LDA(At, 0, 0); PG8_STAGE(PG8_SA(1, 1), a1 + hstep, voffA);
            PG8_WAIT_L(8); PG8_BAR; PG8_WAIT_L(0); PG8_MMA(0, 0, At, B0); PG8_BAR; PG8_SCHED;
            PG8_LDB(B1, 0, 1); PG8_STAGE(PG8_SB(0, 0), b2, voffB);
            PG8_BAR; PG8_WAIT_L(0); PG8_MMA(0, 1, At, B1); PG8_BAR;
            PG8_LDA(At, 0, 1); PG8_STAGE(PG8_SA(0, 0), a2, voffA);
            PG8_BAR; PG8_WAIT_L(0); PG8_MMA(1, 0, At, B0); PG8_BAR; PG8_SCHED;
            PG8_STAGE(PG8_SB(0, 1), b2 + hstep, voffB);
            PG8_WAIT_V(6); PG8_BAR; PG8_MMA(1, 1, At, B1); PG8_BAR;
            PG8_LDB(B0, 1, 0); PG8_SCHED; PG8_LDA(At, 1, 0); PG8_STAGE(PG8_SA(0, 1), a2 + hstep, voffA);
            PG8_WAIT_L(8); PG8_BAR; PG8_WAIT_L(0); PG8_MMA(0, 0, At, B0); PG8_BAR; PG8_SCHED;
            PG8_LDB(B1, 1, 1); PG8_STAGE(PG8_SB(1, 0), b3, voffB);
            PG8_BAR; PG8_WAIT_L(0); PG8_MMA(0, 1, At, B1); PG8_BAR;
            PG8_LDA(At, 1, 1); PG8_STAGE(PG8_SA(1, 0), a3, voffA);
            PG8_BAR; PG8_WAIT_L(0); PG8_MMA(1, 0, At, B0); PG8_BAR; PG8_SCHED;
            PG8_STAGE(PG8_SB(1, 1), b3 + hstep, voffB);
            PG8_WAIT_V(6); PG8_BAR; PG8_MMA(1, 1, At, B1); PG8_BAR;
            }
        }
        if constexpr (ALIGN_EPI) { if (wr == 0) PG8_BAR; }
        if constexpr (!Epi::AFTER_DRAIN) { E(acc, cur, wr, wc, fr, fq); S.done(cur); }
        if (!has_next) break;
#pragma unroll
        for (int a = 0; a < 2; ++a)
#pragma unroll
            for (int b = 0; b < 2; ++b)
#pragma unroll
                for (int m = 0; m < 4; ++m)
#pragma unroll
                    for (int n = 0; n < 2; ++n) acc[a][b][m][n] = (f32x4){0.f, 0.f, 0.f, 0.f};
        cur = nxt; cA = nA; cB = nB; ++ui;
        if constexpr (ALIGN_EPI) { if (wr == 1) PG8_BAR; }
    }
    PG8_WAIT_V(0);
    if constexpr (!ALIGN_EPI) { if (wr == 0) PG8_BAR; }
    PG8_BAR;
    if constexpr (Epi::AFTER_DRAIN) { E.fused(acc, cur, wr, wc, fr, fq, lds, wid, lane); S.done(cur); }
#undef PG8_SA
#undef PG8_SB
#undef PG8_STAGE
#undef PG8_LDA
#undef PG8_LDB
#undef PG8_MMA
#undef PG8_WAIT_V
#undef PG8_WAIT_L
#undef PG8_BAR
#undef PG8_SCHED
}
}
#define LAS __attribute__((address_space(3)))
typedef float f32x4 __attribute__((ext_vector_type(4)));
typedef unsigned u32x4 __attribute__((ext_vector_type(4)));
typedef unsigned u32x2 __attribute__((ext_vector_type(2)));
constexpr int NWAVES = 8, NTHR = 512;
constexpr int LDS_BYTES = 147456;
constexpr int NPHASE = 17;

struct Args { const float* in[24]; float* out; unsigned char* ws; int ph_lo, ph_hi; };
typedef const __attribute__((address_space(4))) unsigned char* kptr_t;
DEV const float* kin(kptr_t kp, int k) { return *(const float* const __attribute__((address_space(4)))*)(kp + 8 * k); }
DEV float* kout(kptr_t kp) { return *(float* const __attribute__((address_space(4)))*)(kp + 192); }
DEV unsigned char* kws(kptr_t kp) { return *(unsigned char* const __attribute__((address_space(4)))*)(kp + 200); }
static_assert(sizeof(Args) == 216, "Args layout");

DEV float wave_sum(float v) {
#pragma unroll
    for (int o = 1; o < 64; o <<= 1) v += __shfl_xor(v, o);
    return v;
}
DEV unsigned pk2(float lo, float hi) { return pg8::cvt_pk_bf16(lo, hi); }

DEV void p0_transpose_item(const float* W, int K, int N, bf16_t* WT, int mode, LAS float* scr, int item, int lane) {
    const int nblk = N / 32, kb = item / nblk, nb = item % nblk, k0 = 64 * kb, n0 = 32 * nb;
#pragma unroll 8
    for (int i = 0; i < 32; ++i) { const int kk = 2 * i + (lane >> 5); scr[kk * 33 + (lane & 31)] = W[(size_t)(k0 + kk) * N + n0 + (lane & 31)]; }
    asm volatile("s_waitcnt lgkmcnt(0)" ::: "memory");
    const int c = lane & 7;
#pragma unroll
    for (int j = 0; j < 4; ++j) { const int nl = (lane >> 3) + 8 * j, n = n0 + nl; const LAS float* s = scr + (8 * c) * 33 + nl;
        const int r = mode == 0 ? n : (256 * (n >> 7) + (n & 127) + (mode == 2 ? 128 : 0));
        u32x4 o; o.x = pk2(s[0 * 33], s[1 * 33]); o.y = pk2(s[2 * 33], s[3 * 33]); o.z = pk2(s[4 * 33], s[5 * 33]); o.w = pk2(s[6 * 33], s[7 * 33]);
        *(u32x4*)(WT + (size_t)r * K + k0 + 8 * c) = o; }
    asm volatile("s_waitcnt lgkmcnt(0)" ::: "memory");
}
DEV void p0_prologue(kptr_t kp, LAS unsigned char* lds, int gw, int NGW, int wave, int lane) {
    LAS float* scr = (LAS float*)(lds + wave * 16384);
    unsigned char* ws = kws(kp);
    constexpr int I_INE = (DM / 64) * (IN_EVEN / 32), I_SQ = (DM / 64) * (DM / 32), I_INO = (DM / 64) * (IN_ODD / 32), I_GU = (DM / 64) * (DFF / 32), I_DN = (DFF / 64) * (DM / 32);
    constexpr int NITEMS = I_INE + 2 * I_SQ + I_INO + 4 * I_GU + 2 * I_DN;
    for (int it = gw; it < NITEMS; it += NGW) {
        int r = it; const float* W; int K, N, mode = 0; bf16_t* dst;
        if (r < I_INE) { W = kin(kp, 1); K = DM; N = IN_EVEN; dst = (bf16_t*)(ws + WS_WINE); }
        else if ((r -= I_INE) < I_SQ) { W = kin(kp, 8); K = DM; N = DM; dst = (bf16_t*)(ws + WS_WOUTE); }
        else if ((r -= I_SQ) < I_INO) { W = kin(kp, 9); K = DM; N = IN_ODD; dst = (bf16_t*)(ws + WS_WINO); }
        else if ((r -= I_INO) < I_SQ) { W = kin(kp, 16); K = DM; N = DM; dst = (bf16_t*)(ws + WS_WOUTO); }
        else if ((r -= I_SQ) < I_GU) { W = kin(kp, 19); K = DM; N = DFF; mode = 1; dst = (bf16_t*)(ws + WS_WGU0); }
        else if ((r -= I_GU) < I_GU) { W = kin(kp, 20); K = DM; N = DFF; mode = 2; dst = (bf16_t*)(ws + WS_WGU0); }
        else if ((r -= I_GU) < I_GU) { W = kin(kp, 19) + (size_t)DM * DFF; K = DM; N = DFF; mode = 1; dst = (bf16_t*)(ws + WS_WGU1); }
        else if ((r -= I_GU) < I_GU) { W = kin(kp, 20) + (size_t)DM * DFF; K = DM; N = DFF; mode = 2; dst = (bf16_t*)(ws + WS_WGU1); }
        else if ((r -= I_GU) < I_DN) { W = kin(kp, 21); K = DFF; N = DM; dst = (bf16_t*)(ws + WS_WDN0); }
        else { r -= I_DN; W = kin(kp, 21) + (size_t)DM * DFF; K = DFF; N = DM; dst = (bf16_t*)(ws + WS_WDN1); }
        p0_transpose_item(W, K, N, dst, mode, scr, r, lane);
    }
    { bf16_t* wsb = (bf16_t*)(ws + WS_SGUW);
      for (int i = gw * 64 + lane; i < 4 * 128 * 128; i += NGW * 64) { const int t = (i >> 7) & 127, sx = i & 127; wsb[i] = sx <= t ? f2bf(kin(kp, 14)[i]) : (bf16_t)0; } }
    const f32x4* x4 = (const f32x4*)kin(kp, 0); u32x2* o2 = (u32x2*)(ws + WS_XB);
    for (size_t i = (size_t)gw * 64 + lane; i < (size_t)MTOK * DM / 4; i += (size_t)NGW * 64) { const f32x4 v = x4[i]; u32x2 w; w.x = pk2(v.x, v.y); w.y = pk2(v.z, v.w); o2[i] = w; }
}
DEV void ln_phase(const float* Y, const float* g, const float* b, float* XF, bf16_t* XB, int gw, int NGW, int lane) {
    f32x4 gv[4], bv[4];
#pragma unroll
    for (int j = 0; j < 4; ++j) { gv[j] = ((const f32x4*)g)[lane + 64 * j]; bv[j] = ((const f32x4*)b)[lane + 64 * j]; }
    for (int m = gw; m < MTOK; m += NGW) {
        const f32x4* xr = (const f32x4*)(Y + (size_t)m * DM) + lane;
        f32x4 v[4]; float s = 0.f;
#pragma unroll
        for (int j = 0; j < 4; ++j) { v[j] = xr[64 * j]; s += (v[j].x + v[j].y) + (v[j].z + v[j].w); }
        const float mean = wave_sum(s) * (1.f / DM); float s2 = 0.f;
#pragma unroll
        for (int j = 0; j < 4; ++j) { v[j] = v[j] - mean; s2 += (v[j].x * v[j].x + v[j].y * v[j].y) + (v[j].z * v[j].z + v[j].w * v[j].w); }
        const float rstd = rsqrtf(wave_sum(s2) * (1.f / DM) + LN_EPS);
        f32x4* of = (f32x4*)(XF + (size_t)m * DM) + lane; u32x2* ob = (u32x2*)(XB + (size_t)m * DM) + lane;
#pragma unroll
        for (int j = 0; j < 4; ++j) { const f32x4 o = v[j] * rstd * gv[j] + bv[j]; of[64 * j] = o; u32x2 w; w.x = pk2(o.x, o.y); w.y = pk2(o.z, o.w); ob[64 * j] = w; }
    }
}

namespace att {
typedef short bf16x8 __attribute__((ext_vector_type(8)));
typedef short s16x4 __attribute__((ext_vector_type(4)));
typedef float f32x16 __attribute__((ext_vector_type(16)));
constexpr int KROW = 272, VROW = 320;
constexpr int KT_BYTES = 64 * KROW, VT_BYTES = 64 * VROW, STAGE = KT_BYTES + VT_BYTES;
constexpr int LDS_WSF = 2 * STAGE;
constexpr int LDS_TAB = LDS_WSF + 8 * 256;
constexpr int XROW = 132;
constexpr float LOG2E = 1.4426950408889634f, C1 = 0.125f * LOG2E;
DEV int crow(int reg, int hh) { return (reg & 3) + 8 * (reg >> 2) + 4 * hh; }
DEV s16x4 vtr(const LAS unsigned char* p) { typedef short v4i16_t __attribute__((ext_vector_type(4))); return __builtin_bit_cast(s16x4, __builtin_amdgcn_ds_read_tr16_b64_v4i16((LAS v4i16_t*)p)); }

template <int MODE> DEV void attn_unit(LAS unsigned char* lds, const bf16_t* __restrict__ HP, bf16_t* __restrict__ MC, int b, int hx, int qb, float lam, const float* __restrict__ subg, const float* __restrict__ relb, int tid) {
    const int lane = tid & 63, wave = __builtin_amdgcn_readfirstlane(tid >> 6), g = wave >> 2, wq = wave & 3, r = lane & 31, hh = lane >> 5;
    constexpr int QOFF = MODE == 0 ? 0 : 1536, KOFF = MODE == 0 ? 512 : 2048, VOFF = MODE == 0 ? 1024 : 2560, NEB = MODE == 0 ? 4 : 2;
    const size_t row0 = (size_t)b * SEQ; const int q0 = qb * 128;
    const int cw = 2 * qb + (wq >> 1);
    const int kt_lo = MODE == 0 ? 0 : (2 * qb - 8 > 0 ? 2 * qb - 8 : 0), kt_hi = 2 * qb + 1;
    LAS float* wsf = (LAS float*)(lds + LDS_WSF) + wave * 64;
    LAS float* tab = (LAS float*)(lds + LDS_TAB);
    if (MODE == 1) { for (int i = tid; i < 514; i += NTHR) tab[i] = relb[(2 * hx + (i >= 257 ? 1 : 0)) * 257 + (i >= 257 ? i - 257 : i)] * LOG2E; }
    bf16x8 qf[4];
    { const bf16_t* qp = HP + (row0 + q0 + 32 * wq + r) * IN_EVEN + QOFF + hx * 128 + g * 64 + hh * 8;
#pragma unroll
      for (int ds = 0; ds < 4; ++ds) qf[ds] = *(const bf16x8*)(qp + 16 * ds); }
    f32x16 o[NEB];
#pragma unroll
    for (int eb = 0; eb < NEB; ++eb)
#pragma unroll
        for (int i = 0; i < 16; ++i) o[eb][i] = 0.f;
    float mhat = -1e30f, l = 0.f;
    const int tq = q0 + 32 * wq + r;
    const float sl2 = exp2f(-2.0f * (float)(hx + 1)) * LOG2E;
    const int srow = tid >> 4, scc = tid & 15;
    const bf16_t* kg = HP + (row0 + srow) * IN_EVEN + KOFF + hx * 128 + scc * 8;
    const bf16_t* vg = HP + (row0 + srow) * IN_EVEN + VOFF + hx * 128 + scc * 8;
    u32x4 kreg[2], vreg[2];
#define ATT_LOAD(kt) do { _Pragma("unroll") for (int i_ = 0; i_ < 2; ++i_) { const size_t ro_ = (size_t)(64 * (kt) + 32 * i_) * IN_EVEN; kreg[i_] = *(const u32x4*)(kg + ro_); vreg[i_] = *(const u32x4*)(vg + ro_); } } while (0)
#define ATT_STORE(buf) do { _Pragma("unroll") for (int i_ = 0; i_ < 2; ++i_) { *(LAS u32x4*)(lds + (buf) * STAGE + (srow + 32 * i_) * KROW + scc * 16) = kreg[i_]; \
        *(LAS u32x4*)(lds + (buf) * STAGE + KT_BYTES + (srow + 32 * i_) * VROW + scc * 16) = vreg[i_]; } } while (0)
    ATT_LOAD(kt_lo); ATT_STORE(0);
    __syncthreads();
    const int p15 = lane & 15, g4 = lane >> 4;
    const int vlane = (4 * hh + (p15 >> 2)) * VROW + ((MODE == 1 ? g * 64 : 0) + 16 * (g4 & 1) + 4 * (p15 & 3)) * 2;
    for (int kt = kt_lo; kt <= kt_hi; ++kt) {
        const int buf = (kt - kt_lo) & 1;
        if (kt < kt_hi) ATT_LOAD(kt + 1);
        const bool active = MODE == 0 ? (kt <= cw) : (kt <= cw && kt >= cw - 8);
        if (active) {
            const LAS unsigned char* Kb = lds + buf * STAGE; const LAS unsigned char* Vb = Kb + KT_BYTES;
            f32x16 s0, s1;
#pragma unroll
            for (int i = 0; i < 16; ++i) { s0[i] = 0.f; s1[i] = 0.f; }
#pragma unroll
            for (int ds = 0; ds < 4; ++ds) {
                const bf16x8 k0 = *(const LAS bf16x8*)(Kb + r * KROW + g * 128 + ds * 32 + hh * 16);
                const bf16x8 k1 = *(const LAS bf16x8*)(Kb + (32 + r) * KROW + g * 128 + ds * 32 + hh * 16);
                s0 = __builtin_amdgcn_mfma_f32_32x32x16_bf16(k0, qf[ds], s0, 0, 0, 0);
                s1 = __builtin_amdgcn_mfma_f32_32x32x16_bf16(k1, qf[ds], s1, 0, 0, 0);
            }
            const int dbase = tq - (64 * kt + 4 * hh);
            if (MODE == 0) {
#pragma unroll
                for (int i = 0; i < 16; ++i) { const int off = (i & 3) + 8 * (i >> 2); const float d0 = (float)(dbase - off), d1 = (float)(dbase - off - 32);
                    s0[i] = s0[i] * C1 - sl2 * __builtin_fabsf(d0); s1[i] = s1[i] * C1 - sl2 * __builtin_fabsf(d1); }
            } else {
                if (kt <= cw - 3) { const float tf = tab[g * 257 + 256];
#pragma unroll
                    for (int i = 0; i < 16; ++i) { s0[i] = s0[i] * C1 + tf; s1[i] = s1[i] * C1 + tf; }
                } else {
#pragma unroll
                    for (int i = 0; i < 16; ++i) { const int off = (i & 3) + 8 * (i >> 2); int r0 = dbase - off, r1 = r0 - 32;
                        r0 = r0 < -128 ? -128 : (r0 > 128 ? 128 : r0); r1 = r1 < -128 ? -128 : (r1 > 128 ? 128 : r1);
                        s0[i] = s0[i] * C1 + tab[g * 257 + 128 + r0]; s1[i] = s1[i] * C1 + tab[g * 257 + 128 + r1]; }
                }
            }
            float rm = __builtin_fmaxf(s0[0], s1[0]);
#pragma unroll
            for (int i = 1; i < 16; ++i) rm = __builtin_fmaxf(rm, __builtin_fmaxf(s0[i], s1[i]));
            rm = __builtin_fmaxf(rm, __shfl_xor(rm, 32));
            if (__any(rm > mhat + 8.f)) {
                const float mnew = __builtin_fmaxf(mhat, rm), f = __builtin_amdgcn_exp2f(mhat - mnew); mhat = mnew; l *= f;
                if (hh == 0) wsf[r] = f;
#pragma unroll
                for (int i = 0; i < 16; ++i) { const float fr = wsf[crow(i, hh)];
#pragma unroll
                    for (int eb = 0; eb < NEB; ++eb) o[eb][i] *= fr; }
            }
            float ls = 0.f;
#pragma unroll
            for (int i = 0; i < 16; ++i) { s0[i] = __builtin_amdgcn_exp2f(s0[i] - mhat); s1[i] = __builtin_amdgcn_exp2f(s1[i] - mhat); ls += s0[i] + s1[i]; }
            l += ls;
            bf16x8 pa[2][2];
#pragma unroll
            for (int s = 0; s < 2; ++s) {
                u32x4 w0, w1;
                w0.x = pk2(s0[8 * s + 0], s0[8 * s + 1]); w0.y = pk2(s0[8 * s + 2], s0[8 * s + 3]); w0.z = pk2(s0[8 * s + 4], s0[8 * s + 5]); w0.w = pk2(s0[8 * s + 6], s0[8 * s + 7]);
                w1.x = pk2(s1[8 * s + 0], s1[8 * s + 1]); w1.y = pk2(s1[8 * s + 2], s1[8 * s + 3]); w1.z = pk2(s1[8 * s + 4], s1[8 * s + 5]); w1.w = pk2(s1[8 * s + 6], s1[8 * s + 7]);
                pa[0][s] = __builtin_bit_cast(bf16x8, w0); pa[1][s] = __builtin_bit_cast(bf16x8, w1);
            }
#pragma unroll
            for (int kb = 0; kb < 2; ++kb)
#pragma unroll
                for (int s = 0; s < 2; ++s) {
                    const LAS unsigned char* vp = Vb + vlane + (32 * kb + 16 * s) * VROW;
#pragma unroll
                    for (int eb = 0; eb < NEB; ++eb) {
                        const s16x4 lo = vtr(vp + eb * 64), hi = vtr(vp + eb * 64 + 8 * VROW);
                        const bf16x8 vf = (bf16x8){lo[0], lo[1], lo[2], lo[3], hi[0], hi[1], hi[2], hi[3]};
                        o[eb] = __builtin_amdgcn_mfma_f32_32x32x16_bf16(pa[kb][s], vf, o[eb], 0, 0, 0);
                    }
                }
        }
        if (kt < kt_hi) ATT_STORE(buf ^ 1);
        __syncthreads();
    }
#undef ATT_LOAD
#undef ATT_STORE
    l += __shfl_xor(l, 32);
    if (hh == 0) wsf[r] = 1.0f / l;
#pragma unroll
    for (int i = 0; i < 16; ++i) { const float fr = wsf[crow(i, hh)];
#pragma unroll
        for (int eb = 0; eb < NEB; ++eb) o[eb][i] *= fr; }
    LAS float* X = (LAS float*)lds;
    const int xr = 32 * wq, rrow = xr + (lane >> 1), half = lane & 1;
    const size_t tok = row0 + q0 + rrow;
    if (MODE == 0) {
        if (g == 1) {
#pragma unroll
            for (int eb = 0; eb < NEB; ++eb)
#pragma unroll
                for (int i = 0; i < 16; ++i) X[(xr + crow(i, hh)) * XROW + 32 * eb + r] = o[eb][i];
        }
        __syncthreads();
        if (g == 0) {
#pragma unroll
            for (int eb = 0; eb < NEB; ++eb)
#pragma unroll
                for (int i = 0; i < 16; ++i) { const int ix = (xr + crow(i, hh)) * XROW + 32 * eb + r; X[ix] = o[eb][i] - lam * X[ix]; }
            f32x4 v[16]; float ss = 0.f;
#pragma unroll
            for (int j = 0; j < 16; ++j) { v[j] = *(const LAS f32x4*)(X + rrow * XROW + 64 * half + 4 * j); ss += (v[j].x * v[j].x + v[j].y * v[j].y) + (v[j].z * v[j].z + v[j].w * v[j].w); }
            ss += __shfl_xor(ss, 1);
            const float rs = rsqrtf(ss * (1.f / 128.f) + LN_EPS) * 0.8f;
            bf16_t* op = MC + tok * DM + hx * 128 + 64 * half;
#pragma unroll
            for (int j = 0; j < 8; ++j) { const f32x4 g0 = *(const f32x4*)(subg + 64 * half + 8 * j), g1 = *(const f32x4*)(subg + 64 * half + 8 * j + 4); const f32x4 a0 = v[2 * j] * rs * g0, a1 = v[2 * j + 1] * rs * g1;
                u32x4 w; w.x = pk2(a0.x, a0.y); w.y = pk2(a0.z, a0.w); w.z = pk2(a1.x, a1.y); w.w = pk2(a1.z, a1.w); *(u32x4*)(op + 8 * j) = w; }
        }
    } else {
#pragma unroll
        for (int eb = 0; eb < NEB; ++eb)
#pragma unroll
            for (int i = 0; i < 16; ++i) X[(xr + crow(i, hh)) * XROW + g * 64 + 32 * eb + r] = o[eb][i];
        f32x4 v[8];
#pragma unroll
        for (int j = 0; j < 8; ++j) v[j] = *(const LAS f32x4*)(X + rrow * XROW + g * 64 + 32 * half + 4 * j);
        bf16_t* op = MC + tok * DM + 512 + hx * 128 + g * 64 + 32 * half;
#pragma unroll
        for (int j = 0; j < 4; ++j) { const f32x4 a0 = v[2 * j], a1 = v[2 * j + 1]; u32x4 w; w.x = pk2(a0.x, a0.y); w.y = pk2(a0.z, a0.w); w.z = pk2(a1.x, a1.y); w.w = pk2(a1.z, a1.w); *(u32x4*)(op + 8 * j) = w; }
    }
    __syncthreads();
}

DEV void attn_phase(LAS unsigned char* lds, kptr_t kp, const bf16_t* HP, bf16_t* MC, int vcu, int G, int tid) {
    float s1 = 0.f, s2 = 0.f;
    { const float* q1 = kin(kp, 2); const float* k1 = kin(kp, 3); const float* q2 = kin(kp, 4); const float* k2 = kin(kp, 5);
      for (int d = 0; d < 64; ++d) { s1 += q1[d] * k1[d]; s2 += q2[d] * k2[d]; } }
    const float lam = expf(s1) - expf(s2) + 0.2f;
    for (int u = vcu; u < 1024; u += G) { const int i = u >> 8, bh = (u & 255) >> 4, s = u & 15; const int qb = i == 0 ? s : (i == 1 ? 31 - s : (i == 2 ? 32 + s : 63 - s));
        attn_unit<0>(lds, HP, MC, bh >> 2, bh & 3, qb, lam, kin(kp, 6), nullptr, tid); }
    for (int u = vcu; u < 1024; u += G) { const int id = 4 * (u & 255) + (u >> 8);
        attn_unit<1>(lds, HP, MC, id >> 8, (id >> 6) & 3, id & 63, 0.f, nullptr, kin(kp, 7), tid); }
}
}

namespace mix1 {
using att::bf16x8; using att::s16x4; using att::f32x16; using att::crow; using att::vtr;
constexpr int VSTR = 1088;
constexpr float LOG2E = 1.4426950408889634f;
DEV float lg2gamma(int h) { return __builtin_log2f(1.f - __builtin_amdgcn_exp2f(-5.f - (float)h)); }
DEV bf16x8 trpair(const LAS unsigned char* p, int hi_off) { const s16x4 lo = vtr(p), hi = vtr(p + hi_off); return (bf16x8){lo[0], lo[1], lo[2], lo[3], hi[0], hi[1], hi[2], hi[3]}; }

template <int KSTR, bool KSCALE> DEV void stage_kv(LAS unsigned char* lds, const bf16_t* __restrict__ HP, size_t tok0, int tid) {
    constexpr int VOFFB = 64 * KSTR;
#pragma unroll
    for (int i = 0; i < 4; ++i) { const int ck = tid + NTHR * i, row = ck >> 5, cc = ck & 31;
        u32x4 v = *(const u32x4*)(HP + (tok0 + row) * IN_ODD + 256 + cc * 8);
        if (KSCALE) { const float f = 0.125f * __builtin_amdgcn_exp2f((float)(63 - row) * lg2gamma(cc >> 3));
            unsigned w[4] = {v.x, v.y, v.z, v.w};
#pragma unroll
            for (int j = 0; j < 4; ++j) w[j] = pk2(__uint_as_float(w[j] << 16) * f, __uint_as_float(w[j] & 0xffff0000u) * f);
            v = (u32x4){w[0], w[1], w[2], w[3]}; }
        *(LAS u32x4*)(lds + row * KSTR + cc * 16) = v; }
#pragma unroll
    for (int i = 0; i < 8; ++i) { const int ck = tid + NTHR * i, row = ck >> 6, cc = ck & 63;
        *(LAS u32x4*)(lds + VOFFB + row * VSTR + cc * 16) = *(const u32x4*)(HP + (tok0 + row) * IN_ODD + 512 + cc * 8); }
}

DEV void ret_kv_phase(LAS unsigned char* lds, const bf16_t* __restrict__ HP, float* __restrict__ KV, int vcu, int G, int tid) {
    constexpr int KSTR = 576;
    const int lane = tid & 63, wave = __builtin_amdgcn_readfirstlane(tid >> 6), h = wave >> 1, dblk = wave & 1, r = lane & 31, hh = lane >> 5, p15 = lane & 15, g4 = lane >> 4;
    const int rowl = 4 * hh + (p15 >> 2), coll = 16 * (g4 & 1) + 4 * (p15 & 3);
    for (int u = vcu; u < BATCH * 128; u += G) { const int b = u >> 7, c = u & 127; const size_t tok0 = (size_t)b * SEQ + 64 * c;
        stage_kv<KSTR, true>(lds, HP, tok0, tid);
        __syncthreads();
        f32x16 acc[4];
#pragma unroll
        for (int eb = 0; eb < 4; ++eb)
#pragma unroll
            for (int i = 0; i < 16; ++i) acc[eb][i] = 0.f;
#pragma unroll
        for (int ks = 0; ks < 4; ++ks) {
            const bf16x8 kf = trpair(lds + (16 * ks + rowl) * KSTR + (h * 64 + 32 * dblk + coll) * 2, 8 * KSTR);
#pragma unroll
            for (int eb = 0; eb < 4; ++eb) { const bf16x8 vf = trpair(lds + 64 * KSTR + (16 * ks + rowl) * VSTR + (h * 128 + 32 * eb + coll) * 2, 8 * VSTR);
                acc[eb] = __builtin_amdgcn_mfma_f32_32x32x16_bf16(vf, kf, acc[eb], 0, 0, 0); }
        }
        float* o = KV + ((size_t)((b * 4 + h) * 128 + c) * 128) * 64 + 32 * dblk + r;
#pragma unroll
        for (int eb = 0; eb < 4; ++eb)
            { float* oq = o + (32 * eb + 4 * hh) * 64;
#pragma unroll
              for (int i = 0; i < 16; ++i) { *oq = acc[eb][i]; oq += ((i & 3) == 3 ? 5 : 1) * 64; asm volatile("" : "+v"(oq)); } }
        __syncthreads();
    }
}
DEV void ret_scan_phase(const float* __restrict__ KV, bf16_t* __restrict__ PREV, int vcu, int G, int tid) {
    for (int idx = vcu * NTHR + tid; idx < 16 * 8192; idx += G * NTHR) { const int bh = idx >> 13, ed = idx & 8191;
        const float cd = __builtin_amdgcn_exp2f(64.f * lg2gamma(bh & 3)); float st = 0.f;
        const float* kv = KV + (size_t)bh * 128 * 8192 + ed; bf16_t* pv = PREV + (size_t)bh * 128 * 8192 + ed;
#pragma unroll 8
        for (int c = 0; c < 128; ++c) { const float x = kv[(size_t)c * 8192]; pv[(size_t)c * 8192] = f2bf(st); st = st * cd + x; }
    }
}
DEV void ret_out_phase(LAS unsigned char* lds, const bf16_t* __restrict__ HP, const bf16_t* __restrict__ PREV, const float* __restrict__ gng, const float* __restrict__ gnb, bf16_t* __restrict__ MC, int vcu, int G, int tid) {
    constexpr int KSTR = 528;
    const int lane = tid & 63, wave = __builtin_amdgcn_readfirstlane(tid >> 6), h = wave >> 1, lb = wave & 1, r = lane & 31, hh = lane >> 5, p15 = lane & 15, g4 = lane >> 4;
    const float lg = lg2gamma(h);
    const int vlane = 64 * KSTR + (4 * hh + (p15 >> 2)) * VSTR + (h * 128 + 16 * (g4 & 1) + 4 * (p15 & 3)) * 2;
    for (int u = vcu; u < BATCH * 128; u += G) { const int b = u >> 7, c = u & 127; const size_t tok0 = (size_t)b * SEQ + 64 * c;
        stage_kv<KSTR, false>(lds, HP, tok0, tid);
        bf16x8 qf[4];
        { const bf16_t* qp = HP + (tok0 + 32 * lb + r) * IN_ODD + h * 64 + hh * 8;
#pragma unroll
          for (int ds = 0; ds < 4; ++ds) qf[ds] = *(const bf16x8*)(qp + 16 * ds); }
        f32x16 acc[4];
        { const bf16_t* pp = PREV + ((size_t)((b * 4 + h) * 128 + c) * 128 + r) * 64 + hh * 8;
#pragma unroll
          for (int eb = 0; eb < 4; ++eb) {
#pragma unroll
              for (int i = 0; i < 16; ++i) acc[eb][i] = 0.f;
#pragma unroll
              for (int ds = 0; ds < 4; ++ds) { const bf16x8 pf = *(const bf16x8*)(pp + (size_t)(32 * eb) * 64 + 16 * ds); acc[eb] = __builtin_amdgcn_mfma_f32_32x32x16_bf16(qf[ds], pf, acc[eb], 0, 0, 0); } } }
#pragma unroll
        for (int i = 0; i < 16; ++i) { const float qd = __builtin_amdgcn_exp2f((float)(32 * lb + crow(i, hh) + 1) * lg);
#pragma unroll
            for (int eb = 0; eb < 4; ++eb) acc[eb][i] *= qd; }
        __syncthreads();
        for (int mb = 0; mb <= lb; ++mb) {
            f32x16 s;
#pragma unroll
            for (int i = 0; i < 16; ++i) s[i] = 0.f;
#pragma unroll
            for (int ds = 0; ds < 4; ++ds) { const bf16x8 kf = *(const LAS bf16x8*)(lds + (32 * mb + r) * KSTR + (h * 64 + 16 * ds + 8 * hh) * 2); s = __builtin_amdgcn_mfma_f32_32x32x16_bf16(kf, qf[ds], s, 0, 0, 0); }
            const int dbase = 32 * lb + r - 32 * mb - 4 * hh;
#pragma unroll
            for (int i = 0; i < 16; ++i) { const int df = dbase - ((i & 3) + 8 * (i >> 2)); const float w = 0.125f * __builtin_amdgcn_exp2f((float)df * lg); s[i] = df >= 0 ? s[i] * w : 0.f; }
#pragma unroll
            for (int sx = 0; sx < 2; ++sx) { u32x4 w; w.x = pk2(s[8 * sx + 0], s[8 * sx + 1]); w.y = pk2(s[8 * sx + 2], s[8 * sx + 3]); w.z = pk2(s[8 * sx + 4], s[8 * sx + 5]); w.w = pk2(s[8 * sx + 6], s[8 * sx + 7]);
                const bf16x8 pa = __builtin_bit_cast(bf16x8, w);
#pragma unroll
                for (int eb = 0; eb < 4; ++eb) { const bf16x8 vf = trpair(lds + vlane + (32 * mb + 16 * sx) * VSTR + eb * 64, 8 * VSTR); acc[eb] = __builtin_amdgcn_mfma_f32_32x32x16_bf16(pa, vf, acc[eb], 0, 0, 0); } }
        }
        float mu[16], rs[16];
#pragma unroll
        for (int i = 0; i < 16; ++i) { float s1 = (acc[0][i] + acc[1][i]) + (acc[2][i] + acc[3][i]);
#pragma unroll
            for (int o = 1; o < 32; o <<= 1) s1 += __shfl_xor(s1, o);
            const float m = s1 * (1.f / 128.f); float s2 = 0.f;
#pragma unroll
            for (int eb = 0; eb < 4; ++eb) { const float d = acc[eb][i] - m; s2 += d * d; }
#pragma unroll
            for (int o = 1; o < 32; o <<= 1) s2 += __shfl_xor(s2, o);
            mu[i] = m; rs[i] = rsqrtf(s2 * (1.f / 128.f) + LN_EPS); }
        const bf16_t* gp = HP + tok0 * IN_ODD + 1024; bf16_t* mp = MC + tok0 * DM;
#pragma unroll
        for (int eb = 0; eb < 4; ++eb) { const int col = h * 128 + 32 * eb + r; const float gg = gng[col], bb = gnb[col];
            const bf16_t* gq = gp + (32 * lb + 4 * hh) * IN_ODD + col; bf16_t* mq = mp + (32 * lb + 4 * hh) * DM + col;
#pragma unroll
            for (int i = 0; i < 16; ++i) { const float gt = bf2f(*gq);
                const float y = (acc[eb][i] - mu[i]) * rs[i] * gg + bb; *mq = f2bf(y * pg8::e_silu(gt));
                const int step = (i & 3) == 3 ? 5 : 1; gq += step * IN_ODD; mq += step * DM; asm volatile("" : "+v"(gq), "+v"(mq)); } }
        __syncthreads();
    }
}

DEV void sgu_phase(LAS unsigned char* lds, const bf16_t* __restrict__ HP, const bf16_t* __restrict__ WSB, const float* __restrict__ lng, const float* __restrict__ lnb, const float* __restrict__ bs, bf16_t* __restrict__ MC, int vcu, int G, int tid) {
    constexpr int TSTR = 320, TOFF = 1024;
    const int lane = tid & 63, wave = __builtin_amdgcn_readfirstlane(tid >> 6), r = lane & 31, hh = lane >> 5, p15 = lane & 15, g4 = lane >> 4;
    LAS float* stats = (LAS float*)lds;
    const int cb = wave & 3, whalf = wave >> 2;
    for (int u = vcu; u < MTOK / 128; u += G) { const size_t tok0 = (size_t)u * 128;
        const bf16_t* up = HP + tok0 * IN_ODD + 1536; bf16_t* mp = MC + tok0 * DM + 512;
        for (int i = 0; i < 16; ++i) { const int row = 16 * wave + i; const u32x4 v = *(const u32x4*)(HP + (tok0 + row) * IN_ODD + 2048 + lane * 8);
            float x[8] = {__uint_as_float(v.x << 16), __uint_as_float(v.x & 0xffff0000u), __uint_as_float(v.y << 16), __uint_as_float(v.y & 0xffff0000u), __uint_as_float(v.z << 16), __uint_as_float(v.z & 0xffff0000u), __uint_as_float(v.w << 16), __uint_as_float(v.w & 0xffff0000u)};
            float s1 = 0.f;
#pragma unroll
            for (int j = 0; j < 8; ++j) s1 += x[j];
            const float m = wave_sum(s1) * (1.f / 512.f); float s2 = 0.f;
#pragma unroll
            for (int j = 0; j < 8; ++j) { const float d = x[j] - m; s2 += d * d; }
            const float rstd = rsqrtf(wave_sum(s2) * (1.f / 512.f) + LN_EPS);
            if (lane == 0) { stats[2 * row] = m; stats[2 * row + 1] = rstd; } }
        __syncthreads();
        for (int g = 0; g < 4; ++g) {
#pragma unroll
            for (int i = 0; i < 4; ++i) { const int ck = tid + NTHR * i, row = ck >> 4, cc = ck & 15; const int ch = g * 128 + cc * 8;
                const u32x4 v = *(const u32x4*)(HP + (tok0 + row) * IN_ODD + 2048 + ch);
                const float m = stats[2 * row], rstd = stats[2 * row + 1];
                const f32x4 g0 = *(const f32x4*)(lng + ch), g1 = *(const f32x4*)(lng + ch + 4), b0 = *(const f32x4*)(lnb + ch), b1 = *(const f32x4*)(lnb + ch + 4);
                u32x4 w;
                w.x = pk2((__uint_as_float(v.x << 16) - m) * rstd * g0.x + b0.x, (__uint_as_float(v.x & 0xffff0000u) - m) * rstd * g0.y + b0.y);
                w.y = pk2((__uint_as_float(v.y << 16) - m) * rstd * g0.z + b0.z, (__uint_as_float(v.y & 0xffff0000u) - m) * rstd * g0.w + b0.w);
                w.z = pk2((__uint_as_float(v.z << 16) - m) * rstd * g1.x + b1.x, (__uint_as_float(v.z & 0xffff0000u) - m) * rstd * g1.y + b1.y);
                w.w = pk2((__uint_as_float(v.w << 16) - m) * rstd * g1.z + b1.z, (__uint_as_float(v.w & 0xffff0000u) - m) * rstd * g1.w + b1.w);
                *(LAS u32x4*)(lds + TOFF + row * TSTR + cc * 16) = w; }
            __syncthreads();
#pragma unroll
            for (int j = 0; j < 2; ++j) { const int tb = whalf == 0 ? (j == 0 ? 0 : 3) : (j == 0 ? 1 : 2);
                f32x16 acc;
#pragma unroll
                for (int i = 0; i < 16; ++i) acc[i] = 0.f;
                const bf16_t* wp = WSB + ((size_t)g * 128 + 32 * tb + r) * 128 + hh * 8;
                for (int ks = 0; ks < 2 * (tb + 1); ++ks) {
                    const bf16x8 wf = *(const bf16x8*)(wp + 16 * ks);
                    const bf16x8 vf = trpair(lds + TOFF + (16 * ks + 8 * hh + (p15 >> 2)) * TSTR + (32 * cb + 16 * (g4 & 1) + 4 * (p15 & 3)) * 2, 4 * TSTR);
                    acc = __builtin_amdgcn_mfma_f32_32x32x16_bf16(wf, vf, acc, 0, 0, 0);
                }
                const int col = g * 128 + 32 * cb + r;
                const bf16_t* uq = up + (32 * tb + 4 * hh) * IN_ODD + col; bf16_t* mq = mp + (32 * tb + 4 * hh) * DM + col; const float* bq = bs + g * 128 + 32 * tb + 4 * hh;
#pragma unroll
                for (int i = 0; i < 16; ++i) { const float uu = bf2f(*uq); *mq = f2bf(uu * (acc[i] + *bq));
                    const int step = (i & 3) == 3 ? 5 : 1; uq += step * IN_ODD; mq += step * DM; bq += step; asm volatile("" : "+v"(uq), "+v"(mq), "+v"(bq)); }
            }
            __syncthreads();
        }
    }
}
}

__global__ void __launch_bounds__(NTHR, 2) mk_fwd(Args a) {
    extern __shared__ __attribute__((aligned(16))) unsigned char lds_raw[];
    LAS unsigned char* lds = (LAS unsigned char*)lds_raw;
    cg::grid_group grid = cg::this_grid();
    for (int ph = a.ph_lo; ph < a.ph_hi; ++ph) {
        int tid = threadIdx.x; asm volatile("" : "+v"(tid));
        kptr_t kp = (kptr_t)__builtin_amdgcn_kernarg_segment_ptr(); asm volatile("" : "+s"(kp));
        unsigned char* ws = kws(kp);
        const int lane = tid & 63, wave = __builtin_amdgcn_readfirstlane(tid >> 6);
        const int G = gridDim.x, bx = blockIdx.x;
        const int vcu = (G % 8 == 0) ? (bx % 8) * (G / 8) + bx / 8 : bx;
        const int gw = vcu * NWAVES + wave, NGW = G * NWAVES;
        bf16_t* XB = (bf16_t*)(ws + WS_XB); bf16_t* HP = (bf16_t*)(ws + WS_HP); bf16_t* MC = (bf16_t*)(ws + WS_MC); float* Y = (float*)(ws + WS_Y); float* XF = kout(kp);
        const int L = ph >= 8 ? 1 : 0;
        switch (ph) {
        case 0: p0_prologue(kp, lds, gw, NGW, wave, lane); break;
        case 1: case 8: {
            const int N = L ? IN_ODD : IN_EVEN;
            pg8::Gemm g{XB, (const bf16_t*)(ws + (L ? WS_WINO : WS_WINE)), MTOK, N, DM}; pg8::StaticOrder S; S.init(MTOK, N, G, bx);
            pg8::EpiBf16G E{HP, N, L ? 6 : (1 << 30)};
            pg8::gemm_phase<pg8::EpiBf16G, pg8::StaticOrder, true, true>(lds, g, S, E, tid);
        } break;
        case 3: case 12: case 6: case 15: {
            const bool dn = (ph == 6 || ph == 15);
            const bf16_t* A = dn ? HP : MC; const int K = dn ? DFF : DM;
            const bf16_t* Bt = (const bf16_t*)(ws + (dn ? (L ? WS_WDN1 : WS_WDN0) : (L ? WS_WOUTO : WS_WOUTE)));
            const float* R = (ph == 3) ? kin(kp, 0) : XF;
            pg8::Gemm g{A, Bt, MTOK, DM, K}; pg8::StaticOrder S; S.init(MTOK, DM, G, bx);
            pg8::EpiResid E{R, Y, DM, ALPHA};
            pg8::gemm_phase<pg8::EpiResid, pg8::StaticOrder, true, true>(lds, g, S, E, tid);
        } break;
        case 4: case 7: case 13: case 16: {
            const bool ffn = (ph == 7 || ph == 16);
            ln_phase(Y, kin(kp, ffn ? 22 : 17) + L * DM, kin(kp, ffn ? 23 : 18) + L * DM, XF, XB, gw, NGW, lane);
        } break;
        case 5: case 14: {
            pg8::Gemm g{XB, (const bf16_t*)(ws + (L ? WS_WGU1 : WS_WGU0)), MTOK, 2 * DFF, DM}; pg8::StaticOrder S; S.init(MTOK, 2 * DFF, G, bx);
            pg8::EpiSwiglu E{HP, DFF};
            pg8::gemm_phase<pg8::EpiSwiglu, pg8::StaticOrder, true, true>(lds, g, S, E, tid);
        } break;
        case 2: att::attn_phase(lds, kp, HP, MC, vcu, G, tid); break;
        case 9: mix1::ret_kv_phase(lds, HP, (float*)(ws + WS_Y), vcu, G, tid);
                mix1::sgu_phase(lds, HP, (const bf16_t*)(ws + WS_SGUW), kin(kp, 12), kin(kp, 13), kin(kp, 15), MC, vcu, G, tid); break;
        case 10: mix1::ret_scan_phase((const float*)(ws + WS_Y), (bf16_t*)(ws + WS_Y + 64 * MiB), vcu, G, tid); break;
        case 11: mix1::ret_out_phase(lds, HP, (const bf16_t*)(ws + WS_Y + 64 * MiB), kin(kp, 10), kin(kp, 11), MC, vcu, G, tid); break;
        default: break;
        }
        if (ph + 1 < a.ph_hi) grid.sync();
    }
}
extern "C" void kernel_launch(void* const* d_in, const int* in_sizes, int n_in, void* d_out, int out_size, void* d_ws, size_t ws_size, hipStream_t stream) {
    static int grid = 0;
    if (grid == 0) {
        if (n_in != 24 || ws_size < WS_END || out_size != MTOK * DM) { fprintf(stderr, "kernel_launch: unexpected shapes (n_in %d ws %zu out %d)\n", n_in, ws_size, out_size); grid = -1; return; }
        int dev = 0, cus = 0, per_cu = 0;
        hipGetDevice(&dev); hipDeviceGetAttribute(&cus, hipDeviceAttributeMultiprocessorCount, dev);
        if (hipFuncSetAttribute((const void*)mk_fwd, hipFuncAttributeMaxDynamicSharedMemorySize, LDS_BYTES) != hipSuccess) { fprintf(stderr, "hipFuncSetAttribute failed\n"); grid = -1; return; }
        hipOccupancyMaxActiveBlocksPerMultiprocessor(&per_cu, (const void*)mk_fwd, NTHR, LDS_BYTES);
        if (per_cu < 1) { fprintf(stderr, "occupancy query says %d blocks/CU\n", per_cu); }
        (void)hipGetLastError();
        grid = cus;
    }
    if (grid < 0) return;
    const float* const* in = (const float* const*)d_in;
    unsigned char* ws = (unsigned char*)d_ws;
    bf16_t* HP = (bf16_t*)(ws + WS_HP); bf16_t* MC = (bf16_t*)(ws + WS_MC); float* Y = (float*)(ws + WS_Y);
    Args a{};
    for (int i = 0; i < 24; ++i) a.in[i] = in[i];
    a.out = (float*)d_out; a.ws = ws;
    auto run = [&](int lo, int hi) { a.ph_lo = lo; a.ph_hi = hi; hipLaunchKernelGGL(mk_fwd, dim3(grid), dim3(NTHR), LDS_BYTES, stream, a); };
    for (int ph = 0; ph < NPHASE; ++ph) run(ph, ph + 1);
}
```

```cpp
#include <hip/hip_runtime.h>
#include <cstdio>
#include <cstdint>

typedef unsigned short bf16_t;
#define DEV __device__ __forceinline__

constexpr int BATCH = 4, SEQ = 8192, DM = 1024, MTOK = BATCH * SEQ;
constexpr int IN_EVEN = 3072, IN_ODD = 2560, DFF = 2816;
constexpr float ALPHA = 1.4142135623730951f, LN_EPS = 1e-5f;

constexpr size_t MiB = 1u << 20;
constexpr size_t WS_CTL = 0;
constexpr size_t WS_WINE = 1 * MiB;
constexpr size_t WS_WOUTE = 7 * MiB;
constexpr size_t WS_WINO = 9 * MiB;
constexpr size_t WS_WOUTO = 14 * MiB;
constexpr size_t WS_WGU0 = 16 * MiB;
constexpr size_t WS_WDN0 = 27 * MiB;
constexpr size_t WS_WGU1 = 33 * MiB;
constexpr size_t WS_WDN1 = 44 * MiB;
constexpr size_t WS_SGUW = 50 * MiB;
constexpr size_t WS_XB = 52 * MiB;
constexpr size_t WS_HP = 116 * MiB;
constexpr size_t WS_MC = 308 * MiB;
constexpr size_t WS_Y = 372 * MiB;
constexpr size_t WS_END = 500 * MiB;

DEV float bf2f(bf16_t v) { return __uint_as_float(((unsigned)v) << 16); }
DEV bf16_t f2bf(float f) { unsigned u = __float_as_uint(f); return (bf16_t)((u + 0x7fffu + ((u >> 16) & 1u)) >> 16); }
DEV float gelu_tanh(float x) { const float u = 0.7978845608028654f * (x + 0.044715f * x * x * x); return x / (1.f + __expf(-2.f * u)); }
DEV float silu(float x) { return x / (1.f + __expf(-x)); }

__global__ void __launch_bounds__(256) nv_wt(const float* W, int K, int N, bf16_t* WT, int mode) {
    __shared__ float t[32][33];
    const int n0 = blockIdx.x * 32, k0 = blockIdx.y * 32, tx = threadIdx.x & 31, ty = threadIdx.x >> 5;
    for (int i = ty; i < 32; i += 8) t[i][tx] = W[(size_t)(k0 + i) * N + n0 + tx];
    __syncthreads();
    for (int i = ty; i < 32; i += 8) { const int n = n0 + i; const int r = mode == 0 ? n : (256 * (n >> 7) + (n & 127) + (mode == 2 ? 128 : 0));
        WT[(size_t)r * K + k0 + tx] = f2bf(t[tx][i]); }
}
__global__ void __launch_bounds__(256) nv_cvt(const float* x, bf16_t* o, size_t n) {
    size_t i = (size_t)blockIdx.x * 256 + threadIdx.x; const size_t st = (size_t)gridDim.x * 256;
    for (; i < n; i += st) o[i] = f2bf(x[i]);
}
struct GE { int mode; bf16_t* outb; float* outf; const float* resid; int ldc; int gelu_from; };
__global__ void __launch_bounds__(256) nv_gemm(const bf16_t* A, const bf16_t* Bt, int K, GE e) {
    __shared__ float As[64][33], Bs[64][33], Bs2[64][33];
    const int tid = threadIdx.x, tx = tid & 15, ty = tid >> 4, row0 = blockIdx.y * 64, col0 = blockIdx.x * 64;
    const bool dual = e.mode == 1;
    float acc[4][4], acc2[4][4];
#pragma unroll
    for (int i = 0; i < 4; ++i)
#pragma unroll
        for (int j = 0; j < 4; ++j) { acc[i][j] = 0.f; acc2[i][j] = 0.f; }
    for (int k0 = 0; k0 < K; k0 += 32) {
        for (int i = tid; i < 2048; i += 256) { const int r = i >> 5, c = i & 31;
            As[r][c] = bf2f(A[(size_t)(row0 + r) * K + k0 + c]);
            const int col = col0 + r, br = dual ? (256 * (col >> 7) + (col & 127)) : col;
            Bs[r][c] = bf2f(Bt[(size_t)br * K + k0 + c]);
            if (dual) Bs2[r][c] = bf2f(Bt[(size_t)(br + 128) * K + k0 + c]); }
        __syncthreads();
#pragma unroll 4
        for (int kk = 0; kk < 32; ++kk) {
            float a[4], b[4], b2[4];
#pragma unroll
            for (int i = 0; i < 4; ++i) { a[i] = As[ty * 4 + i][kk]; b[i] = Bs[tx * 4 + i][kk]; b2[i] = dual ? Bs2[tx * 4 + i][kk] : 0.f; }
#pragma unroll
            for (int i = 0; i < 4; ++i)
#pragma unroll
                for (int j = 0; j < 4; ++j) { acc[i][j] += a[i] * b[j]; acc2[i][j] += a[i] * b2[j]; }
        }
        __syncthreads();
    }
#pragma unroll
    for (int i = 0; i < 4; ++i)
#pragma unroll
        for (int j = 0; j < 4; ++j) {
            const int r = row0 + ty * 4 + i, c = col0 + tx * 4 + j; const size_t o = (size_t)r * e.ldc + c;
            if (e.mode == 0) { float v = acc[i][j]; if (c >= e.gelu_from) v = gelu_tanh(v); e.outb[o] = f2bf(v); }
            else if (e.mode == 1) { e.outb[o] = f2bf(silu(acc[i][j]) * acc2[i][j]); }
            else { e.outf[o] = ALPHA * e.resid[o] + acc[i][j]; }
        }
}
__global__ void __launch_bounds__(256) nv_ln(const float* Y, const float* g, const float* b, float* XF, bf16_t* XB) {
    const int row = blockIdx.x * 4 + (threadIdx.x >> 6), lane = threadIdx.x & 63;
    const float* y = Y + (size_t)row * DM; float v[16]; float s = 0.f;
#pragma unroll
    for (int j = 0; j < 16; ++j) { v[j] = y[lane + 64 * j]; s += v[j]; }
#pragma unroll
    for (int o = 1; o < 64; o <<= 1) s += __shfl_xor(s, o);
    const float mean = s * (1.f / DM); float q = 0.f;
#pragma unroll
    for (int j = 0; j < 16; ++j) { v[j] -= mean; q += v[j] * v[j]; }
#pragma unroll
    for (int o = 1; o < 64; o <<= 1) q += __shfl_xor(q, o);
    const float rstd = rsqrtf(q * (1.f / DM) + LN_EPS);
#pragma unroll
    for (int j = 0; j < 16; ++j) { const int c = lane + 64 * j; const float o = v[j] * rstd * g[c] + b[c]; XF[(size_t)row * DM + c] = o; XB[(size_t)row * DM + c] = f2bf(o); }
}
template <int MODE, int DVS> __global__ void __launch_bounds__(256) nv_attn(const bf16_t* HP, float* OT, bf16_t* MC, const float* relb) {
    const int tid = threadIdx.x, qi = tid & 63, es = tid >> 6, c = blockIdx.x;
    int b, h, m = 0;
    if (MODE == 0) { m = blockIdx.y & 1; h = (blockIdx.y >> 1) & 3; b = blockIdx.y >> 3; } else { h = blockIdx.y & 7; b = blockIdx.y >> 3; }
    const int tq = c * 64 + qi;
    const bf16_t* base = HP + (size_t)b * SEQ * IN_EVEN;
    int qcol, kcol, vcol;
    if (MODE == 0) { qcol = h * 128 + m * 64; kcol = 512 + h * 128 + m * 64; vcol = 1024 + h * 128 + es * DVS; }
    else { qcol = 1536 + h * 64; kcol = 2048 + h * 64; vcol = 2560 + h * 64 + es * DVS; }
    float q[64];
#pragma unroll
    for (int d = 0; d < 64; ++d) q[d] = bf2f(base[(size_t)tq * IN_EVEN + qcol + d]) * 0.125f;
    float o[DVS];
#pragma unroll
    for (int e = 0; e < DVS; ++e) o[e] = 0.f;
    float mx = -1e30f, l = 0.f;
    const int k_lo = MODE == 0 ? 0 : ((c - 8) * 64 > 0 ? (c - 8) * 64 : 0), k_hi = (c + 1) * 64;
    const float slope = exp2f(-2.0f * (float)(h + 1));
    for (int key = k_lo; key < k_hi; ++key) {
        const bf16_t* kr = base + (size_t)key * IN_EVEN + kcol;
        float s = 0.f;
#pragma unroll
        for (int d = 0; d < 64; ++d) s += q[d] * bf2f(kr[d]);
        if (MODE == 0) s -= slope * fabsf((float)(tq - key));
        else { int rel = tq - key; rel = rel < -128 ? -128 : (rel > 128 ? 128 : rel); s += relb[h * 257 + rel + 128]; }
        if (s > mx) { const float f = expf(mx - s); l *= f;
#pragma unroll
            for (int e = 0; e < DVS; ++e) o[e] *= f;
            mx = s; }
        const float p = expf(s - mx); l += p;
        const bf16_t* vr = base + (size_t)key * IN_EVEN + vcol;
#pragma unroll
        for (int e = 0; e < DVS; ++e) o[e] += p * bf2f(vr[e]);
    }
    const float inv = 1.f / l; const size_t tok = (size_t)b * SEQ + tq;
#pragma unroll
    for (int e = 0; e < DVS; ++e) {
        if (MODE == 0) OT[((size_t)m * MTOK + tok) * 512 + h * 128 + es * DVS + e] = o[e] * inv;
        else MC[tok * DM + 512 + h * 64 + es * DVS + e] = f2bf(o[e] * inv);
    }
}
__global__ void __launch_bounds__(256) nv_diff_combine(const float* OT, const float* lq1, const float* lk1, const float* lq2, const float* lk2, const float* g, bf16_t* MC) {
    const int i = blockIdx.x * 256 + threadIdx.x; const int tok = i >> 2, h = i & 3;
    float s1 = 0.f, s2 = 0.f;
    for (int d = 0; d < 64; ++d) { s1 += lq1[d] * lk1[d]; s2 += lq2[d] * lk2[d]; }
    const float lam = expf(s1) - expf(s2) + 0.2f;
    const float* o1 = OT + (size_t)tok * 512 + h * 128; const float* o2 = o1 + (size_t)MTOK * 512;
    float ss = 0.f;
    for (int e = 0; e < 128; ++e) { const float d = o1[e] - lam * o2[e]; ss += d * d; }
    const float r = rsqrtf(ss * (1.f / 128.f) + LN_EPS) * 0.8f;
    for (int e = 0; e < 128; ++e) { const float d = o1[e] - lam * o2[e]; MC[(size_t)tok * DM + h * 128 + e] = f2bf(d * r * g[e]); }
}
__global__ void __launch_bounds__(128) nv_ret(const bf16_t* HP, float* OT) {
    const int b = blockIdx.x >> 2, h = blockIdx.x & 3, e = threadIdx.x;
    const float gamma = 1.f - exp2f(-5.f - (float)h);
    float S[64];
#pragma unroll
    for (int d = 0; d < 64; ++d) S[d] = 0.f;
    for (int t = 0; t < SEQ; ++t) {
        const bf16_t* row = HP + ((size_t)b * SEQ + t) * IN_ODD;
        const float v = bf2f(row[512 + h * 128 + e]); float o = 0.f;
#pragma unroll
        for (int d = 0; d < 64; ++d) { const float kd = bf2f(row[256 + h * 64 + d]) * 0.125f; S[d] = gamma * S[d] + kd * v; o += bf2f(row[h * 64 + d]) * S[d]; }
        OT[((size_t)b * SEQ + t) * 512 + h * 128 + e] = o;
    }
}
__global__ void __launch_bounds__(256) nv_gn_gate(const float* OT, const bf16_t* HP, const float* g, const float* bb, bf16_t* MC) {
    const int i = blockIdx.x * 256 + threadIdx.x; const int tok = i >> 2, h = i & 3;
    const float* o = OT + (size_t)tok * 512 + h * 128; float s = 0.f;
    for (int e = 0; e < 128; ++e) s += o[e];
    const float mu = s * (1.f / 128.f); float q = 0.f;
    for (int e = 0; e < 128; ++e) { const float d = o[e] - mu; q += d * d; }
    const float r = rsqrtf(q * (1.f / 128.f) + LN_EPS);
    for (int e = 0; e < 128; ++e) { const int c = h * 128 + e; const float y = (o[e] - mu) * r * g[c] + bb[c]; const float gt = bf2f(HP[(size_t)tok * IN_ODD + 1024 + c]);
        MC[(size_t)tok * DM + c] = f2bf(y * silu(gt)); }
}
__global__ void __launch_bounds__(256) nv_sgu_ln(const bf16_t* HP, const float* g, const float* bb, float* VN) {
    const int tok = blockIdx.x * 256 + threadIdx.x; const bf16_t* v = HP + (size_t)tok * IN_ODD + 2048; float s = 0.f;
    for (int c = 0; c < 512; ++c) s += bf2f(v[c]);
    const float mu = s * (1.f / 512.f); float q = 0.f;
    for (int c = 0; c < 512; ++c) { const float d = bf2f(v[c]) - mu; q += d * d; }
    const float r = rsqrtf(q * (1.f / 512.f) + LN_EPS);
    for (int c = 0; c < 512; ++c) VN[(size_t)tok * 512 + c] = (bf2f(v[c]) - mu) * r * g[c] + bb[c];
}
__global__ void __launch_bounds__(256) nv_sgu_mix(const float* VN, const bf16_t* HP, const float* W, const float* bs, bf16_t* MC) {
    const int chunk = blockIdx.x, g = blockIdx.y, c = threadIdx.x & 127, th = threadIdx.x >> 7;
    for (int t = th * 64; t < th * 64 + 64; ++t) {
        float acc = 0.f; const float* w = W + ((size_t)g * 128 + t) * 128;
        for (int s = 0; s <= t; ++s) acc += w[s] * VN[((size_t)chunk * 128 + s) * 512 + g * 128 + c];
        const size_t tok = (size_t)chunk * 128 + t; const float u = bf2f(HP[tok * IN_ODD + 1536 + g * 128 + c]);
        MC[tok * DM + 512 + g * 128 + c] = f2bf(u * (acc + bs[g * 128 + t]));
    }
}

namespace pg8 {
#define PG8_LAS __attribute__((address_space(3)))
typedef unsigned short bf16_t;
typedef short bf16x8 __attribute__((ext_vector_type(8)));
typedef float f32x4 __attribute__((ext_vector_type(4)));
typedef unsigned u32x4 __attribute__((ext_vector_type(4)));
constexpr int BM = 256, BK = 64, HALF = 128, HTB = HALF * BK * 2  , STAGE_BYTES = 8 * HTB, NXCD = 8, WGM = 8;

__host__ __device__ __forceinline__ int lds_byte(int r, int c) { const int st = (r >> 4) * 2 + (c >> 5), rr = r & 15, cc = c & 31, ob = rr * 64 + cc * 2; return st * 1024 + (ob ^ (((ob >> 9) & 1) << 5)); }
__host__ __device__ __forceinline__ void stage_rc(int b, int& R, int& C) { const int st = b / 1024, sb = b % 1024, swz = sb ^ (((sb >> 9) & 1) << 5); R = (st >> 1) * 16 + swz / 64; C = (st & 1) * 32 + (swz % 64) / 2; }
__host__ __device__ __forceinline__ int perm32(int rho) { const int n = rho >> 4, i = rho & 15; return 8 * (i >> 2) + 4 * n + (i & 3); }

struct Unit { int pm, pn; };
struct Gemm { const bf16_t* A; const bf16_t* Bt; int M, N, K; };

struct StaticOrder {
    int nM, nN, nwg, G, c;
    __host__ __device__ void init(int M, int N, int G_, int c_) { nM = M / BM; nN = N / BM; nwg = nM * nN; G = G_; c = c_; }
    __host__ __device__ bool next(int i, Unit& u) const {
        const long L = (long)i * G + c; if (L >= nwg) return false;
        int wgid = (int)L; { const int q = nwg / NXCD, r = nwg % NXCD, xcd = wgid % NXCD, off = wgid / NXCD; wgid = (xcd < r ? xcd * (q + 1) : r * (q + 1) + (xcd - r) * q) + off; }
        const int nig = WGM * nN, gid = wgid / nig, fm = gid * WGM, gsz = (nM - fm) < WGM ? (nM - fm) : WGM;
        u.pm = fm + ((wgid % nig) % gsz); u.pn = (wgid % nig) / gsz; return true;
    }
    __device__ __forceinline__ void a_ready(const Unit&) const {}
    __device__ __forceinline__ void done(const Unit&) const {}
};

__device__ __forceinline__ unsigned cvt_pk_bf16(float lo, float hi) { unsigned r; asm volatile("v_cvt_pk_bf16_f32 %0, %1, %2" : "=v"(r) : "v"(lo), "v"(hi)); return r; }
__device__ __forceinline__ float e_gelu(float x) { const float u = 0.7978845608028654f * (x + 0.044715f * x * x * x); return x * __builtin_amdgcn_rcpf(1.f + __builtin_amdgcn_exp2f(-2.885390081777927f * u)); }
__device__ __forceinline__ float e_silu(float x) { return x * __builtin_amdgcn_rcpf(1.f + __builtin_amdgcn_exp2f(-1.4426950408889634f * x)); }
struct EpiBf16G {
    static constexpr bool PERM = true, AFTER_DRAIN = false;
    bf16_t* O; int ldc; int gelu_from_tile;
    __device__ __forceinline__ void operator()(const f32x4 (&acc)[2][2][4][2], const Unit& u, int wr, int wc, int fr, int fq) const {
        const int row0 = u.pm * BM + wr * 64 + fr, col0 = u.pn * BM + wc * 32 + 8 * fq; const bool g = u.pn >= gelu_from_tile;
#pragma unroll
        for (int ai = 0; ai < 2; ++ai)
#pragma unroll
            for (int m = 0; m < 4; ++m) { bf16_t* rowp = O + (size_t)(row0 + ai * HALF + m * 16) * ldc + col0;
#pragma unroll
                for (int bj = 0; bj < 2; ++bj) { f32x4 v0 = acc[ai][bj][m][0], v1 = acc[ai][bj][m][1];
                    if (g) {
#pragma unroll
                        for (int i = 0; i < 4; ++i) { v0[i] = e_gelu(v0[i]); v1[i] = e_gelu(v1[i]); } }
                    u32x4 w; w.x = cvt_pk_bf16(v0[0], v0[1]); w.y = cvt_pk_bf16(v0[2], v0[3]); w.z = cvt_pk_bf16(v1[0], v1[1]); w.w = cvt_pk_bf16(v1[2], v1[3]);
                    *(u32x4*)(rowp + bj * HALF) = w; } }
    }
};
struct EpiSwiglu {
    static constexpr bool PERM = true, AFTER_DRAIN = false;
    bf16_t* O; int ldc;
    __device__ __forceinline__ void operator()(const f32x4 (&acc)[2][2][4][2], const Unit& u, int wr, int wc, int fr, int fq) const {
        const int row0 = u.pm * BM + wr * 64 + fr, col0 = u.pn * HALF + wc * 32 + 8 * fq;
#pragma unroll
        for (int ai = 0; ai < 2; ++ai)
#pragma unroll
            for (int m = 0; m < 4; ++m) { bf16_t* rowp = O + (size_t)(row0 + ai * HALF + m * 16) * ldc + col0;
                f32x4 h0, h1;
#pragma unroll
                for (int i = 0; i < 4; ++i) { h0[i] = e_silu(acc[ai][0][m][0][i]) * acc[ai][1][m][0][i]; h1[i] = e_silu(acc[ai][0][m][1][i]) * acc[ai][1][m][1][i]; }
                u32x4 w; w.x = cvt_pk_bf16(h0[0], h0[1]); w.y = cvt_pk_bf16(h0[2], h0[3]); w.z = cvt_pk_bf16(h1[0], h1[1]); w.w = cvt_pk_bf16(h1[2], h1[3]);
                *(u32x4*)rowp = w; }
    }
};
struct EpiResid {
    static constexpr bool PERM = false, AFTER_DRAIN = false;
    const float* R; float* Y; int ldc; float alpha;
    __device__ __forceinline__ void operator()(const f32x4 (&acc)[2][2][4][2], const Unit& u, int wr, int wc, int fr, int fq) const {
        const int row0 = u.pm * BM + wr * 64 + fr, col0 = u.pn * BM + wc * 32 + 4 * fq;
#pragma unroll
        for (int ai = 0; ai < 2; ++ai)
#pragma unroll
            for (int m = 0; m < 4; ++m) { const size_t off = (size_t)(row0 + ai * HALF + m * 16) * ldc + col0;
#pragma unroll
                for (int bj = 0; bj < 2; ++bj)
#pragma unroll
                    for (int n = 0; n < 2; ++n) { const f32x4 r = *(const f32x4*)(R + off + bj * HALF + n * 16); *(f32x4*)(Y + off + bj * HALF + n * 16) = r * alpha + acc[ai][bj][m][n]; }
                if (m & 1) asm volatile("" ::: "memory"); }
    }
};
template <class Epi, class Sched, bool ALIGN_EPI = false, bool SP2 = false>
__device__ __forceinline__ void gemm_phase(PG8_LAS unsigned char* lds, const Gemm g, const Sched& S, const Epi& E, const int tid) {
    const int wid = __builtin_amdgcn_readfirstlane(tid >> 6), lane = tid & 63, wr = wid >> 2, wc = wid & 3, fr = lane & 15, fq = lane >> 4;
    const int K = g.K, nt = K / BK;
    unsigned voffA[2], voffB[2];
#pragma unroll
    for (int i = 0; i < 2; ++i) { int R, C; stage_rc(tid * 16 + i * 8192, R, C); const int Rb = Epi::PERM ? ((R & ~31) + perm32(R & 31)) : R;
        voffA[i] = (unsigned)(R * K + C) * 2u; voffB[i] = (unsigned)(Rb * K + C) * 2u; }
    const size_t kstep = (size_t)(BK * 2);
    const size_t hstep = (size_t)HALF * K * 2;
    const size_t tstep = 2 * hstep;
    const unsigned ldsw = (unsigned)wid * 1024u;
    const int aoff = lds_byte(wr * 64 + fr, fq * 8), boff = lds_byte(wc * 32 + fr, fq * 8);
#define PG8_SA(b, h) (((b) * 2 + (h)) * HTB)
#define PG8_SB(b, h) ((4 + (b) * 2 + (h)) * HTB)
#define PG8_STAGE(bufoff, gbase, voff) do { _Pragma("unroll") for (int _i = 0; _i < 2; ++_i) \
        __builtin_amdgcn_global_load_lds((const unsigned*)((const char*)(gbase) + (voff)[_i]), (PG8_LAS unsigned*)(lds + (bufoff) + ldsw + _i * 8192), 16, 0, 0); } while (0)
#define PG8_LDA(dst, b, h) do { _Pragma("unroll") for (int m = 0; m < 4; ++m) _Pragma("unroll") for (int k = 0; k < 2; ++k) dst[m][k] = *(const PG8_LAS bf16x8*)(lds + PG8_SA(b, h) + aoff + m * 2048 + k * 1024); } while (0)
#define PG8_LDB(dst, b, h) do { _Pragma("unroll") for (int n = 0; n < 2; ++n) _Pragma("unroll") for (int k = 0; k < 2; ++k) dst[n][k] = *(const PG8_LAS bf16x8*)(lds + PG8_SB(b, h) + boff + n * 2048 + k * 1024); } while (0)
#define PG8_MMA(ai, bj, At, Bt) do { __builtin_amdgcn_s_setprio(1); _Pragma("unroll") for (int m = 0; m < 4; ++m) _Pragma("unroll") for (int n = 0; n < 2; ++n) _Pragma("unroll") for (int k = 0; k < 2; ++k) \
        acc[ai][bj][m][n] = __builtin_amdgcn_mfma_f32_16x16x32_bf16(Bt[n][k], At[m][k], acc[ai][bj][m][n], 0, 0, 0); __builtin_amdgcn_s_setprio(0); } while (0)
#define PG8_WAIT_V(n) asm volatile("s_waitcnt vmcnt(" #n ")" ::: "memory")
#define PG8_WAIT_L(n) asm volatile("s_waitcnt lgkmcnt(" #n ")" ::: "memory")
#define PG8_BAR __builtin_amdgcn_s_barrier()
#define PG8_SCHED __builtin_amdgcn_sched_barrier(0)
    Unit cur, nxt; int ui = 0;
    if (!S.next(0, cur)) return;
    f32x4 acc[2][2][4][2];
#pragma unroll
    for (int a = 0; a < 2; ++a)
#pragma unroll
        for (int b = 0; b < 2; ++b)
#pragma unroll
            for (int m = 0; m < 4; ++m)
#pragma unroll
                for (int n = 0; n < 2; ++n) acc[a][b][m][n] = (f32x4){0.f, 0.f, 0.f, 0.f};
    bf16x8 At[4][2], B0[2][2], B1[2][2];
    const char* cA = (const char*)g.A + (size_t)cur.pm * tstep; const char* cB = (const char*)g.Bt + (size_t)cur.pn * tstep;
    S.a_ready(cur);
    if constexpr (SP2) {
        PG8_STAGE(PG8_SB(0, 0), cB, voffB); PG8_STAGE(PG8_SB(0, 1), cB + hstep, voffB); PG8_STAGE(PG8_SA(0, 0), cA, voffA); PG8_STAGE(PG8_SA(0, 1), cA + hstep, voffA);
        if (wr == 1) PG8_BAR;
        PG8_WAIT_V(2); PG8_BAR;
        PG8_STAGE(PG8_SB(1, 0), cB + kstep, voffB); PG8_STAGE(PG8_SA(1, 0), cA + kstep, voffA); PG8_STAGE(PG8_SB(1, 1), cB + hstep + kstep, voffB);
        PG8_WAIT_V(6); PG8_BAR;
    } else {
        PG8_STAGE(PG8_SB(0, 0), cB, voffB); PG8_STAGE(PG8_SA(0, 0), cA, voffA); PG8_STAGE(PG8_SB(0, 1), cB + hstep, voffB); PG8_STAGE(PG8_SA(0, 1), cA + hstep, voffA);
        if (wr == 1) PG8_BAR;
        PG8_WAIT_V(4); PG8_BAR;
        PG8_STAGE(PG8_SB(1, 0), cB + kstep, voffB); PG8_STAGE(PG8_SA(1, 0), cA + kstep, voffA); PG8_STAGE(PG8_SB(1, 1), cB + hstep + kstep, voffB);
        PG8_WAIT_V(6); PG8_BAR;
    }
    for (;;) {
        const bool has_next = S.next(ui + 1, nxt);
        const char* nA = has_next ? (const char*)g.A + (size_t)nxt.pm * tstep : cA; const char* nB = has_next ? (const char*)g.Bt + (size_t)nxt.pn * tstep : cB;
        for (int t = 0; t < nt; t += 2) {
            const bool last = (t == nt - 2);
            const char* a1 = cA + (size_t)(t + 1) * kstep;
            const char* a2 = last ? nA : cA + (size_t)(t + 2) * kstep; const char* b2 = last ? nB : cB + (size_t)(t + 2) * kstep;
            const char* a3 = a2 + kstep; const char* b3 = b2 + kstep;
            if (last && has_next) S.a_ready(nxt);
            if constexpr (SP2) {
            PG8_LDB(B0, 0, 0); PG8_LDB(B1, 0, 1); PG8_SCHED; PG8_LDA(At, 0, 0); PG8_STAGE(PG8_SA(1, 1), a1 + hstep, voffA);
            PG8_WAIT_V(8); PG8_WAIT_L(0); PG8_BAR; PG8_MMA(0, 0, At, B0); PG8_MMA(0, 1, At, B1); PG8_BAR; PG8_SCHED;
            PG8_LDA(At, 0, 1); PG8_STAGE(PG8_SB(0, 0), b2, voffB); PG8_STAGE(PG8_SB(0, 1), b2 + hstep, voffB); PG8_STAGE(PG8_SA(0, 0), a2, voffA);
            PG8_WAIT_V(8); PG8_WAIT_L(0); PG8_BAR; PG8_MMA(1, 0, At, B0); PG8_MMA(1, 1, At, B1); PG8_BAR; PG8_SCHED;
            PG8_LDB(B0, 1, 0); PG8_LDB(B1, 1, 1); PG8_SCHED; PG8_LDA(At, 1, 0); PG8_STAGE(PG8_SA(0, 1), a2 + hstep, voffA);
            PG8_WAIT_V(8); PG8_WAIT_L(0); PG8_BAR; PG8_MMA(0, 0, At, B0); PG8_MMA(0, 1, At, B1); PG8_BAR; PG8_SCHED;
            PG8_LDA(At, 1, 1); PG8_STAGE(PG8_SB(1, 0), b3, voffB); PG8_STAGE(PG8_SB(1, 1), b3 + hstep, voffB); PG8_STAGE(PG8_SA(1, 0), a3, voffA);
            PG8_WAIT_V(8); PG8_WAIT_L(0); PG8_BAR; PG8_MMA(1, 0, At, B0); PG8_MMA(1, 1, At, B1); PG8_BAR; PG8_SCHED;
            } else {
            PG8_LDB(B0, 0, 0); PG8_SCHED; PG8_LDA(At, 0, 0); PG8_STAGE(PG8_SA(1, 1), a1 + hstep, voffA);
            PG8_WAIT_L(8); PG8_BAR; PG8_WAIT_L(0); PG8_MMA(0, 0, At, B0); PG8_BAR; PG8_SCHED;
            PG8_LDB(B1, 0, 1); PG8_STAGE(PG8_SB(0, 0), b2, voffB);
            PG8_BAR; PG8_WAIT_L(0); PG8_MMA(0, 1, At, B1); PG8_BAR;
            PG8_LDA(At, 0, 1); PG8_STAGE(PG8_SA(0, 0), a2, voffA);
            PG8_BAR; PG8_WAIT_L(0); PG8_MMA(1, 0, At, B0); PG8_BAR; PG8_SCHED;
            PG8_STAGE(PG8_SB(0, 1), b2 + hstep, voffB);
            PG8_WAIT_V(6); PG8_BAR; PG8_MMA(1, 1, At, B1); PG8_BAR;
            PG8_LDB(B0, 1, 0); PG8_SCHED; PG8_LDA(At, 1, 0); PG8_STAGE(PG8_SA(0, 1), a2 + hstep, voffA);
            PG8_WAIT_L(8); PG8_BAR; PG8_WAIT_L(0); PG8_MMA(0, 0, At, B0); PG8_BAR; PG8_SCHED;
            PG8_LDB(B1, 1, 1); PG8_STAGE(PG8_SB(1, 0), b3, voffB);
            PG8_BAR; PG8_WAIT_L(0); PG8_MMA(0, 1, At, B1); PG8_BAR;
            PG8_LDA(At, 1, 1); PG8_STAGE(PG8_SA(1, 0), a3, voffA);
            PG8_BAR; PG8_WAIT_L(0); PG8_MMA(1, 0, At, B0); PG8_BAR; PG8_SCHED;
            PG8_STAGE(PG8_SB(1, 1), b3 + hstep, voffB);
            PG8_WAIT_V(6); PG8_BAR; PG8_MMA(1, 1, At, B1); PG8_BAR;
            }
        }
        if constexpr (ALIGN_EPI) { if (wr == 0) PG8_BAR; }
        if constexpr (!Epi::AFTER_DRAIN) { E(acc, cur, wr, wc, fr, fq); S.done(cur); }
        if (!has_next) break;
#pragma unroll
        for (int a = 0; a < 2; ++a)
#pragma unroll
            for (int b = 0; b < 2; ++b)
#pragma unroll
                for (int m = 0; m < 4; ++m)
#pragma unroll
                    for (int n = 0; n < 2; ++n) acc[a][b][m][n] = (f32x4){0.f, 0.f, 0.f, 0.f};
        cur = nxt; cA = nA; cB = nB; ++ui;
        if constexpr (ALIGN_EPI) { if (wr == 1) PG8_BAR; }
    }
    PG8_WAIT_V(0);
    if constexpr (!ALIGN_EPI) { if (wr == 0) PG8_BAR; }
    PG8_BAR;
    if constexpr (Epi::AFTER_DRAIN) { E.fused(acc, cur, wr, wc, fr, fq, lds, wid, lane); S.done(cur); }
#undef PG8_SA
#undef PG8_SB
#undef PG8_STAGE
#undef PG8_LDA
#undef PG8_LDB
#undef PG8_MMA
#undef PG8_WAIT_V
#undef PG8_WAIT_L
#undef PG8_BAR
#undef PG8_SCHED
}
}
#define LAS __attribute__((address_space(3)))
typedef float f32x4 __attribute__((ext_vector_type(4)));
typedef unsigned u32x4 __attribute__((ext_vector_type(4)));
typedef unsigned u32x2 __attribute__((ext_vector_type(2)));
constexpr int NWAVES = 8, NTHR = 512;
constexpr int LDS_BYTES = 147456;
constexpr int NPHASE = 17;

struct Args { const float* in[24]; float* out; unsigned char* ws; int ph_lo, ph_hi; };
typedef const __attribute__((address_space(4))) unsigned char* kptr_t;
DEV const float* kin(kptr_t kp, int k) { return *(const float* const __attribute__((address_space(4)))*)(kp + 8 * k); }
DEV float* kout(kptr_t kp) { return *(float* const __attribute__((address_space(4)))*)(kp + 192); }
DEV unsigned char* kws(kptr_t kp) { return *(unsigned char* const __attribute__((address_space(4)))*)(kp + 200); }
static_assert(sizeof(Args) == 216, "Args layout");

DEV float wave_sum(float v) {
#pragma unroll
    for (int o = 1; o < 64; o <<= 1) v += __shfl_xor(v, o);
    return v;
}
DEV unsigned pk2(float lo, float hi) { return pg8::cvt_pk_bf16(lo, hi); }

DEV void p0_transpose_item(const float* W, int K, int N, bf16_t* WT, int mode, LAS float* scr, int item, int lane) {
    const int nblk = N / 32, kb = item / nblk, nb = item % nblk, k0 = 64 * kb, n0 = 32 * nb;
#pragma unroll 8
    for (int i = 0; i < 32; ++i) { const int kk = 2 * i + (lane >> 5); scr[kk * 33 + (lane & 31)] = W[(size_t)(k0 + kk) * N + n0 + (lane & 31)]; }
    asm volatile("s_waitcnt lgkmcnt(0)" ::: "memory");
    const int c = lane & 7;
#pragma unroll
    for (int j = 0; j < 4; ++j) { const int nl = (lane >> 3) + 8 * j, n = n0 + nl; const LAS float* s = scr + (8 * c) * 33 + nl;
        const int r = mode == 0 ? n : (256 * (n >> 7) + (n & 127) + (mode == 2 ? 128 : 0));
        u32x4 o; o.x = pk2(s[0 * 33], s[1 * 33]); o.y = pk2(s[2 * 33], s[3 * 33]); o.z = pk2(s[4 * 33], s[5 * 33]); o.w = pk2(s[6 * 33], s[7 * 33]);
        *(u32x4*)(WT + (size_t)r * K + k0 + 8 * c) = o; }
    asm volatile("s_waitcnt lgkmcnt(0)" ::: "memory");
}
DEV void p0_prologue(kptr_t kp, LAS unsigned char* lds, int gw, int NGW, int wave, int lane) {
    LAS float* scr = (LAS float*)(lds + wave * 16384);
    unsigned char* ws = kws(kp);
    constexpr int I_INE = (DM / 64) * (IN_EVEN / 32), I_SQ = (DM / 64) * (DM / 32), I_INO = (DM / 64) * (IN_ODD / 32), I_GU = (DM / 64) * (DFF / 32), I_DN = (DFF / 64) * (DM / 32);
    constexpr int NITEMS = I_INE + 2 * I_SQ + I_INO + 4 * I_GU + 2 * I_DN;
    for (int it = gw; it < NITEMS; it += NGW) {
        int r = it; const float* W; int K, N, mode = 0; bf16_t* dst;
        if (r < I_INE) { W = kin(kp, 1); K = DM; N = IN_EVEN; dst = (bf16_t*)(ws + WS_WINE); }
        else if ((r -= I_INE) < I_SQ) { W = kin(kp, 8); K = DM; N = DM; dst = (bf16_t*)(ws + WS_WOUTE); }
        else if ((r -= I_SQ) < I_INO) { W = kin(kp, 9); K = DM; N = IN_ODD; dst = (bf16_t*)(ws + WS_WINO); }
        else if ((r -= I_INO) < I_SQ) { W = kin(kp, 16); K = DM; N = DM; dst = (bf16_t*)(ws + WS_WOUTO); }
        else if ((r -= I_SQ) < I_GU) { W = kin(kp, 19); K = DM; N = DFF; mode = 1; dst = (bf16_t*)(ws + WS_WGU0); }
        else if ((r -= I_GU) < I_GU) { W = kin(kp, 20); K = DM; N = DFF; mode = 2; dst = (bf16_t*)(ws + WS_WGU0); }
        else if ((r -= I_GU) < I_GU) { W = kin(kp, 19) + (size_t)DM * DFF; K = DM; N = DFF; mode = 1; dst = (bf16_t*)(ws + WS_WGU1); }
        else if ((r -= I_GU) < I_GU) { W = kin(kp, 20) + (size_t)DM * DFF; K = DM; N = DFF; mode = 2; dst = (bf16_t*)(ws + WS_WGU1); }
        else if ((r -= I_GU) < I_DN) { W = kin(kp, 21); K = DFF; N = DM; dst = (bf16_t*)(ws + WS_WDN0); }
        else { r -= I_DN; W = kin(kp, 21) + (size_t)DM * DFF; K = DFF; N = DM; dst = (bf16_t*)(ws + WS_WDN1); }
        p0_transpose_item(W, K, N, dst, mode, scr, r, lane);
    }
    { bf16_t* wsb = (bf16_t*)(ws + WS_SGUW);
      for (int i = gw * 64 + lane; i < 4 * 128 * 128; i += NGW * 64) { const int t = (i >> 7) & 127, sx = i & 127; wsb[i] = sx <= t ? f2bf(kin(kp, 14)[i]) : (bf16_t)0; } }
    const f32x4* x4 = (const f32x4*)kin(kp, 0); u32x2* o2 = (u32x2*)(ws + WS_XB);
    for (size_t i = (size_t)gw * 64 + lane; i < (size_t)MTOK * DM / 4; i += (size_t)NGW * 64) { const f32x4 v = x4[i]; u32x2 w; w.x = pk2(v.x, v.y); w.y = pk2(v.z, v.w); o2[i] = w; }
}
DEV void ln_phase(const float* Y, const float* g, const float* b, float* XF, bf16_t* XB, int gw, int NGW, int lane) {
    f32x4 gv[4], bv[4];
#pragma unroll
    for (int j = 0; j < 4; ++j) { gv[j] = ((const f32x4*)g)[lane + 64 * j]; bv[j] = ((const f32x4*)b)[lane + 64 * j]; }
    for (int m = gw; m < MTOK; m += NGW) {
        const f32x4* xr = (const f32x4*)(Y + (size_t)m * DM) + lane;
        f32x4 v[4]; float s = 0.f;
#pragma unroll
        for (int j = 0; j < 4; ++j) { v[j] = xr[64 * j]; s += (v[j].x + v[j].y) + (v[j].z + v[j].w); }
        const float mean = wave_sum(s) * (1.f / DM); float s2 = 0.f;
#pragma unroll
        for (int j = 0; j < 4; ++j) { v[j] = v[j] - mean; s2 += (v[j].x * v[j].x + v[j].y * v[j].y) + (v[j].z * v[j].z + v[j].w * v[j].w); }
        const float rstd = rsqrtf(wave_sum(s2) * (1.f / DM) + LN_EPS);
        f32x4* of = (f32x4*)(XF + (size_t)m * DM) + lane; u32x2* ob = (u32x2*)(XB + (size_t)m * DM) + lane;
#pragma unroll
        for (int j = 0; j < 4; ++j) { const f32x4 o = v[j] * rstd * gv[j] + bv[j]; of[64 * j] = o; u32x2 w; w.x = pk2(o.x, o.y); w.y = pk2(o.z, o.w); ob[64 * j] = w; }
    }
}

namespace att {
typedef short bf16x8 __attribute__((ext_vector_type(8)));
typedef short s16x4 __attribute__((ext_vector_type(4)));
typedef float f32x16 __attribute__((ext_vector_type(16)));
constexpr int KROW = 272, VROW = 320;
constexpr int KT_BYTES = 64 * KROW, VT_BYTES = 64 * VROW, STAGE = KT_BYTES + VT_BYTES;
constexpr int LDS_WSF = 2 * STAGE;
constexpr int LDS_TAB = LDS_WSF + 8 * 256;
constexpr int XROW = 132;
constexpr float LOG2E = 1.4426950408889634f, C1 = 0.125f * LOG2E;
DEV int crow(int reg, int hh) { return (reg & 3) + 8 * (reg >> 2) + 4 * hh; }
DEV s16x4 vtr(const LAS unsigned char* p) { typedef short v4i16_t __attribute__((ext_vector_type(4))); return __builtin_bit_cast(s16x4, __builtin_amdgcn_ds_read_tr16_b64_v4i16((LAS v4i16_t*)p)); }

template <int MODE> DEV void attn_unit(LAS unsigned char* lds, const bf16_t* __restrict__ HP, bf16_t* __restrict__ MC, int b, int hx, int qb, float lam, const float* __restrict__ subg, const float* __restrict__ relb, int tid) {
    const int lane = tid & 63, wave = __builtin_amdgcn_readfirstlane(tid >> 6), g = wave >> 2, wq = wave & 3, r = lane & 31, hh = lane >> 5;
    constexpr int QOFF = MODE == 0 ? 0 : 1536, KOFF = MODE == 0 ? 512 : 2048, VOFF = MODE == 0 ? 1024 : 2560, NEB = MODE == 0 ? 4 : 2;
    const size_t row0 = (size_t)b * SEQ; const int q0 = qb * 128;
    const int cw = 2 * qb + (wq >> 1);
    const int kt_lo = MODE == 0 ? 0 : (2 * qb - 8 > 0 ? 2 * qb - 8 : 0), kt_hi = 2 * qb + 1;
    LAS float* wsf = (LAS float*)(lds + LDS_WSF) + wave * 64;
    LAS float* tab = (LAS float*)(lds + LDS_TAB);
    if (MODE == 1) { for (int i = tid; i < 514; i += NTHR) tab[i] = relb[(2 * hx + (i >= 257 ? 1 : 0)) * 257 + (i >= 257 ? i - 257 : i)] * LOG2E; }
    bf16x8 qf[4];
    { const bf16_t* qp = HP + (row0 + q0 + 32 * wq + r) * IN_EVEN + QOFF + hx * 128 + g * 64 + hh * 8;
#pragma unroll
      for (int ds = 0; ds < 4; ++ds) qf[ds] = *(const bf16x8*)(qp + 16 * ds); }
    f32x16 o[NEB];
#pragma unroll
    for (int eb = 0; eb < NEB; ++eb)
#pragma unroll
        for (int i = 0; i < 16; ++i) o[eb][i] = 0.f;
    float mhat = -1e30f, l = 0.f;
    const int tq = q0 + 32 * wq + r;
    const float sl2 = exp2f(-2.0f * (float)(hx + 1)) * LOG2E;
    const int srow = tid >> 4, scc = tid & 15;
    const bf16_t* kg = HP + (row0 + srow) * IN_EVEN + KOFF + hx * 128 + scc * 8;
    const bf16_t* vg = HP + (row0 + srow) * IN_EVEN + VOFF + hx * 128 + scc * 8;
    u32x4 kreg[2], vreg[2];
#define ATT_LOAD(kt) do { _Pragma("unroll") for (int i_ = 0; i_ < 2; ++i_) { const size_t ro_ = (size_t)(64 * (kt) + 32 * i_) * IN_EVEN; kreg[i_] = *(const u32x4*)(kg + ro_); vreg[i_] = *(const u32x4*)(vg + ro_); } } while (0)
#define ATT_STORE(buf) do { _Pragma("unroll") for (int i_ = 0; i_ < 2; ++i_) { *(LAS u32x4*)(lds + (buf) * STAGE + (srow + 32 * i_) * KROW + scc * 16) = kreg[i_]; \
        *(LAS u32x4*)(lds + (buf) * STAGE + KT_BYTES + (srow + 32 * i_) * VROW + scc * 16) = vreg[i_]; } } while (0)
    ATT_LOAD(kt_lo); ATT_STORE(0);
    __syncthreads();
    const int p15 = lane & 15, g4 = lane >> 4;
    const int vlane = (4 * hh + (p15 >> 2)) * VROW + ((MODE == 1 ? g * 64 : 0) + 16 * (g4 & 1) + 4 * (p15 & 3)) * 2;
    for (int kt = kt_lo; kt <= kt_hi; ++kt) {
        const int buf = (kt - kt_lo) & 1;
        if (kt < kt_hi) ATT_LOAD(kt + 1);
        const bool active = MODE == 0 ? (kt <= cw) : (kt <= cw && kt >= cw - 8);
        if (active) {
            const LAS unsigned char* Kb = lds + buf * STAGE; const LAS unsigned char* Vb = Kb + KT_BYTES;
            f32x16 s0, s1;
#pragma unroll
            for (int i = 0; i < 16; ++i) { s0[i] = 0.f; s1[i] = 0.f; }
#pragma unroll
            for (int ds = 0; ds < 4; ++ds) {
                const bf16x8 k0 = *(const LAS bf16x8*)(Kb + r * KROW + g * 128 + ds * 32 + hh * 16);
                const bf16x8 k1 = *(const LAS bf16x8*)(Kb + (32 + r) * KROW + g * 128 + ds * 32 + hh * 16);
                s0 = __builtin_amdgcn_mfma_f32_32x32x16_bf16(k0, qf[ds], s0, 0, 0, 0);
                s1 = __builtin_amdgcn_mfma_f32_32x32x16_bf16(k1, qf[ds], s1, 0, 0, 0);
            }
            const int dbase = tq - (64 * kt + 4 * hh);
            if (MODE == 0) {
#pragma unroll
                for (int i = 0; i < 16; ++i) { const int off = (i & 3) + 8 * (i >> 2); const float d0 = (float)(dbase - off), d1 = (float)(dbase - off - 32);
                    s0[i] = s0[i] * C1 - sl2 * __builtin_fabsf(d0); s1[i] = s1[i] * C1 - sl2 * __builtin_fabsf(d1); }
            } else {
                if (kt <= cw - 3) { const float tf = tab[g * 257 + 256];
#pragma unroll
                    for (int i = 0; i < 16; ++i) { s0[i] = s0[i] * C1 + tf; s1[i] = s1[i] * C1 + tf; }
                } else {
#pragma unroll
                    for (int i = 0; i < 16; ++i) { const int off = (i & 3) + 8 * (i >> 2); int r0 = dbase - off, r1 = r0 - 32;
                        r0 = r0 < -128 ? -128 : (r0 > 128 ? 128 : r0); r1 = r1 < -128 ? -128 : (r1 > 128 ? 128 : r1);
                        s0[i] = s0[i] * C1 + tab[g * 257 + 128 + r0]; s1[i] = s1[i] * C1 + tab[g * 257 + 128 + r1]; }
                }
            }
            float rm = __builtin_fmaxf(s0[0], s1[0]);
#pragma unroll
            for (int i = 1; i < 16; ++i) rm = __builtin_fmaxf(rm, __builtin_fmaxf(s0[i], s1[i]));
            rm = __builtin_fmaxf(rm, __shfl_xor(rm, 32));
            if (__any(rm > mhat + 8.f)) {
                const float mnew = __builtin_fmaxf(mhat, rm), f = __builtin_amdgcn_exp2f(mhat - mnew); mhat = mnew; l *= f;
                if (hh == 0) wsf[r] = f;
#pragma unroll
                for (int i = 0; i < 16; ++i) { const float fr = wsf[crow(i, hh)];
#pragma unroll
                    for (int eb = 0; eb < NEB; ++eb) o[eb][i] *= fr; }
            }
            float ls = 0.f;
#pragma unroll
            for (int i = 0; i < 16; ++i) { s0[i] = __builtin_amdgcn_exp2f(s0[i] - mhat); s1[i] = __builtin_amdgcn_exp2f(s1[i] - mhat); ls += s0[i] + s1[i]; }
            l += ls;
            bf16x8 pa[2][2];
#pragma unroll
            for (int s = 0; s < 2; ++s) {
                u32x4 w0, w1;
                w0.x = pk2(s0[8 * s + 0], s0[8 * s + 1]); w0.y = pk2(s0[8 * s + 2], s0[8 * s + 3]); w0.z = pk2(s0[8 * s + 4], s0[8 * s + 5]); w0.w = pk2(s0[8 * s + 6], s0[8 * s + 7]);
                w1.x = pk2(s1[8 * s + 0], s1[8 * s + 1]); w1.y = pk2(s1[8 * s + 2], s1[8 * s + 3]); w1.z = pk2(s1[8 * s + 4], s1[8 * s + 5]); w1.w = pk2(s1[8 * s + 6], s1[8 * s + 7]);
                pa[0][s] = __builtin_bit_cast(bf16x8, w0); pa[1][s] = __builtin_bit_cast(bf16x8, w1);
            }
#pragma unroll
            for (int kb = 0; kb < 2; ++kb)
#pragma unroll
                for (int s = 0; s < 2; ++s) {
                    const LAS unsigned char* vp = Vb + vlane + (32 * kb + 16 * s) * VROW;
#pragma unroll
                    for (int eb = 0; eb < NEB; ++eb) {
                        const s16x4 lo = vtr(vp + eb * 64), hi = vtr(vp + eb * 64 + 8 * VROW);
                        const bf16x8 vf = (bf16x8){lo[0], lo[1], lo[2], lo[3], hi[0], hi[1], hi[2], hi[3]};
                        o[eb] = __builtin_amdgcn_mfma_f32_32x32x16_bf16(pa[kb][s], vf, o[eb], 0, 0, 0);
                    }
                }
        }
        if (kt < kt_hi) ATT_STORE(buf ^ 1);
        __syncthreads();
    }
#undef ATT_LOAD
#undef ATT_STORE
    l += __shfl_xor(l, 32);
    if (hh == 0) wsf[r] = 1.0f / l;
#pragma unroll
    for (int i = 0; i < 16; ++i) { const float fr = wsf[crow(i, hh)];
#pragma unroll
        for (int eb = 0; eb < NEB; ++eb) o[eb][i] *= fr; }
    LAS float* X = (LAS float*)lds;
    const int xr = 32 * wq, rrow = xr + (lane >> 1), half = lane & 1;
    const size_t tok = row0 + q0 + rrow;
    if (MODE == 0) {
        if (g == 1) {
#pragma unroll
            for (int eb = 0; eb < NEB; ++eb)
#pragma unroll
                for (int i = 0; i < 16; ++i) X[(xr + crow(i, hh)) * XROW + 32 * eb + r] = o[eb][i];
        }
        __syncthreads();
        if (g == 0) {
#pragma unroll
            for (int eb = 0; eb < NEB; ++eb)
#pragma unroll
                for (int i = 0; i < 16; ++i) { const int ix = (xr + crow(i, hh)) * XROW + 32 * eb + r; X[ix] = o[eb][i] - lam * X[ix]; }
            f32x4 v[16]; float ss = 0.f;
#pragma unroll
            for (int j = 0; j < 16; ++j) { v[j] = *(const LAS f32x4*)(X + rrow * XROW + 64 * half + 4 * j); ss += (v[j].x * v[j].x + v[j].y * v[j].y) + (v[j].z * v[j].z + v[j].w * v[j].w); }
            ss += __shfl_xor(ss, 1);
            const float rs = rsqrtf(ss * (1.f / 128.f) + LN_EPS) * 0.8f;
            bf16_t* op = MC + tok * DM + hx * 128 + 64 * half;
#pragma unroll
            for (int j = 0; j < 8; ++j) { const f32x4 g0 = *(const f32x4*)(subg + 64 * half + 8 * j), g1 = *(const f32x4*)(subg + 64 * half + 8 * j + 4); const f32x4 a0 = v[2 * j] * rs * g0, a1 = v[2 * j + 1] * rs * g1;
                u32x4 w; w.x = pk2(a0.x, a0.y); w.y = pk2(a0.z, a0.w); w.z = pk2(a1.x, a1.y); w.w = pk2(a1.z, a1.w); *(u32x4*)(op + 8 * j) = w; }
        }
    } else {
#pragma unroll
        for (int eb = 0; eb < NEB; ++eb)
#pragma unroll
            for (int i = 0; i < 16; ++i) X[(xr + crow(i, hh)) * XROW + g * 64 + 32 * eb + r] = o[eb][i];
        f32x4 v[8];
#pragma unroll
        for (int j = 0; j < 8; ++j) v[j] = *(const LAS f32x4*)(X + rrow * XROW + g * 64 + 32 * half + 4 * j);
        bf16_t* op = MC + tok * DM + 512 + hx * 128 + g * 64 + 32 * half;
#pragma unroll
        for (int j = 0; j < 4; ++j) { const f32x4 a0 = v[2 * j], a1 = v[2 * j + 1]; u32x4 w; w.x = pk2(a0.x, a0.y); w.y = pk2(a0.z, a0.w); w.z = pk2(a1.x, a1.y); w.w = pk2(a1.z, a1.w); *(u32x4*)(op + 8 * j) = w; }
    }
    __syncthreads();
}

DEV void attn_phase(LAS unsigned char* lds, kptr_t kp, const bf16_t* HP, bf16_t* MC, int vcu, int G, int tid) {
    float s1 = 0.f, s2 = 0.f;
    { const float* q1 = kin(kp, 2); const float* k1 = kin(kp, 3); const float* q2 = kin(kp, 4); const float* k2 = kin(kp, 5);
      for (int d = 0; d < 64; ++d) { s1 += q1[d] * k1[d]; s2 += q2[d] * k2[d]; } }
    const float lam = expf(s1) - expf(s2) + 0.2f;
    for (int u = vcu; u < 1024; u += G) { const int i = u >> 8, bh = (u & 255) >> 4, s = u & 15; const int qb = i == 0 ? s : (i == 1 ? 31 - s : (i == 2 ? 32 + s : 63 - s));
        attn_unit<0>(lds, HP, MC, bh >> 2, bh & 3, qb, lam, kin(kp, 6), nullptr, tid); }
    for (int u = vcu; u < 1024; u += G) { const int id = 4 * (u & 255) + (u >> 8);
        attn_unit<1>(lds, HP, MC, id >> 8, (id >> 6) & 3, id & 63, 0.f, nullptr, kin(kp, 7), tid); }
}
}

namespace mix1 {
using att::bf16x8; using att::s16x4; using att::f32x16; using att::crow; using att::vtr;
constexpr int VSTR = 1088;
constexpr float LOG2E = 1.4426950408889634f;
DEV float lg2gamma(int h) { return __builtin_log2f(1.f - __builtin_amdgcn_exp2f(-5.f - (float)h)); }
DEV bf16x8 trpair(const LAS unsigned char* p, int hi_off) { const s16x4 lo = vtr(p), hi = vtr(p + hi_off); return (bf16x8){lo[0], lo[1], lo[2], lo[3], hi[0], hi[1], hi[2], hi[3]}; }

template <int KSTR, bool KSCALE> DEV void stage_kv(LAS unsigned char* lds, const bf16_t* __restrict__ HP, size_t tok0, int tid) {
    constexpr int VOFFB = 64 * KSTR;
#pragma unroll
    for (int i = 0; i < 4; ++i) { const int ck = tid + NTHR * i, row = ck >> 5, cc = ck & 31;
        u32x4 v = *(const u32x4*)(HP + (tok0 + row) * IN_ODD + 256 + cc * 8);
        if (KSCALE) { const float f = 0.125f * __builtin_amdgcn_exp2f((float)(63 - row) * lg2gamma(cc >> 3));
            unsigned w[4] = {v.x, v.y, v.z, v.w};
#pragma unroll
            for (int j = 0; j < 4; ++j) w[j] = pk2(__uint_as_float(w[j] << 16) * f, __uint_as_float(w[j] & 0xffff0000u) * f);
            v = (u32x4){w[0], w[1], w[2], w[3]}; }
        *(LAS u32x4*)(lds + row * KSTR + cc * 16) = v; }
#pragma unroll
    for (int i = 0; i < 8; ++i) { const int ck = tid + NTHR * i, row = ck >> 6, cc = ck & 63;
        *(LAS u32x4*)(lds + VOFFB + row * VSTR + cc * 16) = *(const u32x4*)(HP + (tok0 + row) * IN_ODD + 512 + cc * 8); }
}

DEV void ret_kv_phase(LAS unsigned char* lds, const bf16_t* __restrict__ HP, float* __restrict__ KV, int vcu, int G, int tid) {
    constexpr int KSTR = 576;
    const int lane = tid & 63, wave = __builtin_amdgcn_readfirstlane(tid >> 6), h = wave >> 1, dblk = wave & 1, r = lane & 31, hh = lane >> 5, p15 = lane & 15, g4 = lane >> 4;
    const int rowl = 4 * hh + (p15 >> 2), coll = 16 * (g4 & 1) + 4 * (p15 & 3);
    for (int u = vcu; u < BATCH * 128; u += G) { const int b = u >> 7, c = u & 127; const size_t tok0 = (size_t)b * SEQ + 64 * c;
        stage_kv<KSTR, true>(lds, HP, tok0, tid);
        __syncthreads();
        f32x16 acc[4];
#pragma unroll
        for (int eb = 0; eb < 4; ++eb)
#pragma unroll
            for (int i = 0; i < 16; ++i) acc[eb][i] = 0.f;
#pragma unroll
        for (int ks = 0; ks < 4; ++ks) {
            const bf16x8 kf = trpair(lds + (16 * ks + rowl) * KSTR + (h * 64 + 32 * dblk + coll) * 2, 8 * KSTR);
#pragma unroll
            for (int eb = 0; eb < 4; ++eb) { const bf16x8 vf = trpair(lds + 64 * KSTR + (16 * ks + rowl) * VSTR + (h * 128 + 32 * eb + coll) * 2, 8 * VSTR);
                acc[eb] = __builtin_amdgcn_mfma_f32_32x32x16_bf16(vf, kf, acc[eb], 0, 0, 0); }
        }
        float* o = KV + ((size_t)((b * 4 + h) * 128 + c) * 128) * 64 + 32 * dblk + r;
#pragma unroll
        for (int eb = 0; eb < 4; ++eb)
            { float* oq = o + (32 * eb + 4 * hh) * 64;
#pragma unroll
              for (int i = 0; i < 16; ++i) { *oq = acc[eb][i]; oq += ((i & 3) == 3 ? 5 : 1) * 64; asm volatile("" : "+v"(oq)); } }
        __syncthreads();
    }
}
DEV void ret_scan_phase(const float* __restrict__ KV, bf16_t* __restrict__ PREV, int vcu, int G, int tid) {
    for (int idx = vcu * NTHR + tid; idx < 16 * 8192; idx += G * NTHR) { const int bh = idx >> 13, ed = idx & 8191;
        const float cd = __builtin_amdgcn_exp2f(64.f * lg2gamma(bh & 3)); float st = 0.f;
        const float* kv = KV + (size_t)bh * 128 * 8192 + ed; bf16_t* pv = PREV + (size_t)bh * 128 * 8192 + ed;
#pragma unroll 8
        for (int c = 0; c < 128; ++c) { const float x = kv[(size_t)c * 8192]; pv[(size_t)c * 8192] = f2bf(st); st = st * cd + x; }
    }
}
DEV void ret_out_phase(LAS unsigned char* lds, const bf16_t* __restrict__ HP, const bf16_t* __restrict__ PREV, const float* __restrict__ gng, const float* __restrict__ gnb, bf16_t* __restrict__ MC, int vcu, int G, int tid) {
    constexpr int KSTR = 528;
    const int lane = tid & 63, wave = __builtin_amdgcn_readfirstlane(tid >> 6), h = wave >> 1, lb = wave & 1, r = lane & 31, hh = lane >> 5, p15 = lane & 15, g4 = lane >> 4;
    const float lg = lg2gamma(h);
    const int vlane = 64 * KSTR + (4 * hh + (p15 >> 2)) * VSTR + (h * 128 + 16 * (g4 & 1) + 4 * (p15 & 3)) * 2;
    for (int u = vcu; u < BATCH * 128; u += G) { const int b = u >> 7, c = u & 127; const size_t tok0 = (size_t)b * SEQ + 64 * c;
        stage_kv<KSTR, false>(lds, HP, tok0, tid);
        bf16x8 qf[4];
        { const bf16_t* qp = HP + (tok0 + 32 * lb + r) * IN_ODD + h * 64 + hh * 8;
#pragma unroll
          for (int ds = 0; ds < 4; ++ds) qf[ds] = *(const bf16x8*)(qp + 16 * ds); }
        f32x16 acc[4];
        { const bf16_t* pp = PREV + ((size_t)((b * 4 + h) * 128 + c) * 128 + r) * 64 + hh * 8;
#pragma unroll
          for (int eb = 0; eb < 4; ++eb) {
#pragma unroll
              for (int i = 0; i < 16; ++i) acc[eb][i] = 0.f;
#pragma unroll
              for (int ds = 0; ds < 4; ++ds) { const bf16x8 pf = *(const bf16x8*)(pp + (size_t)(32 * eb) * 64 + 16 * ds); acc[eb] = __builtin_amdgcn_mfma_f32_32x32x16_bf16(qf[ds], pf, acc[eb], 0, 0, 0); } } }
#pragma unroll
        for (int i = 0; i < 16; ++i) { const float qd = __builtin_amdgcn_exp2f((float)(32 * lb + crow(i, hh) + 1) * lg);
#pragma unroll
            for (int eb = 0; eb < 4; ++eb) acc[eb][i] *= qd; }
        __syncthreads();
        for (int mb = 0; mb <= lb; ++mb) {
            f32x16 s;
#pragma unroll
            for (int i = 0; i < 16; ++i) s[i] = 0.f;
#pragma unroll
            for (int ds = 0; ds < 4; ++ds) { const bf16x8 kf = *(const LAS bf16x8*)(lds + (32 * mb + r) * KSTR + (h * 64 + 16 * ds + 8 * hh) * 2); s = __builtin_amdgcn_mfma_f32_32x32x16_bf16(kf, qf[ds], s, 0, 0, 0); }
            const int dbase = 32 * lb + r - 32 * mb - 4 * hh;
#pragma unroll
            for (int i = 0; i < 16; ++i) { const int df = dbase - ((i & 3) + 8 * (i >> 2)); const float w = 0.125f * __builtin_amdgcn_exp2f((float)df * lg); s[i] = df >= 0 ? s[i] * w : 0.f; }
#pragma unroll
            for (int sx = 0; sx < 2; ++sx) { u32x4 w; w.x = pk2(s[8 * sx + 0], s[8 * sx + 1]); w.y = pk2(s[8 * sx + 2], s[8 * sx + 3]); w.z = pk2(s[8 * sx + 4], s[8 * sx + 5]); w.w = pk2(s[8 * sx + 6], s[8 * sx + 7]);
                const bf16x8 pa = __builtin_bit_cast(bf16x8, w);
#pragma unroll
                for (int eb = 0; eb < 4; ++eb) { const bf16x8 vf = trpair(lds + vlane + (32 * mb + 16 * sx) * VSTR + eb * 64, 8 * VSTR); acc[eb] = __builtin_amdgcn_mfma_f32_32x32x16_bf16(pa, vf, acc[eb], 0, 0, 0); } }
        }
        float mu[16], rs[16];
#pragma unroll
        for (int i = 0; i < 16; ++i) { float s1 = (acc[0][i] + acc[1][i]) + (acc[2][i] + acc[3][i]);
#pragma unroll
            for (int o = 1; o < 32; o <<= 1) s1 += __shfl_xor(s1, o);
            const float m = s1 * (1.f / 128.f); float s2 = 0.f;
#pragma unroll
            for (int eb = 0; eb < 4; ++eb) { const float d = acc[eb][i] - m; s2 += d * d; }
#pragma unroll
            for (int o = 1; o < 32; o <<= 1) s2 += __shfl_xor(s2, o);
            mu[i] = m; rs[i] = rsqrtf(s2 * (1.f / 128.f) + LN_EPS); }
        const bf16_t* gp = HP + tok0 * IN_ODD + 1024; bf16_t* mp = MC + tok0 * DM;
#pragma unroll
        for (int eb = 0; eb < 4; ++eb) { const int col = h * 128 + 32 * eb + r; const float gg = gng[col], bb = gnb[col];
            const bf16_t* gq = gp + (32 * lb + 4 * hh) * IN_ODD + col; bf16_t* mq = mp + (32 * lb + 4 * hh) * DM + col;
#pragma unroll
            for (int i = 0; i < 16; ++i) { const float gt = bf2f(*gq);
                const float y = (acc[eb][i] - mu[i]) * rs[i] * gg + bb; *mq = f2bf(y * pg8::e_silu(gt));
                const int step = (i & 3) == 3 ? 5 : 1; gq += step * IN_ODD; mq += step * DM; asm volatile("" : "+v"(gq), "+v"(mq)); } }
        __syncthreads();
    }
}

DEV void sgu_phase(LAS unsigned char* lds, const bf16_t* __restrict__ HP, const bf16_t* __restrict__ WSB, const float* __restrict__ lng, const float* __restrict__ lnb, const float* __restrict__ bs, bf16_t* __restrict__ MC, int vcu, int G, int tid) {
    constexpr int TSTR = 320, TOFF = 1024;
    const int lane = tid & 63, wave = __builtin_amdgcn_readfirstlane(tid >> 6), r = lane & 31, hh = lane >> 5, p15 = lane & 15, g4 = lane >> 4;
    LAS float* stats = (LAS float*)lds;
    const int cb = wave & 3, whalf = wave >> 2;
    for (int u = vcu; u < MTOK / 128; u += G) { const size_t tok0 = (size_t)u * 128;
        const bf16_t* up = HP + tok0 * IN_ODD + 1536; bf16_t* mp = MC + tok0 * DM + 512;
        for (int i = 0; i < 16; ++i) { const int row = 16 * wave + i; const u32x4 v = *(const u32x4*)(HP + (tok0 + row) * IN_ODD + 2048 + lane * 8);
            float x[8] = {__uint_as_float(v.x << 16), __uint_as_float(v.x & 0xffff0000u), __uint_as_float(v.y << 16), __uint_as_float(v.y & 0xffff0000u), __uint_as_float(v.z << 16), __uint_as_float(v.z & 0xffff0000u), __uint_as_float(v.w << 16), __uint_as_float(v.w & 0xffff0000u)};
            float s1 = 0.f;
#pragma unroll
            for (int j = 0; j < 8; ++j) s1 += x[j];
            const float m = wave_sum(s1) * (1.f / 512.f); float s2 = 0.f;
#pragma unroll
            for (int j = 0; j < 8; ++j) { const float d = x[j] - m; s2 += d * d; }
            const float rstd = rsqrtf(wave_sum(s2) * (1.f / 512.f) + LN_EPS);
            if (lane == 0) { stats[2 * row] = m; stats[2 * row + 1] = rstd; } }
        __syncthreads();
        for (int g = 0; g < 4; ++g) {
#pragma unroll
            for (int i = 0; i < 4; ++i) { const int ck = tid + NTHR * i, row = ck >> 4, cc = ck & 15; const int ch = g * 128 + cc * 8;
                const u32x4 v = *(const u32x4*)(HP + (tok0 + row) * IN_ODD + 2048 + ch);
                const float m = stats[2 * row], rstd = stats[2 * row + 1];
                const f32x4 g0 = *(const f32x4*)(lng + ch), g1 = *(const f32x4*)(lng + ch + 4), b0 = *(const f32x4*)(lnb + ch), b1 = *(const f32x4*)(lnb + ch + 4);
                u32x4 w;
                w.x = pk2((__uint_as_float(v.x << 16) - m) * rstd * g0.x + b0.x, (__uint_as_float(v.x & 0xffff0000u) - m) * rstd * g0.y + b0.y);
                w.y = pk2((__uint_as_float(v.y << 16) - m) * rstd * g0.z + b0.z, (__uint_as_float(v.y & 0xffff0000u) - m) * rstd * g0.w + b0.w);
                w.z = pk2((__uint_as_float(v.z << 16) - m) * rstd * g1.x + b1.x, (__uint_as_float(v.z & 0xffff0000u) - m) * rstd * g1.y + b1.y);
                w.w = pk2((__uint_as_float(v.w << 16) - m) * rstd * g1.z + b1.z, (__uint_as_float(v.w & 0xffff0000u) - m) * rstd * g1.w + b1.w);
                *(LAS u32x4*)(lds + TOFF + row * TSTR + cc * 16) = w; }
            __syncthreads();
#pragma unroll
            for (int j = 0; j < 2; ++j) { const int tb = whalf == 0 ? (j == 0 ? 0 : 3) : (j == 0 ? 1 : 2);
                f32x16 acc;
#pragma unroll
                for (int i = 0; i < 16; ++i) acc[i] = 0.f;
                const bf16_t* wp = WSB + ((size_t)g * 128 + 32 * tb + r) * 128 + hh * 8;
                for (int ks = 0; ks < 2 * (tb + 1); ++ks) {
                    const bf16x8 wf = *(const bf16x8*)(wp + 16 * ks);
                    const bf16x8 vf = trpair(lds + TOFF + (16 * ks + 8 * hh + (p15 >> 2)) * TSTR + (32 * cb + 16 * (g4 & 1) + 4 * (p15 & 3)) * 2, 4 * TSTR);
                    acc = __builtin_amdgcn_mfma_f32_32x32x16_bf16(wf, vf, acc, 0, 0, 0);
                }
                const int col = g * 128 + 32 * cb + r;
                const bf16_t* uq = up + (32 * tb + 4 * hh) * IN_ODD + col; bf16_t* mq = mp + (32 * tb + 4 * hh) * DM + col; const float* bq = bs + g * 128 + 32 * tb + 4 * hh;
#pragma unroll
                for (int i = 0; i < 16; ++i) { const float uu = bf2f(*uq); *mq = f2bf(uu * (acc[i] + *bq));
                    const int step = (i & 3) == 3 ? 5 : 1; uq += step * IN_ODD; mq += step * DM; bq += step; asm volatile("" : "+v"(uq), "+v"(mq), "+v"(bq)); }
            }
            __syncthreads();
        }
    }
}
}

#define XB_TMO      128
#define XB_XCNT(j)  (256  + 64 * (j))
#define XB_XSUB(j)  (1280 + 64 * (j))
#define XB_XGEN(j)  (2304 + 64 * (j))
#define XB_TOP      3328
#define XB_TOPGEN   3392
#define XCD_BAR_WORDS 3456
#define XB_SPIN_CAP (1u << 18)

__device__ __forceinline__ unsigned xb_ld(unsigned* p)              { return __hip_atomic_load(p, __ATOMIC_RELAXED, __HIP_MEMORY_SCOPE_AGENT); }
__device__ __forceinline__ unsigned xb_add(unsigned* p, unsigned v) { return __hip_atomic_fetch_add(p, v, __ATOMIC_RELAXED, __HIP_MEMORY_SCOPE_AGENT); }
__device__ __forceinline__ unsigned xb_xcc_id() { return (unsigned)__builtin_amdgcn_s_getreg((3 << 11) | 20) & 0xFu; }
#define XB_SPIN(cond, bar) do { unsigned _sp = 0; while (cond) { __builtin_amdgcn_s_sleep(1); \
    if ((++_sp & 255u) == 0u) { if (xb_ld(&(bar)[XB_TMO])) break; if (_sp > XB_SPIN_CAP) { atomicAdd(&(bar)[XB_TMO], 1u); break; } } } } while (0)

struct XcdBarrier {
    unsigned* bar; unsigned x;
    volatile LAS unsigned* st;
};

__device__ __forceinline__ XcdBarrier xcd_barrier_post(unsigned* bar, volatile LAS unsigned* st) {
    XcdBarrier b; b.bar = bar; b.x = xb_xcc_id(); b.st = st;
    if (threadIdx.x == 0) (void)xb_add(&bar[XB_XCNT(b.x)], 1u);
    return b;
}
__device__ __forceinline__ void xcd_barrier_complete(unsigned* bar, unsigned x, unsigned& nloc, unsigned& nx) {
    const unsigned G = gridDim.x * gridDim.y * gridDim.z;
    unsigned sum, cnt, mine, sp = 0u;
    for (;;) {
        sum = 0u; cnt = 0u; mine = 0u;
#pragma unroll
        for (unsigned j = 0; j < 16; ++j) { const unsigned c = xb_ld(&bar[XB_XCNT(j)]); sum += c; cnt += (c > 0u) ? 1u : 0u; mine = (j == x) ? c : mine; }
        if (sum == G) break;
        __builtin_amdgcn_s_sleep(1);
        if ((++sp & 255u) == 0u) { if (xb_ld(&bar[XB_TMO])) break; if (sp > XB_SPIN_CAP) { atomicAdd(&bar[XB_TMO], 1u); break; } }
    }
    nloc = mine > 0u ? mine : 1u; nx = cnt > 0u ? cnt : 1u;
}

__device__ __forceinline__ void xcd_barrier(const XcdBarrier& b) {
    asm volatile("s_waitcnt vmcnt(0)" ::: "memory");
    __syncthreads();
    if (threadIdx.x == 0) {
        unsigned* bar = b.bar;
        __builtin_amdgcn_s_waitcnt(0);
        unsigned nloc = b.st[0], nx = b.st[1];
        if (nloc == 0u) { xcd_barrier_complete(bar, b.x, nloc, nx); b.st[0] = nloc; b.st[1] = nx; }
        const unsigned old = xb_add(&bar[XB_XSUB(b.x)], 1u);
        const unsigned gen = old / nloc;
        if (old + 1u == (gen + 1u) * nloc) {
            __builtin_amdgcn_fence(__ATOMIC_RELEASE, "agent");
            asm volatile("s_waitcnt vmcnt(0)" ::: "memory");
            const unsigned og = xb_add(&bar[XB_TOP], 1u);
            const unsigned tg = og / nx;
            if (og + 1u == (tg + 1u) * nx) xb_add(&bar[XB_TOPGEN], 1u);
            else XB_SPIN(xb_ld(&bar[XB_TOPGEN]) == tg, bar);
            __builtin_amdgcn_fence(__ATOMIC_ACQUIRE, "agent");
            xb_add(&bar[XB_XGEN(b.x)], 1u);
            asm volatile("s_waitcnt vmcnt(0)" ::: "memory");
        } else {
            XB_SPIN(xb_ld(&bar[XB_XGEN(b.x)]) == gen, bar);
            __builtin_amdgcn_fence(__ATOMIC_ACQUIRE, "agent");
            asm volatile("s_waitcnt vmcnt(0)" ::: "memory");
        }
    }
    __syncthreads();
}

__global__ void __launch_bounds__(NTHR, 2) mk_fwd(Args a) {
    extern __shared__ __attribute__((aligned(16))) unsigned char lds_raw[];
    LAS unsigned char* lds = (LAS unsigned char*)lds_raw;
    volatile LAS unsigned* MISC = (volatile LAS unsigned*)(lds + LDS_BYTES - 64);
    if (threadIdx.x < 16) MISC[threadIdx.x] = 0u;
    __syncthreads();
    XcdBarrier bar; bar.bar = nullptr; bar.x = 0; bar.st = nullptr;
    if (a.ph_hi - a.ph_lo > 1) bar = xcd_barrier_post((unsigned*)(a.ws + WS_CTL) + 1024, MISC + 8);
    for (int ph = a.ph_lo; ph < a.ph_hi; ++ph) {
        int tid = threadIdx.x; asm volatile("" : "+v"(tid));
        kptr_t kp = (kptr_t)__builtin_amdgcn_kernarg_segment_ptr(); asm volatile("" : "+s"(kp));
        unsigned char* ws = kws(kp);
        const int lane = tid & 63, wave = __builtin_amdgcn_readfirstlane(tid >> 6);
        const int G = gridDim.x, bx = blockIdx.x;
        const int vcu = (G % 8 == 0) ? (bx % 8) * (G / 8) + bx / 8 : bx;
        const int gw = vcu * NWAVES + wave, NGW = G * NWAVES;
        bf16_t* XB = (bf16_t*)(ws + WS_XB); bf16_t* HP = (bf16_t*)(ws + WS_HP); bf16_t* MC = (bf16_t*)(ws + WS_MC); float* Y = (float*)(ws + WS_Y); float* XF = kout(kp);
        const int L = ph >= 8 ? 1 : 0;
        switch (ph) {
        case 0: p0_prologue(kp, lds, gw, NGW, wave, lane); break;
        case 1: case 8: {
            const int N = L ? IN_ODD : IN_EVEN;
            pg8::Gemm g{XB, (const bf16_t*)(ws + (L ? WS_WINO : WS_WINE)), MTOK, N, DM}; pg8::StaticOrder S; S.init(MTOK, N, G, bx);
            pg8::EpiBf16G E{HP, N, L ? 6 : (1 << 30)};
            pg8::gemm_phase<pg8::EpiBf16G, pg8::StaticOrder, true, true>(lds, g, S, E, tid);
        } break;
        case 3: case 12: case 6: case 15: {
            const bool dn = (ph == 6 || ph == 15);
            const bf16_t* A = dn ? HP : MC; const int K = dn ? DFF : DM;
            const bf16_t* Bt = (const bf16_t*)(ws + (dn ? (L ? WS_WDN1 : WS_WDN0) : (L ? WS_WOUTO : WS_WOUTE)));
            const float* R = (ph == 3) ? kin(kp, 0) : XF;
            pg8::Gemm g{A, Bt, MTOK, DM, K}; pg8::StaticOrder S; S.init(MTOK, DM, G, bx);
            pg8::EpiResid E{R, Y, DM, ALPHA};
            pg8::gemm_phase<pg8::EpiResid, pg8::StaticOrder, true, true>(lds, g, S, E, tid);
        } break;
        case 4: case 7: case 13: case 16: {
            const bool ffn = (ph == 7 || ph == 16);
            ln_phase(Y, kin(kp, ffn ? 22 : 17) + L * DM, kin(kp, ffn ? 23 : 18) + L * DM, XF, XB, gw, NGW, lane);
        } break;
        case 5: case 14: {
            pg8::Gemm g{XB, (const bf16_t*)(ws + (L ? WS_WGU1 : WS_WGU0)), MTOK, 2 * DFF, DM}; pg8::StaticOrder S; S.init(MTOK, 2 * DFF, G, bx);
            pg8::EpiSwiglu E{HP, DFF};
            pg8::gemm_phase<pg8::EpiSwiglu, pg8::StaticOrder, true, true>(lds, g, S, E, tid);
        } break;
        case 2: att::attn_phase(lds, kp, HP, MC, vcu, G, tid); break;
        case 9: mix1::ret_kv_phase(lds, HP, (float*)(ws + WS_Y), vcu, G, tid);
                mix1::sgu_phase(lds, HP, (const bf16_t*)(ws + WS_SGUW), kin(kp, 12), kin(kp, 13), kin(kp, 15), MC, vcu, G, tid); break;
        case 10: mix1::ret_scan_phase((const float*)(ws + WS_Y), (bf16_t*)(ws + WS_Y + 64 * MiB), vcu, G, tid); break;
        case 11: mix1::ret_out_phase(lds, HP, (const bf16_t*)(ws + WS_Y + 64 * MiB), kin(kp, 10), kin(kp, 11), MC, vcu, G, tid); break;
        default: break;
        }
        if (ph + 1 < a.ph_hi) xcd_barrier(bar);
    }
}
extern "C" void kernel_launch(void* const* d_in, const int* in_sizes, int n_in, void* d_out, int out_size, void* d_ws, size_t ws_size, hipStream_t stream) {
    static int grid = 0;
    if (grid == 0) {
        if (n_in != 24 || ws_size < WS_END || out_size != MTOK * DM) { fprintf(stderr, "kernel_launch: unexpected shapes (n_in %d ws %zu out %d)\n", n_in, ws_size, out_size); grid = -1; return; }
        int dev = 0, cus = 0, per_cu = 0;
        hipGetDevice(&dev); hipDeviceGetAttribute(&cus, hipDeviceAttributeMultiprocessorCount, dev);
        if (hipFuncSetAttribute((const void*)mk_fwd, hipFuncAttributeMaxDynamicSharedMemorySize, LDS_BYTES) != hipSuccess) { fprintf(stderr, "hipFuncSetAttribute failed\n"); grid = -1; return; }
        hipOccupancyMaxActiveBlocksPerMultiprocessor(&per_cu, (const void*)mk_fwd, NTHR, LDS_BYTES);
        if (per_cu < 1) { fprintf(stderr, "occupancy query says %d blocks/CU\n", per_cu); }
        (void)hipGetLastError();
        grid = cus;
    }
    if (grid < 0) return;
    const float* const* in = (const float* const*)d_in;
    unsigned char* ws = (unsigned char*)d_ws;
    bf16_t* HP = (bf16_t*)(ws + WS_HP); bf16_t* MC = (bf16_t*)(ws + WS_MC); float* Y = (float*)(ws + WS_Y);
    Args a{};
    for (int i = 0; i < 24; ++i) a.in[i] = in[i];
    a.out = (float*)d_out; a.ws = ws;
    auto run = [&](int lo, int hi) { a.ph_lo = lo; a.ph_hi = hi; hipLaunchKernelGGL(mk_fwd, dim3(grid), dim3(NTHR), LDS_BYTES, stream, a); };
#if defined(MK_PER_PHASE)
    for (int ph = 0; ph < NPHASE; ++ph) run(ph, ph + 1);
#else
    hipMemsetAsync(ws + WS_CTL, 0, 65536, stream);
    run(0, NPHASE);
#endif
}
```

```cpp
#include <hip/hip_runtime.h>
#include <cstdio>
#include <cstdint>

typedef unsigned short bf16_t;
#define DEV __device__ __forceinline__

constexpr int BATCH = 4, SEQ = 8192, DM = 1024, MTOK = BATCH * SEQ;
constexpr int IN_EVEN = 3072, IN_ODD = 2560, DFF = 2816;
constexpr float ALPHA = 1.4142135623730951f, LN_EPS = 1e-5f;

constexpr size_t MiB = 1u << 20;
constexpr size_t WS_CTL = 0;
constexpr size_t WS_WINE = 1 * MiB;
constexpr size_t WS_WOUTE = 7 * MiB;
constexpr size_t WS_WINO = 9 * MiB;
constexpr size_t WS_WOUTO = 14 * MiB;
constexpr size_t WS_WGU0 = 16 * MiB;
constexpr size_t WS_WDN0 = 27 * MiB;
constexpr size_t WS_WGU1 = 33 * MiB;
constexpr size_t WS_WDN1 = 44 * MiB;
constexpr size_t WS_SGUW = 50 * MiB;
constexpr size_t WS_KN2 = 50 * MiB + 512 * 1024;
constexpr size_t WS_XB = 52 * MiB;
constexpr size_t WS_HP = 116 * MiB;
constexpr size_t WS_MC = 308 * MiB;
constexpr size_t WS_Y = 372 * MiB;
constexpr size_t WS_END = 500 * MiB;

DEV float bf2f(bf16_t v) { return __uint_as_float(((unsigned)v) << 16); }
DEV bf16_t f2bf(float f) { unsigned u = __float_as_uint(f); return (bf16_t)((u + 0x7fffu + ((u >> 16) & 1u)) >> 16); }
DEV float gelu_tanh(float x) { const float u = 0.7978845608028654f * (x + 0.044715f * x * x * x); return x / (1.f + __expf(-2.f * u)); }
DEV float silu(float x) { return x / (1.f + __expf(-x)); }

__global__ void __launch_bounds__(256) nv_wt(const float* W, int K, int N, bf16_t* WT, int mode) {
    __shared__ float t[32][33];
    const int n0 = blockIdx.x * 32, k0 = blockIdx.y * 32, tx = threadIdx.x & 31, ty = threadIdx.x >> 5;
    for (int i = ty; i < 32; i += 8) t[i][tx] = W[(size_t)(k0 + i) * N + n0 + tx];
    __syncthreads();
    for (int i = ty; i < 32; i += 8) { const int n = n0 + i; const int r = mode == 0 ? n : (256 * (n >> 7) + (n & 127) + (mode == 2 ? 128 : 0));
        WT[(size_t)r * K + k0 + tx] = f2bf(t[tx][i]); }
}
__global__ void __launch_bounds__(256) nv_cvt(const float* x, bf16_t* o, size_t n) {
    size_t i = (size_t)blockIdx.x * 256 + threadIdx.x; const size_t st = (size_t)gridDim.x * 256;
    for (; i < n; i += st) o[i] = f2bf(x[i]);
}
struct GE { int mode; bf16_t* outb; float* outf; const float* resid; int ldc; int gelu_from; };
__global__ void __launch_bounds__(256) nv_gemm(const bf16_t* A, const bf16_t* Bt, int K, GE e) {
    __shared__ float As[64][33], Bs[64][33], Bs2[64][33];
    const int tid = threadIdx.x, tx = tid & 15, ty = tid >> 4, row0 = blockIdx.y * 64, col0 = blockIdx.x * 64;
    const bool dual = e.mode == 1;
    float acc[4][4], acc2[4][4];
#pragma unroll
    for (int i = 0; i < 4; ++i)
#pragma unroll
        for (int j = 0; j < 4; ++j) { acc[i][j] = 0.f; acc2[i][j] = 0.f; }
    for (int k0 = 0; k0 < K; k0 += 32) {
        for (int i = tid; i < 2048; i += 256) { const int r = i >> 5, c = i & 31;
            As[r][c] = bf2f(A[(size_t)(row0 + r) * K + k0 + c]);
            const int col = col0 + r, br = dual ? (256 * (col >> 7) + (col & 127)) : col;
            Bs[r][c] = bf2f(Bt[(size_t)br * K + k0 + c]);
            if (dual) Bs2[r][c] = bf2f(Bt[(size_t)(br + 128) * K + k0 + c]); }
        __syncthreads();
#pragma unroll 4
        for (int kk = 0; kk < 32; ++kk) {
            float a[4], b[4], b2[4];
#pragma unroll
            for (int i = 0; i < 4; ++i) { a[i] = As[ty * 4 + i][kk]; b[i] = Bs[tx * 4 + i][kk]; b2[i] = dual ? Bs2[tx * 4 + i][kk] : 0.f; }
#pragma unroll
            for (int i = 0; i < 4; ++i)
#pragma unroll
                for (int j = 0; j < 4; ++j) { acc[i][j] += a[i] * b[j]; acc2[i][j] += a[i] * b2[j]; }
        }
        __syncthreads();
    }
#pragma unroll
    for (int i = 0; i < 4; ++i)
#pragma unroll
        for (int j = 0; j < 4; ++j) {
            const int r = row0 + ty * 4 + i, c = col0 + tx * 4 + j; const size_t o = (size_t)r * e.ldc + c;
            if (e.mode == 0) { float v = acc[i][j]; if (c >= e.gelu_from) v = gelu_tanh(v); e.outb[o] = f2bf(v); }
            else if (e.mode == 1) { e.outb[o] = f2bf(silu(acc[i][j]) * acc2[i][j]); }
            else { e.outf[o] = ALPHA * e.resid[o] + acc[i][j]; }
        }
}
__global__ void __launch_bounds__(256) nv_ln(const float* Y, const float* g, const float* b, float* XF, bf16_t* XB) {
    const int row = blockIdx.x * 4 + (threadIdx.x >> 6), lane = threadIdx.x & 63;
    const float* y = Y + (size_t)row * DM; float v[16]; float s = 0.f;
#pragma unroll
    for (int j = 0; j < 16; ++j) { v[j] = y[lane + 64 * j]; s += v[j]; }
#pragma unroll
    for (int o = 1; o < 64; o <<= 1) s += __shfl_xor(s, o);
    const float mean = s * (1.f / DM); float q = 0.f;
#pragma unroll
    for (int j = 0; j < 16; ++j) { v[j] -= mean; q += v[j] * v[j]; }
#pragma unroll
    for (int o = 1; o < 64; o <<= 1) q += __shfl_xor(q, o);
    const float rstd = rsqrtf(q * (1.f / DM) + LN_EPS);
#pragma unroll
    for (int j = 0; j < 16; ++j) { const int c = lane + 64 * j; const float o = v[j] * rstd * g[c] + b[c]; XF[(size_t)row * DM + c] = o; XB[(size_t)row * DM + c] = f2bf(o); }
}
template <int MODE, int DVS> __global__ void __launch_bounds__(256) nv_attn(const bf16_t* HP, float* OT, bf16_t* MC, const float* relb) {
    const int tid = threadIdx.x, qi = tid & 63, es = tid >> 6, c = blockIdx.x;
    int b, h, m = 0;
    if (MODE == 0) { m = blockIdx.y & 1; h = (blockIdx.y >> 1) & 3; b = blockIdx.y >> 3; } else { h = blockIdx.y & 7; b = blockIdx.y >> 3; }
    const int tq = c * 64 + qi;
    const bf16_t* base = HP + (size_t)b * SEQ * IN_EVEN;
    int qcol, kcol, vcol;
    if (MODE == 0) { qcol = h * 128 + m * 64; kcol = 512 + h * 128 + m * 64; vcol = 1024 + h * 128 + es * DVS; }
    else { qcol = 1536 + h * 64; kcol = 2048 + h * 64; vcol = 2560 + h * 64 + es * DVS; }
    float q[64];
#pragma unroll
    for (int d = 0; d < 64; ++d) q[d] = bf2f(base[(size_t)tq * IN_EVEN + qcol + d]) * 0.125f;
    float o[DVS];
#pragma unroll
    for (int e = 0; e < DVS; ++e) o[e] = 0.f;
    float mx = -1e30f, l = 0.f;
    const int k_lo = MODE == 0 ? 0 : ((c - 8) * 64 > 0 ? (c - 8) * 64 : 0), k_hi = (c + 1) * 64;
    const float slope = exp2f(-2.0f * (float)(h + 1));
    for (int key = k_lo; key < k_hi; ++key) {
        const bf16_t* kr = base + (size_t)key * IN_EVEN + kcol;
        float s = 0.f;
#pragma unroll
        for (int d = 0; d < 64; ++d) s += q[d] * bf2f(kr[d]);
        if (MODE == 0) s -= slope * fabsf((float)(tq - key));
        else { int rel = tq - key; rel = rel < -128 ? -128 : (rel > 128 ? 128 : rel); s += relb[h * 257 + rel + 128]; }
        if (s > mx) { const float f = expf(mx - s); l *= f;
#pragma unroll
            for (int e = 0; e < DVS; ++e) o[e] *= f;
            mx = s; }
        const float p = expf(s - mx); l += p;
        const bf16_t* vr = base + (size_t)key * IN_EVEN + vcol;
#pragma unroll
        for (int e = 0; e < DVS; ++e) o[e] += p * bf2f(vr[e]);
    }
    const float inv = 1.f / l; const size_t tok = (size_t)b * SEQ + tq;
#pragma unroll
    for (int e = 0; e < DVS; ++e) {
        if (MODE == 0) OT[((size_t)m * MTOK + tok) * 512 + h * 128 + es * DVS + e] = o[e] * inv;
        else MC[tok * DM + 512 + h * 64 + es * DVS + e] = f2bf(o[e] * inv);
    }
}
__global__ void __launch_bounds__(256) nv_diff_combine(const float* OT, const float* lq1, const float* lk1, const float* lq2, const float* lk2, const float* g, bf16_t* MC) {
    const int i = blockIdx.x * 256 + threadIdx.x; const int tok = i >> 2, h = i & 3;
    float s1 = 0.f, s2 = 0.f;
    for (int d = 0; d < 64; ++d) { s1 += lq1[d] * lk1[d]; s2 += lq2[d] * lk2[d]; }
    const float lam = expf(s1) - expf(s2) + 0.2f;
    const float* o1 = OT + (size_t)tok * 512 + h * 128; const float* o2 = o1 + (size_t)MTOK * 512;
    float ss = 0.f;
    for (int e = 0; e < 128; ++e) { const float d = o1[e] - lam * o2[e]; ss += d * d; }
    const float r = rsqrtf(ss * (1.f / 128.f) + LN_EPS) * 0.8f;
    for (int e = 0; e < 128; ++e) { const float d = o1[e] - lam * o2[e]; MC[(size_t)tok * DM + h * 128 + e] = f2bf(d * r * g[e]); }
}
__global__ void __launch_bounds__(128) nv_ret(const bf16_t* HP, float* OT) {
    const int b = blockIdx.x >> 2, h = blockIdx.x & 3, e = threadIdx.x;
    const float gamma = 1.f - exp2f(-5.f - (float)h);
    float S[64];
#pragma unroll
    for (int d = 0; d < 64; ++d) S[d] = 0.f;
    for (int t = 0; t < SEQ; ++t) {
        const bf16_t* row = HP + ((size_t)b * SEQ + t) * IN_ODD;
        const float v = bf2f(row[512 + h * 128 + e]); float o = 0.f;
#pragma unroll
        for (int d = 0; d < 64; ++d) { const float kd = bf2f(row[256 + h * 64 + d]) * 0.125f; S[d] = gamma * S[d] + kd * v; o += bf2f(row[h * 64 + d]) * S[d]; }
        OT[((size_t)b * SEQ + t) * 512 + h * 128 + e] = o;
    }
}
__global__ void __launch_bounds__(256) nv_gn_gate(const float* OT, const bf16_t* HP, const float* g, const float* bb, bf16_t* MC) {
    const int i = blockIdx.x * 256 + threadIdx.x; const int tok = i >> 2, h = i & 3;
    const float* o = OT + (size_t)tok * 512 + h * 128; float s = 0.f;
    for (int e = 0; e < 128; ++e) s += o[e];
    const float mu = s * (1.f / 128.f); float q = 0.f;
    for (int e = 0; e < 128; ++e) { const float d = o[e] - mu; q += d * d; }
    const float r = rsqrtf(q * (1.f / 128.f) + LN_EPS);
    for (int e = 0; e < 128; ++e) { const int c = h * 128 + e; const float y = (o[e] - mu) * r * g[c] + bb[c]; const float gt = bf2f(HP[(size_t)tok * IN_ODD + 1024 + c]);
        MC[(size_t)tok * DM + c] = f2bf(y * silu(gt)); }
}
__global__ void __launch_bounds__(256) nv_sgu_ln(const bf16_t* HP, const float* g, const float* bb, float* VN) {
    const int tok = blockIdx.x * 256 + threadIdx.x; const bf16_t* v = HP + (size_t)tok * IN_ODD + 2048; float s = 0.f;
    for (int c = 0; c < 512; ++c) s += bf2f(v[c]);
    const float mu = s * (1.f / 512.f); float q = 0.f;
    for (int c = 0; c < 512; ++c) { const float d = bf2f(v[c]) - mu; q += d * d; }
    const float r = rsqrtf(q * (1.f / 512.f) + LN_EPS);
    for (int c = 0; c < 512; ++c) VN[(size_t)tok * 512 + c] = (bf2f(v[c]) - mu) * r * g[c] + bb[c];
}
__global__ void __launch_bounds__(256) nv_sgu_mix(const float* VN, const bf16_t* HP, const float* W, const float* bs, bf16_t* MC) {
    const int chunk = blockIdx.x, g = blockIdx.y, c = threadIdx.x & 127, th = threadIdx.x >> 7;
    for (int t = th * 64; t < th * 64 + 64; ++t) {
        float acc = 0.f; const float* w = W + ((size_t)g * 128 + t) * 128;
        for (int s = 0; s <= t; ++s) acc += w[s] * VN[((size_t)chunk * 128 + s) * 512 + g * 128 + c];
        const size_t tok = (size_t)chunk * 128 + t; const float u = bf2f(HP[tok * IN_ODD + 1536 + g * 128 + c]);
        MC[tok * DM + 512 + g * 128 + c] = f2bf(u * (acc + bs[g * 128 + t]));
    }
}

namespace pg8 {
#define PG8_LAS __attribute__((address_space(3)))
typedef unsigned short bf16_t;
typedef short bf16x8 __attribute__((ext_vector_type(8)));
typedef float f32x4 __attribute__((ext_vector_type(4)));
typedef unsigned u32x4 __attribute__((ext_vector_type(4)));
constexpr int BM = 256, BK = 64, HALF = 128, HTB = HALF * BK * 2  , STAGE_BYTES = 8 * HTB, NXCD = 8, WGM = 8;

__host__ __device__ __forceinline__ int lds_byte(int r, int c) { const int st = (r >> 4) * 2 + (c >> 5), rr = r & 15, cc = c & 31, ob = rr * 64 + cc * 2; return st * 1024 + (ob ^ (((ob >> 9) & 1) << 5)); }
__host__ __device__ __forceinline__ void stage_rc(int b, int& R, int& C) { const int st = b / 1024, sb = b % 1024, swz = sb ^ (((sb >> 9) & 1) << 5); R = (st >> 1) * 16 + swz / 64; C = (st & 1) * 32 + (swz % 64) / 2; }
__host__ __device__ __forceinline__ int perm32(int rho) { const int n = rho >> 4, i = rho & 15; return 8 * (i >> 2) + 4 * n + (i & 3); }

struct Unit { int pm, pn; };
struct Gemm { const bf16_t* A; const bf16_t* Bt; int M, N, K; };

struct StaticOrder {
    int nM, nN, nwg, G, c;
    __host__ __device__ void init(int M, int N, int G_, int c_) { nM = M / BM; nN = N / BM; nwg = nM * nN; G = G_; c = c_; }
    __host__ __device__ bool next(int i, Unit& u) const {
        const long L = (long)i * G + c; if (L >= nwg) return false;
        int wgid = (int)L; { const int q = nwg / NXCD, r = nwg % NXCD, xcd = wgid % NXCD, off = wgid / NXCD; wgid = (xcd < r ? xcd * (q + 1) : r * (q + 1) + (xcd - r) * q) + off; }
        const int nig = WGM * nN, gid = wgid / nig, fm = gid * WGM, gsz = (nM - fm) < WGM ? (nM - fm) : WGM;
        u.pm = fm + ((wgid % nig) % gsz); u.pn = (wgid % nig) / gsz; return true;
    }
    __device__ __forceinline__ void a_ready(const Unit&) const {}
    __device__ __forceinline__ void done(const Unit&) const {}
};

__device__ __forceinline__ unsigned cvt_pk_bf16(float lo, float hi) { unsigned r; asm volatile("v_cvt_pk_bf16_f32 %0, %1, %2" : "=v"(r) : "v"(lo), "v"(hi)); return r; }
__device__ __forceinline__ float e_gelu(float x) { const float u = 0.7978845608028654f * (x + 0.044715f * x * x * x); return x * __builtin_amdgcn_rcpf(1.f + __builtin_amdgcn_exp2f(-2.885390081777927f * u)); }
__device__ __forceinline__ float e_silu(float x) { return x * __builtin_amdgcn_rcpf(1.f + __builtin_amdgcn_exp2f(-1.4426950408889634f * x)); }
struct EpiBf16G {
    static constexpr bool PERM = true, AFTER_DRAIN = false;
    bf16_t* O; int ldc; int gelu_from_tile;
    __device__ __forceinline__ void operator()(const f32x4 (&acc)[2][2][4][2], const Unit& u, int wr, int wc, int fr, int fq) const {
        const int row0 = u.pm * BM + wr * 64 + fr, col0 = u.pn * BM + wc * 32 + 8 * fq; const bool g = u.pn >= gelu_from_tile;
#pragma unroll
        for (int ai = 0; ai < 2; ++ai)
#pragma unroll
            for (int m = 0; m < 4; ++m) { bf16_t* rowp = O + (size_t)(row0 + ai * HALF + m * 16) * ldc + col0;
#pragma unroll
                for (int bj = 0; bj < 2; ++bj) { f32x4 v0 = acc[ai][bj][m][0], v1 = acc[ai][bj][m][1];
                    if (g) {
#pragma unroll
                        for (int i = 0; i < 4; ++i) { v0[i] = e_gelu(v0[i]); v1[i] = e_gelu(v1[i]); } }
                    u32x4 w; w.x = cvt_pk_bf16(v0[0], v0[1]); w.y = cvt_pk_bf16(v0[2], v0[3]); w.z = cvt_pk_bf16(v1[0], v1[1]); w.w = cvt_pk_bf16(v1[2], v1[3]);
                    *(u32x4*)(rowp + bj * HALF) = w; } }
    }
};
struct EpiSwiglu {
    static constexpr bool PERM = true, AFTER_DRAIN = false;
    bf16_t* O; int ldc;
    __device__ __forceinline__ void operator()(const f32x4 (&acc)[2][2][4][2], const Unit& u, int wr, int wc, int fr, int fq) const {
        const int row0 = u.pm * BM + wr * 64 + fr, col0 = u.pn * HALF + wc * 32 + 8 * fq;
#pragma unroll
        for (int ai = 0; ai < 2; ++ai)
#pragma unroll
            for (int m = 0; m < 4; ++m) { bf16_t* rowp = O + (size_t)(row0 + ai * HALF + m * 16) * ldc + col0;
                f32x4 h0, h1;
#pragma unroll
                for (int i = 0; i < 4; ++i) { h0[i] = e_silu(acc[ai][0][m][0][i]) * acc[ai][1][m][0][i]; h1[i] = e_silu(acc[ai][0][m][1][i]) * acc[ai][1][m][1][i]; }
                u32x4 w; w.x = cvt_pk_bf16(h0[0], h0[1]); w.y = cvt_pk_bf16(h0[2], h0[3]); w.z = cvt_pk_bf16(h1[0], h1[1]); w.w = cvt_pk_bf16(h1[2], h1[3]);
                *(u32x4*)rowp = w; }
    }
};
struct EpiResid {
    static constexpr bool PERM = false, AFTER_DRAIN = false;
    const float* R; float* Y; int ldc; float alpha;
    __device__ __forceinline__ void operator()(const f32x4 (&acc)[2][2][4][2], const Unit& u, int wr, int wc, int fr, int fq) const {
        const int row0 = u.pm * BM + wr * 64 + fr, col0 = u.pn * BM + wc * 32 + 4 * fq;
#pragma unroll
        for (int ai = 0; ai < 2; ++ai)
#pragma unroll
            for (int m = 0; m < 4; ++m) { const size_t off = (size_t)(row0 + ai * HALF + m * 16) * ldc + col0;
#pragma unroll
                for (int bj = 0; bj < 2; ++bj)
#pragma unroll
                    for (int n = 0; n < 2; ++n) { const f32x4 r = *(const f32x4*)(R + off + bj * HALF + n * 16); *(f32x4*)(Y + off + bj * HALF + n * 16) = r * alpha + acc[ai][bj][m][n]; }
                if (m & 1) asm volatile("" ::: "memory"); }
    }
};
template <class Epi, class Sched, bool ALIGN_EPI = false, bool SP2 = false>
__device__ __forceinline__ void gemm_phase(PG8_LAS unsigned char* lds, const Gemm g, const Sched& S, const Epi& E, const int tid) {
    const int wid = __builtin_amdgcn_readfirstlane(tid >> 6), lane = tid & 63, wr = wid >> 2, wc = wid & 3, fr = lane & 15, fq = lane >> 4;
    const int K = g.K, nt = K / BK;
    unsigned voffA[2], voffB[2];
#pragma unroll
    for (int i = 0; i < 2; ++i) { int R, C; stage_rc(tid * 16 + i * 8192, R, C); const int Rb = Epi::PERM ? ((R & ~31) + perm32(R & 31)) : R;
        voffA[i] = (unsigned)(R * K + C) * 2u; voffB[i] = (unsigned)(Rb * K + C) * 2u; }
    const size_t kstep = (size_t)(BK * 2);
    const size_t hstep = (size_t)HALF * K * 2;
    const size_t tstep = 2 * hstep;
    const unsigned ldsw = (unsigned)wid * 1024u;
    const int aoff = lds_byte(wr * 64 + fr, fq * 8), boff = lds_byte(wc * 32 + fr, fq * 8);
#define PG8_SA(b, h) (((b) * 2 + (h)) * HTB)
#define PG8_SB(b, h) ((4 + (b) * 2 + (h)) * HTB)
#define PG8_STAGE(bufoff, gbase, voff) do { _Pragma("unroll") for (int _i = 0; _i < 2; ++_i) \
        __builtin_amdgcn_global_load_lds((const unsigned*)((const char*)(gbase) + (voff)[_i]), (PG8_LAS unsigned*)(lds + (bufoff) + ldsw + _i * 8192), 16, 0, 0); } while (0)
#define PG8_LDA(dst, b, h) do { _Pragma("unroll") for (int m = 0; m < 4; ++m) _Pragma("unroll") for (int k = 0; k < 2; ++k) dst[m][k] = *(const PG8_LAS bf16x8*)(lds + PG8_SA(b, h) + aoff + m * 2048 + k * 1024); } while (0)
#define PG8_LDB(dst, b, h) do { _Pragma("unroll") for (int n = 0; n < 2; ++n) _Pragma("unroll") for (int k = 0; k < 2; ++k) dst[n][k] = *(const PG8_LAS bf16x8*)(lds + PG8_SB(b, h) + boff + n * 2048 + k * 1024); } while (0)
#define PG8_MMA(ai, bj, At, Bt) do { __builtin_amdgcn_s_setprio(1); _Pragma("unroll") for (int m = 0; m < 4; ++m) _Pragma("unroll") for (int n = 0; n < 2; ++n) _Pragma("unroll") for (int k = 0; k < 2; ++k) \
        acc[ai][bj][m][n] = __builtin_amdgcn_mfma_f32_16x16x32_bf16(Bt[n][k], At[m][k], acc[ai][bj][m][n], 0, 0, 0); __builtin_amdgcn_s_setprio(0); } while (0)
#define PG8_WAIT_V(n) asm volatile("s_waitcnt vmcnt(" #n ")" ::: "memory")
#define PG8_WAIT_L(n) asm volatile("s_waitcnt lgkmcnt(" #n ")" ::: "memory")
#define PG8_BAR __builtin_amdgcn_s_barrier()
#define PG8_SCHED __builtin_amdgcn_sched_barrier(0)
    Unit cur, nxt; int ui = 0;
    if (!S.next(0, cur)) return;
    f32x4 acc[2][2][4][2];
#pragma unroll
    for (int a = 0; a < 2; ++a)
#pragma unroll
        for (int b = 0; b < 2; ++b)
#pragma unroll
            for (int m = 0; m < 4; ++m)
#pragma unroll
                for (int n = 0; n < 2; ++n) acc[a][b][m][n] = (f32x4){0.f, 0.f, 0.f, 0.f};
    bf16x8 At[4][2], B0[2][2], B1[2][2];
    const char* cA = (const char*)g.A + (size_t)cur.pm * tstep; const char* cB = (const char*)g.Bt + (size_t)cur.pn * tstep;
    S.a_ready(cur);
    if constexpr (SP2) {
        PG8_STAGE(PG8_SB(0, 0), cB, voffB); PG8_STAGE(PG8_SB(0, 1), cB + hstep, voffB); PG8_STAGE(PG8_SA(0, 0), cA, voffA); PG8_STAGE(PG8_SA(0, 1), cA + hstep, voffA);
        if (wr == 1) PG8_BAR;
        PG8_WAIT_V(2); PG8_BAR;
        PG8_STAGE(PG8_SB(1, 0), cB + kstep, voffB); PG8_STAGE(PG8_SA(1, 0), cA + kstep, voffA); PG8_STAGE(PG8_SB(1, 1), cB + hstep + kstep, voffB);
        PG8_WAIT_V(6); PG8_BAR;
    } else {
        PG8_STAGE(PG8_SB(0, 0), cB, voffB); PG8_STAGE(PG8_SA(0, 0), cA, voffA); PG8_STAGE(PG8_SB(0, 1), cB + hstep, voffB); PG8_STAGE(PG8_SA(0, 1), cA + hstep, voffA);
        if (wr == 1) PG8_BAR;
        PG8_WAIT_V(4); PG8_BAR;
        PG8_STAGE(PG8_SB(1, 0), cB + kstep, voffB); PG8_STAGE(PG8_SA(1, 0), cA + kstep, voffA); PG8_STAGE(PG8_SB(1, 1), cB + hstep + kstep, voffB);
        PG8_WAIT_V(6); PG8_BAR;
    }
    for (;;) {
        const bool has_next = S.next(ui + 1, nxt);
        const char* nA = has_next ? (const char*)g.A + (size_t)nxt.pm * tstep : cA; const char* nB = has_next ? (const char*)g.Bt + (size_t)nxt.pn * tstep : cB;
        for (int t = 0; t < nt; t += 2) {
            const bool last = (t == nt - 2);
            const char* a1 = cA + (size_t)(t + 1) * kstep;
            const char* a2 = last ? nA : cA + (size_t)(t + 2) * kstep; const char* b2 = last ? nB : cB + (size_t)(t + 2) * kstep;
            const char* a3 = a2 + kstep; const char* b3 = b2 + kstep;
            if (last && has_next) S.a_ready(nxt);
            if constexpr (SP2) {
            PG8_LDB(B0, 0, 0); PG8_LDB(B1, 0, 1); PG8_SCHED; PG8_LDA(At, 0, 0); PG8_STAGE(PG8_SA(1, 1), a1 + hstep, voffA);
            PG8_WAIT_V(8); PG8_WAIT_L(0); PG8_BAR; PG8_MMA(0, 0, At, B0); PG8_MMA(0, 1, At, B1); PG8_BAR; PG8_SCHED;
            PG8_LDA(At, 0, 1); PG8_STAGE(PG8_SB(0, 0), b2, voffB); PG8_STAGE(PG8_SB(0, 1), b2 + hstep, voffB); PG8_STAGE(PG8_SA(0, 0), a2, voffA);
            PG8_WAIT_V(8); PG8_WAIT_L(0); PG8_BAR; PG8_MMA(1, 0, At, B0); PG8_MMA(1, 1, At, B1); PG8_BAR; PG8_SCHED;
            PG8_LDB(B0, 1, 0); PG8_LDB(B1, 1, 1); PG8_SCHED; PG8_LDA(At, 1, 0); PG8_STAGE(PG8_SA(0, 1), a2 + hstep, voffA);
            PG8_WAIT_V(8); PG8_WAIT_L(0); PG8_BAR; PG8_MMA(0, 0, At, B0); PG8_MMA(0, 1, At, B1); PG8_BAR; PG8_SCHED;
            PG8_LDA(At, 1, 1); PG8_STAGE(PG8_SB(1, 0), b3, voffB); PG8_STAGE(PG8_SB(1, 1), b3 + hstep, voffB); PG8_STAGE(PG8_SA(1, 0), a3, voffA);
            PG8_WAIT_V(8); PG8_WAIT_L(0); PG8_BAR; PG8_MMA(1, 0, At, B0); PG8_MMA(1, 1, At, B1); PG8_BAR; PG8_SCHED;
            } else {
            PG8_LDB(B0, 0, 0); PG8_SCHED; PG8_LDA(At, 0, 0); PG8_STAGE(PG8_SA(1, 1), a1 + hstep, voffA);
            PG8_WAIT_L(8); PG8_BAR; PG8_WAIT_L(0); PG8_MMA(0, 0, At, B0); PG8_BAR; PG8_SCHED;
            PG8_LDB(B1, 0, 1); PG8_STAGE(PG8_SB(0, 0), b2, voffB);
            PG8_BAR; PG8_WAIT_L(0); PG8_MMA(0, 1, At, B1); PG8_BAR;
            PG8_LDA(At, 0, 1); PG8_STAGE(PG8_SA(0, 0), a2, voffA);
            PG8_BAR; PG8_WAIT_L(0); PG8_MMA(1, 0, At, B0); PG8_BAR; PG8_SCHED;
            PG8_STAGE(PG8_SB(0, 1), b2 + hstep, voffB);
            PG8_WAIT_V(6); PG8_BAR; PG8_MMA(1, 1, At, B1); PG8_BAR;
            PG8_LDB(B0, 1, 0); PG8_SCHED; PG8_LDA(At, 1, 0); PG8_STAGE(PG8_SA(0, 1), a2 + hstep, voffA);
            PG8_WAIT_L(8); PG8_BAR; PG8_WAIT_L(0); PG8_MMA(0, 0, At, B0); PG8_BAR; PG8_SCHED;
            PG8_LDB(B1, 1, 1); PG8_STAGE(PG8_SB(1, 0), b3, voffB);
            PG8_BAR; PG8_WAIT_L(0); PG8_MMA(0, 1, At, B1); PG8_BAR;
            PG8_LDA(At, 1, 1); PG8_STAGE(PG8_SA(1, 0), a3, voffA);
            PG8_BAR; PG8_WAIT_L(0); PG8_MMA(1, 0, At, B0); PG8_BAR; PG8_SCHED;
            PG8_STAGE(PG8_SB(1, 1), b3 + hstep, voffB);
            PG8_WAIT_V(6); PG8_BAR; PG8_MMA(1, 1, At, B1); PG8_BAR;
            }
        }
        if constexpr (ALIGN_EPI) { if (wr == 0) PG8_BAR; }
        if constexpr (!Epi::AFTER_DRAIN) { E(acc, cur, wr, wc, fr, fq); S.done(cur); }
        if (!has_next) break;
#pragma unroll
        for (int a = 0; a < 2; ++a)
#pragma unroll
            for (int b = 0; b < 2; ++b)
#pragma unroll
                for (int m = 0; m < 4; ++m)
#pragma unroll
                    for (int n = 0; n < 2; ++n) acc[a][b][m][n] = (f32x4){0.f, 0.f, 0.f, 0.f};
        cur = nxt; cA = nA; cB = nB; ++ui;
        if constexpr (ALIGN_EPI) { if (wr == 1) PG8_BAR; }
    }
    PG8_WAIT_V(0);
    if constexpr (!ALIGN_EPI) { if (wr == 0) PG8_BAR; }
    PG8_BAR;
    if constexpr (Epi::AFTER_DRAIN) { E.fused(acc, cur, wr, wc, fr, fq, lds, wid, lane); S.done(cur); }
#undef PG8_SA
#undef PG8_SB
#undef PG8_STAGE
#undef PG8_LDA
#undef PG8_LDB
#undef PG8_MMA
#undef PG8_WAIT_V
#undef PG8_WAIT_L
#undef PG8_BAR
#undef PG8_SCHED
}
}
#define LAS __attribute__((address_space(3)))
typedef float f32x4 __attribute__((ext_vector_type(4)));
typedef unsigned u32x4 __attribute__((ext_vector_type(4)));
typedef unsigned u32x2 __attribute__((ext_vector_type(2)));
constexpr int NWAVES = 8, NTHR = 512;
constexpr int LDS_BYTES = 147456;
constexpr int NPHASE = 17;
#ifndef PROBE_DUP
#define PROBE_DUP 0u
#endif

struct Args { const float* in[24]; float* out; unsigned char* ws; int ph_lo, ph_hi; };
typedef const __attribute__((address_space(4))) unsigned char* kptr_t;
DEV const float* kin(kptr_t kp, int k) { return *(const float* const __attribute__((address_space(4)))*)(kp + 8 * k); }
DEV float* kout(kptr_t kp) { return *(float* const __attribute__((address_space(4)))*)(kp + 192); }
DEV unsigned char* kws(kptr_t kp) { return *(unsigned char* const __attribute__((address_space(4)))*)(kp + 200); }
static_assert(sizeof(Args) == 216, "Args layout");

DEV float wave_sum(float v) {
#pragma unroll
    for (int o = 1; o < 64; o <<= 1) v += __shfl_xor(v, o);
    return v;
}
DEV unsigned pk2(float lo, float hi) { return pg8::cvt_pk_bf16(lo, hi); }

DEV void p0_transpose_item(const float* W, int K, int N, bf16_t* WT, int mode, LAS float* scr, int item, int lane) {
    const int nblk = N / 32, kb = item / nblk, nb = item % nblk, k0 = 64 * kb, n0 = 32 * nb;
#pragma unroll 8
    for (int i = 0; i < 32; ++i) { const int kk = 2 * i + (lane >> 5); scr[kk * 33 + (lane & 31)] = W[(size_t)(k0 + kk) * N + n0 + (lane & 31)]; }
    asm volatile("s_waitcnt lgkmcnt(0)" ::: "memory");
    const int c = lane & 7;
#pragma unroll
    for (int j = 0; j < 4; ++j) { const int nl = (lane >> 3) + 8 * j, n = n0 + nl; const LAS float* s = scr + (8 * c) * 33 + nl;
        const int r = mode == 0 ? n : (256 * (n >> 7) + (n & 127) + (mode == 2 ? 128 : 0));
        u32x4 o; o.x = pk2(s[0 * 33], s[1 * 33]); o.y = pk2(s[2 * 33], s[3 * 33]); o.z = pk2(s[4 * 33], s[5 * 33]); o.w = pk2(s[6 * 33], s[7 * 33]);
        *(u32x4*)(WT + (size_t)r * K + k0 + 8 * c) = o; }
    asm volatile("s_waitcnt lgkmcnt(0)" ::: "memory");
}
DEV void p0_prologue(kptr_t kp, LAS unsigned char* lds, int gw, int NGW, int wave, int lane) {
    LAS float* scr = (LAS float*)(lds + wave * 16384);
    unsigned char* ws = kws(kp);
    constexpr int I_INE = (DM / 64) * (IN_EVEN / 32), I_SQ = (DM / 64) * (DM / 32), I_INO = (DM / 64) * (IN_ODD / 32), I_GU = (DM / 64) * (DFF / 32), I_DN = (DFF / 64) * (DM / 32);
    constexpr int NITEMS = I_INE + 2 * I_SQ + I_INO + 4 * I_GU + 2 * I_DN;
    for (int it = gw; it < NITEMS; it += NGW) {
        int r = it; const float* W; int K, N, mode = 0; bf16_t* dst;
        if (r < I_INE) { W = kin(kp, 1); K = DM; N = IN_EVEN; dst = (bf16_t*)(ws + WS_WINE); }
        else if ((r -= I_INE) < I_SQ) { W = kin(kp, 8); K = DM; N = DM; dst = (bf16_t*)(ws + WS_WOUTE); }
        else if ((r -= I_SQ) < I_INO) { W = kin(kp, 9); K = DM; N = IN_ODD; dst = (bf16_t*)(ws + WS_WINO); }
        else if ((r -= I_INO) < I_SQ) { W = kin(kp, 16); K = DM; N = DM; dst = (bf16_t*)(ws + WS_WOUTO); }
        else if ((r -= I_SQ) < I_GU) { W = kin(kp, 19); K = DM; N = DFF; mode = 1; dst = (bf16_t*)(ws + WS_WGU0); }
        else if ((r -= I_GU) < I_GU) { W = kin(kp, 20); K = DM; N = DFF; mode = 2; dst = (bf16_t*)(ws + WS_WGU0); }
        else if ((r -= I_GU) < I_GU) { W = kin(kp, 19) + (size_t)DM * DFF; K = DM; N = DFF; mode = 1; dst = (bf16_t*)(ws + WS_WGU1); }
        else if ((r -= I_GU) < I_GU) { W = kin(kp, 20) + (size_t)DM * DFF; K = DM; N = DFF; mode = 2; dst = (bf16_t*)(ws + WS_WGU1); }
        else if ((r -= I_GU) < I_DN) { W = kin(kp, 21); K = DFF; N = DM; dst = (bf16_t*)(ws + WS_WDN0); }
        else { r -= I_DN; W = kin(kp, 21) + (size_t)DM * DFF; K = DFF; N = DM; dst = (bf16_t*)(ws + WS_WDN1); }
        p0_transpose_item(W, K, N, dst, mode, scr, r, lane);
    }
    { bf16_t* wsb = (bf16_t*)(ws + WS_SGUW);
      for (int i = gw * 64 + lane; i < 4 * 128 * 128; i += NGW * 64) { const int t = (i >> 7) & 127, sx = i & 127; wsb[i] = sx <= t ? f2bf(kin(kp, 14)[i]) : (bf16_t)0; } }
    const f32x4* x4 = (const f32x4*)kin(kp, 0); u32x2* o2 = (u32x2*)(ws + WS_XB);
    for (size_t i = (size_t)gw * 64 + lane; i < (size_t)MTOK * DM / 4; i += (size_t)NGW * 64) { const f32x4 v = x4[i]; u32x2 w; w.x = pk2(v.x, v.y); w.y = pk2(v.z, v.w); o2[i] = w; }
}
DEV void ln_phase(const float* Y, const float* g, const float* b, float* XF, bf16_t* XB, int gw, int NGW, int lane) {
    f32x4 gv[4], bv[4];
#pragma unroll
    for (int j = 0; j < 4; ++j) { gv[j] = ((const f32x4*)g)[lane + 64 * j]; bv[j] = ((const f32x4*)b)[lane + 64 * j]; }
    for (int m = gw; m < MTOK; m += NGW) {
        const f32x4* xr = (const f32x4*)(Y + (size_t)m * DM) + lane;
        f32x4 v[4]; float s = 0.f;
#pragma unroll
        for (int j = 0; j < 4; ++j) { v[j] = xr[64 * j]; s += (v[j].x + v[j].y) + (v[j].z + v[j].w); }
        const float mean = wave_sum(s) * (1.f / DM); float s2 = 0.f;
#pragma unroll
        for (int j = 0; j < 4; ++j) { v[j] = v[j] - mean; s2 += (v[j].x * v[j].x + v[j].y * v[j].y) + (v[j].z * v[j].z + v[j].w * v[j].w); }
        const float rstd = rsqrtf(wave_sum(s2) * (1.f / DM) + LN_EPS);
        f32x4* of = (f32x4*)(XF + (size_t)m * DM) + lane; u32x2* ob = (u32x2*)(XB + (size_t)m * DM) + lane;
#pragma unroll
        for (int j = 0; j < 4; ++j) { const f32x4 o = v[j] * rstd * gv[j] + bv[j]; of[64 * j] = o; u32x2 w; w.x = pk2(o.x, o.y); w.y = pk2(o.z, o.w); ob[64 * j] = w; }
    }
}

namespace att {
typedef short bf16x8 __attribute__((ext_vector_type(8)));
typedef short s16x4 __attribute__((ext_vector_type(4)));
typedef float f32x16 __attribute__((ext_vector_type(16)));
constexpr int KROW = 272, VROW = 320;
constexpr int KT_BYTES = 64 * KROW, VT_BYTES = 64 * VROW, STAGE = KT_BYTES + VT_BYTES;
constexpr int LDS_WSF = 2 * STAGE;
constexpr int LDS_TAB = LDS_WSF + 8 * 256;
constexpr int LDS_PM = LDS_TAB + 2064;
constexpr int LDS_FLAG = LDS_PM + 1024;
constexpr int XROW = 132;
constexpr float LOG2E = 1.4426950408889634f, C1 = 0.125f * LOG2E;
constexpr float SKIP_T = 40.f;
DEV int crow(int reg, int hh) { return (reg & 3) + 8 * (reg >> 2) + 4 * hh; }
DEV s16x4 vtr(const LAS unsigned char* p) { typedef short v4i16_t __attribute__((ext_vector_type(4))); return __builtin_bit_cast(s16x4, __builtin_amdgcn_ds_read_tr16_b64_v4i16((LAS v4i16_t*)p)); }
#define ATT_SB() __builtin_amdgcn_sched_barrier(0)

DEV void knorm_phase(const bf16_t* __restrict__ HP, float* __restrict__ KN2, int gw, int NGW, int lane) {
    for (int t = gw; t < BATCH * 128; t += NGW) {
        float mx = 0.f;
        for (int st = 0; st < 8; ++st) { const u32x4* p = (const u32x4*)(HP + ((size_t)t * 64 + st * 8 + (lane >> 3)) * IN_EVEN + 512 + (lane & 7) * 64); float ss = 0.f;
#pragma unroll
            for (int j = 0; j < 8; ++j) { const u32x4 v = p[j]; const unsigned w[4] = {v.x, v.y, v.z, v.w};
#pragma unroll
                for (int q = 0; q < 4; ++q) { const float a = __uint_as_float(w[q] << 16), c = __uint_as_float(w[q] & 0xffff0000u); ss += a * a + c * c; } }
            mx = __builtin_fmaxf(mx, ss); }
        mx = __builtin_fmaxf(mx, __shfl_xor(mx, 8)); mx = __builtin_fmaxf(mx, __shfl_xor(mx, 16)); mx = __builtin_fmaxf(mx, __shfl_xor(mx, 32));
        if (lane < 8) KN2[(size_t)t * 8 + lane] = mx;
    }
}

template <int MODE> DEV void attn_unit(LAS unsigned char* lds, const bf16_t* __restrict__ HP, bf16_t* __restrict__ MC, int b, int hx, int qb, float lam, const float* __restrict__ subg, const float* __restrict__ relb, const float* __restrict__ KN2, int tid) {
    const int lane = tid & 63, wave = __builtin_amdgcn_readfirstlane(tid >> 6), g = wave >> 2, wq = wave & 3, r = lane & 31, hh = lane >> 5;
    constexpr int QOFF = MODE == 0 ? 0 : 1536, KOFF = MODE == 0 ? 512 : 2048, VOFF = MODE == 0 ? 1024 : 2560, NEB = MODE == 0 ? 4 : 2;
    const size_t row0 = (size_t)b * SEQ; const int q0 = qb * 128;
    const int cw = 2 * qb + (wq >> 1);
    const int kt_lo = MODE == 0 ? 0 : (2 * qb - 8 > 0 ? 2 * qb - 8 : 0), kt_hi = 2 * qb + 1;
    LAS float* wsf = (LAS float*)(lds + LDS_WSF) + wave * 64;
    LAS float* tab = (LAS float*)(lds + LDS_TAB);
    LAS float* PM = (LAS float*)(lds + LDS_PM);
    volatile LAS unsigned* flag = (volatile LAS unsigned*)(lds + LDS_FLAG);
    if (MODE == 1) { for (int i = tid; i < 514; i += NTHR) tab[i] = relb[(2 * hx + (i >= 257 ? 1 : 0)) * 257 + (i >= 257 ? i - 257 : i)] * LOG2E; }
    if (MODE == 0 && wq == 0) {
        float v0 = __builtin_sqrtf(KN2[((size_t)b * 128 + lane) * 8 + hx * 2 + g]), v1 = __builtin_sqrtf(KN2[((size_t)b * 128 + 64 + lane) * 8 + hx * 2 + g]);
#pragma unroll
        for (int o = 1; o < 64; o <<= 1) { const float t0 = __shfl_up(v0, o), t1 = __shfl_up(v1, o); if (lane >= o) { v0 = __builtin_fmaxf(v0, t0); v1 = __builtin_fmaxf(v1, t1); } }
        v1 = __builtin_fmaxf(v1, __shfl(v0, 63));
        PM[g * 128 + lane] = v0; PM[g * 128 + 64 + lane] = v1;
    }
    bf16x8 qf[4];
    { const bf16_t* qp = HP + (row0 + q0 + 32 * wq + r) * IN_EVEN + QOFF + hx * 128 + g * 64 + hh * 8;
#pragma unroll
      for (int ds = 0; ds < 4; ++ds) qf[ds] = *(const bf16x8*)(qp + 16 * ds); }
    float qn = 0.f;
    if (MODE == 0) { float ss = 0.f;
#pragma unroll
        for (int ds = 0; ds < 4; ++ds) { const u32x4 w4 = __builtin_bit_cast(u32x4, qf[ds]); const unsigned w[4] = {w4.x, w4.y, w4.z, w4.w};
#pragma unroll
            for (int q = 0; q < 4; ++q) { const float a = __uint_as_float(w[q] << 16), c = __uint_as_float(w[q] & 0xffff0000u); ss += a * a + c * c; } }
        ss += __shfl_xor(ss, 32); qn = __builtin_sqrtf(ss) * (C1 * 1.001f); }
    f32x16 o[NEB];
#pragma unroll
    for (int eb = 0; eb < NEB; ++eb)
#pragma unroll
        for (int i = 0; i < 16; ++i) o[eb][i] = 0.f;
    float mhat = 0.f, l = 0.f; bool first = true;
    const int tq = q0 + 32 * wq + r;
    const float sl2 = exp2f(-2.0f * (float)(hx + 1)) * LOG2E;
    const int srow = tid >> 4, scc = tid & 15;
    const bf16_t* kg = HP + (row0 + srow) * IN_EVEN + KOFF + hx * 128 + scc * 8;
    const bf16_t* vg = HP + (row0 + srow) * IN_EVEN + VOFF + hx * 128 + scc * 8;
    u32x4 kreg[2], vreg[2];
#define ATT_LOAD(kt) do { _Pragma("unroll") for (int i_ = 0; i_ < 2; ++i_) { const size_t ro_ = (size_t)(64 * (kt) + 32 * i_) * IN_EVEN; kreg[i_] = *(const u32x4*)(kg + ro_); vreg[i_] = *(const u32x4*)(vg + ro_); } } while (0)
#define ATT_STORE(buf) do { _Pragma("unroll") for (int i_ = 0; i_ < 2; ++i_) { *(LAS u32x4*)(lds + (buf) * STAGE + (srow + 32 * i_) * KROW + scc * 16) = kreg[i_]; \
        *(LAS u32x4*)(lds + (buf) * STAGE + KT_BYTES + (srow + 32 * i_) * VROW + scc * 16) = vreg[i_]; } } while (0)
    ATT_LOAD(kt_hi); ATT_STORE(0);
    __syncthreads();
    const int p15 = lane & 15, g4 = lane >> 4;
    const int vlane = (4 * hh + (p15 >> 2)) * VROW + ((MODE == 1 ? g * 64 : 0) + 16 * (g4 & 1) + 4 * (p15 & 3)) * 2;
    int it = 0;
    for (int kt = kt_hi; kt >= kt_lo; --kt, ++it) {
        const int buf = it & 1;
        if (kt > kt_lo) ATT_LOAD(kt - 1);
        const bool active = MODE == 0 ? (kt <= cw) : (kt <= cw && kt >= cw - 8);
        if (active) {
            const LAS unsigned char* Kb = lds + buf * STAGE; const LAS unsigned char* Vb = Kb + KT_BYTES;
            f32x16 s0, s1;
#pragma unroll
            for (int i = 0; i < 16; ++i) { s0[i] = 0.f; s1[i] = 0.f; }
#pragma unroll
            for (int ds = 0; ds < 4; ++ds) {
                const bf16x8 k0 = *(const LAS bf16x8*)(Kb + r * KROW + g * 128 + ds * 32 + hh * 16);
                const bf16x8 k1 = *(const LAS bf16x8*)(Kb + (32 + r) * KROW + g * 128 + ds * 32 + hh * 16);
                s0 = __builtin_amdgcn_mfma_f32_32x32x16_bf16(k0, qf[ds], s0, 0, 0, 0);
                s1 = __builtin_amdgcn_mfma_f32_32x32x16_bf16(k1, qf[ds], s1, 0, 0, 0);
            }
            bf16x8 vfa[2], vfb[2];
#define ATT_LOADV(dst, u) do { const LAS unsigned char* vp_ = Vb + vlane + (16 * ((u) / (NEB / 2))) * VROW + (2 * ((u) % (NEB / 2))) * 64; _Pragma("unroll") for (int e_ = 0; e_ < 2; ++e_) { \
        const s16x4 lo_ = vtr(vp_ + e_ * 64), hi_ = vtr(vp_ + e_ * 64 + 8 * VROW); dst[e_] = (bf16x8){lo_[0], lo_[1], lo_[2], lo_[3], hi_[0], hi_[1], hi_[2], hi_[3]}; } } while (0)
            ATT_SB(); ATT_LOADV(vfa, 0); ATT_SB();
            const int dbase = tq - (64 * kt + 4 * hh);
            if (MODE == 0) {
                const float df = (float)dbase, nm = -mhat, nsl = -sl2;
#pragma unroll
                for (int i = 0; i < 16; ++i) { const float of = (float)((i & 3) + 8 * (i >> 2));
                    s0[i] = __builtin_fmaf(s0[i], C1, __builtin_fmaf(__builtin_fabsf(df - of), nsl, nm)); s1[i] = __builtin_fmaf(s1[i], C1, __builtin_fmaf(__builtin_fabsf(df - of - 32.f), nsl, nm)); }
            } else {
                if (kt <= cw - 3) { const float tf = tab[g * 257 + 256] - mhat;
#pragma unroll
                    for (int i = 0; i < 16; ++i) { s0[i] = __builtin_fmaf(s0[i], C1, tf); s1[i] = __builtin_fmaf(s1[i], C1, tf); }
                } else {
#pragma unroll
                    for (int i = 0; i < 16; ++i) { const int off = (i & 3) + 8 * (i >> 2); int r0 = dbase - off, r1 = r0 - 32;
                        r0 = r0 < -128 ? -128 : (r0 > 128 ? 128 : r0); r1 = r1 < -128 ? -128 : (r1 > 128 ? 128 : r1);
                        s0[i] = __builtin_fmaf(s0[i], C1, tab[g * 257 + 128 + r0] - mhat); s1[i] = __builtin_fmaf(s1[i], C1, tab[g * 257 + 128 + r1] - mhat); }
                }
            }
            float rm = __builtin_fmaxf(s0[0], s1[0]);
#pragma unroll
            for (int i = 1; i < 16; ++i) rm = __builtin_fmaxf(rm, __builtin_fmaxf(s0[i], s1[i]));
            rm = __builtin_fmaxf(rm, __shfl_xor(rm, 32));
            if (first || __any(rm > 8.f)) {
                const float dl = first ? rm : __builtin_fmaxf(rm, 0.f), f = first ? 0.f : __builtin_amdgcn_exp2f(-dl); mhat += dl; l *= f;
#pragma unroll
                for (int i = 0; i < 16; ++i) { s0[i] -= dl; s1[i] -= dl; }
                if (hh == 0) wsf[r] = f;
#pragma unroll
                for (int i = 0; i < 16; ++i) { const float fr = wsf[crow(i, hh)];
#pragma unroll
                    for (int eb = 0; eb < NEB; ++eb) o[eb][i] *= fr; }
                first = false;
            }
            float ls = 0.f;
#pragma unroll
            for (int i = 0; i < 16; ++i) { s0[i] = __builtin_amdgcn_exp2f(s0[i]); s1[i] = __builtin_amdgcn_exp2f(s1[i]); ls += s0[i] + s1[i]; }
            l += ls;
            bf16x8 pa[4];
#pragma unroll
            for (int s = 0; s < 2; ++s) {
                u32x4 w0, w1;
                w0.x = pk2(s0[8 * s + 0], s0[8 * s + 1]); w0.y = pk2(s0[8 * s + 2], s0[8 * s + 3]); w0.z = pk2(s0[8 * s + 4], s0[8 * s + 5]); w0.w = pk2(s0[8 * s + 6], s0[8 * s + 7]);
                w1.x = pk2(s1[8 * s + 0], s1[8 * s + 1]); w1.y = pk2(s1[8 * s + 2], s1[8 * s + 3]); w1.z = pk2(s1[8 * s + 4], s1[8 * s + 5]); w1.w = pk2(s1[8 * s + 6], s1[8 * s + 7]);
                pa[s] = __builtin_bit_cast(bf16x8, w0); pa[2 + s] = __builtin_bit_cast(bf16x8, w1);
            }
#define ATT_MMA(vf, u) do { _Pragma("unroll") for (int e_ = 0; e_ < 2; ++e_) { const int eb_ = 2 * ((u) % (NEB / 2)) + e_; o[eb_] = __builtin_amdgcn_mfma_f32_32x32x16_bf16(pa[(u) / (NEB / 2)], vf[e_], o[eb_], 0, 0, 0); } } while (0)
            ATT_SB(); ATT_LOADV(vfb, 1); ATT_SB(); ATT_MMA(vfa, 0); ATT_SB(); ATT_LOADV(vfa, 2); ATT_SB(); ATT_MMA(vfb, 1); ATT_SB(); ATT_LOADV(vfb, 3); ATT_SB(); ATT_MMA(vfa, 2); ATT_SB();
            if constexpr (NEB == 4) { ATT_LOADV(vfa, 4); ATT_SB(); ATT_MMA(vfb, 3); ATT_SB(); ATT_LOADV(vfb, 5); ATT_SB(); ATT_MMA(vfa, 4); ATT_SB(); ATT_LOADV(vfa, 6); ATT_SB(); ATT_MMA(vfb, 5); ATT_SB(); ATT_LOADV(vfb, 7); ATT_SB(); ATT_MMA(vfa, 6); ATT_SB(); ATT_MMA(vfb, 7); ATT_SB(); }
            else { ATT_MMA(vfb, 3); ATT_SB(); }
#undef ATT_MMA
#undef ATT_LOADV
        }
        if (MODE == 0) {
            bool dn = true;
            if (kt > 0) { const float ub = qn * PM[g * 128 + kt - 1] - sl2 * (float)(tq - (64 * kt - 1)); dn = !first && (ub < mhat - SKIP_T); }
            const bool wd = __all(dn);
            if (lane == 0) flag[(it & 1) * 8 + wave] = wd ? 1u : 0u;
        }
        if (kt > kt_lo) ATT_STORE(buf ^ 1);
        __syncthreads();
        if (MODE == 0) { unsigned a = 1u;
#pragma unroll
            for (int w = 0; w < 8; ++w) a &= flag[(it & 1) * 8 + w];
            if (a) break; }
    }
#undef ATT_LOAD
#undef ATT_STORE
    l += __shfl_xor(l, 32);
    if (hh == 0) wsf[r] = 1.0f / l;
#pragma unroll
    for (int i = 0; i < 16; ++i) { const float fr = wsf[crow(i, hh)];
#pragma unroll
        for (int eb = 0; eb < NEB; ++eb) o[eb][i] *= fr; }
    LAS float* X = (LAS float*)lds;
    const int xr = 32 * wq, rrow = xr + (lane >> 1), half = lane & 1;
    const size_t tok = row0 + q0 + rrow;
    if (MODE == 0) {
        if (g == 1) {
#pragma unroll
            for (int eb = 0; eb < NEB; ++eb)
#pragma unroll
                for (int i = 0; i < 16; ++i) X[(xr + crow(i, hh)) * XROW + 32 * eb + r] = o[eb][i];
        }
        __syncthreads();
        if (g == 0) {
#pragma unroll
            for (int eb = 0; eb < NEB; ++eb)
#pragma unroll
                for (int i = 0; i < 16; ++i) { const int ix = (xr + crow(i, hh)) * XROW + 32 * eb + r; X[ix] = o[eb][i] - lam * X[ix]; }
            f32x4 v[16]; float ss = 0.f;
#pragma unroll
            for (int j = 0; j < 16; ++j) { v[j] = *(const LAS f32x4*)(X + rrow * XROW + 64 * half + 4 * j); ss += (v[j].x * v[j].x + v[j].y * v[j].y) + (v[j].z * v[j].z + v[j].w * v[j].w); }
            ss += __shfl_xor(ss, 1);
            const float rs = rsqrtf(ss * (1.f / 128.f) + LN_EPS) * 0.8f;
            bf16_t* op = MC + tok * DM + hx * 128 + 64 * half;
#pragma unroll
            for (int j = 0; j < 8; ++j) { const f32x4 g0 = *(const f32x4*)(subg + 64 * half + 8 * j), g1 = *(const f32x4*)(subg + 64 * half + 8 * j + 4); const f32x4 a0 = v[2 * j] * rs * g0, a1 = v[2 * j + 1] * rs * g1;
                u32x4 w; w.x = pk2(a0.x, a0.y); w.y = pk2(a0.z, a0.w); w.z = pk2(a1.x, a1.y); w.w = pk2(a1.z, a1.w); *(u32x4*)(op + 8 * j) = w; }
        }
    } else {
#pragma unroll
        for (int eb = 0; eb < NEB; ++eb)
#pragma unroll
            for (int i = 0; i < 16; ++i) X[(xr + crow(i, hh)) * XROW + g * 64 + 32 * eb + r] = o[eb][i];
        f32x4 v[8];
#pragma unroll
        for (int j = 0; j < 8; ++j) v[j] = *(const LAS f32x4*)(X + rrow * XROW + g * 64 + 32 * half + 4 * j);
        bf16_t* op = MC + tok * DM + 512 + hx * 128 + g * 64 + 32 * half;
#pragma unroll
        for (int j = 0; j < 4; ++j) { const f32x4 a0 = v[2 * j], a1 = v[2 * j + 1]; u32x4 w; w.x = pk2(a0.x, a0.y); w.y = pk2(a0.z, a0.w); w.z = pk2(a1.x, a1.y); w.w = pk2(a1.z, a1.w); *(u32x4*)(op + 8 * j) = w; }
    }
    __syncthreads();
}

DEV void attn_phase(LAS unsigned char* lds, kptr_t kp, const bf16_t* HP, bf16_t* MC, const float* KN2, unsigned* qctr, int tid) {
    float s1 = 0.f, s2 = 0.f;
    { const float* q1 = kin(kp, 2); const float* k1 = kin(kp, 3); const float* q2 = kin(kp, 4); const float* k2 = kin(kp, 5);
      for (int d = 0; d < 64; ++d) { s1 += q1[d] * k1[d]; s2 += q2[d] * k2[d]; } }
    const float lam = expf(s1) - expf(s2) + 0.2f;
    volatile LAS unsigned* slot = (volatile LAS unsigned*)(lds + LDS_FLAG + 64);
    for (;;) {
        if (tid == 0) *slot = __hip_atomic_fetch_add(qctr, 1u, __ATOMIC_RELAXED, __HIP_MEMORY_SCOPE_AGENT);
        __syncthreads();
        const int idx = (int)*slot;
        if (idx >= 2048) break;
        if (idx < 1024) { const int qb = 63 - (idx >> 4), hx = 3 - ((idx >> 2) & 3), b = idx & 3;
            attn_unit<0>(lds, HP, MC, b, hx, qb, lam, kin(kp, 6), nullptr, KN2, tid); }
        else { const int id = idx - 1024;
            attn_unit<1>(lds, HP, MC, id >> 8, (id >> 6) & 3, id & 63, 0.f, nullptr, kin(kp, 7), nullptr, tid); }
    }
    __syncthreads();
}
#undef ATT_SB
}

namespace mix1 {
using att::bf16x8; using att::s16x4; using att::f32x16; using att::crow; using att::vtr;
constexpr int VSTR = 1088;
constexpr float LOG2E = 1.4426950408889634f;
DEV float lg2gamma(int h) { return __builtin_log2f(1.f - __builtin_amdgcn_exp2f(-5.f - (float)h)); }
DEV bf16x8 trpair(const LAS unsigned char* p, int hi_off) { const s16x4 lo = vtr(p), hi = vtr(p + hi_off); return (bf16x8){lo[0], lo[1], lo[2], lo[3], hi[0], hi[1], hi[2], hi[3]}; }

template <int KSTR, bool KSCALE> DEV void stage_kv(LAS unsigned char* lds, const bf16_t* __restrict__ HP, size_t tok0, int tid) {
    constexpr int VOFFB = 64 * KSTR;
#pragma unroll
    for (int i = 0; i < 4; ++i) { const int ck = tid + NTHR * i, row = ck >> 5, cc = ck & 31;
        u32x4 v = *(const u32x4*)(HP + (tok0 + row) * IN_ODD + 256 + cc * 8);
        if (KSCALE) { const float f = 0.125f * __builtin_amdgcn_exp2f((float)(63 - row) * lg2gamma(cc >> 3));
            unsigned w[4] = {v.x, v.y, v.z, v.w};
#pragma unroll
            for (int j = 0; j < 4; ++j) w[j] = pk2(__uint_as_float(w[j] << 16) * f, __uint_as_float(w[j] & 0xffff0000u) * f);
            v = (u32x4){w[0], w[1], w[2], w[3]}; }
        *(LAS u32x4*)(lds + row * KSTR + cc * 16) = v; }
#pragma unroll
    for (int i = 0; i < 8; ++i) { const int ck = tid + NTHR * i, row = ck >> 6, cc = ck & 63;
        *(LAS u32x4*)(lds + VOFFB + row * VSTR + cc * 16) = *(const u32x4*)(HP + (tok0 + row) * IN_ODD + 512 + cc * 8); }
}

DEV void ret_kv_phase(LAS unsigned char* lds, const bf16_t* __restrict__ HP, float* __restrict__ KV, int vcu, int G, int tid) {
    constexpr int KSTR = 576;
    const int lane = tid & 63, wave = __builtin_amdgcn_readfirstlane(tid >> 6), h = wave >> 1, dblk = wave & 1, r = lane & 31, hh = lane >> 5, p15 = lane & 15, g4 = lane >> 4;
    const int rowl = 4 * hh + (p15 >> 2), coll = 16 * (g4 & 1) + 4 * (p15 & 3);
    for (int u = vcu; u < BATCH * 128; u += G) { const int b = u >> 7, c = u & 127; const size_t tok0 = (size_t)b * SEQ + 64 * c;
        stage_kv<KSTR, true>(lds, HP, tok0, tid);
        __syncthreads();
        f32x16 acc[4];
#pragma unroll
        for (int eb = 0; eb < 4; ++eb)
#pragma unroll
            for (int i = 0; i < 16; ++i) acc[eb][i] = 0.f;
#pragma unroll
        for (int ks = 0; ks < 4; ++ks) {
            const bf16x8 kf = trpair(lds + (16 * ks + rowl) * KSTR + (h * 64 + 32 * dblk + coll) * 2, 8 * KSTR);
#pragma unroll
            for (int eb = 0; eb < 4; ++eb) { const bf16x8 vf = trpair(lds + 64 * KSTR + (16 * ks + rowl) * VSTR + (h * 128 + 32 * eb + coll) * 2, 8 * VSTR);
                acc[eb] = __builtin_amdgcn_mfma_f32_32x32x16_bf16(vf, kf, acc[eb], 0, 0, 0); }
        }
        float* o = KV + ((size_t)((b * 4 + h) * 128 + c) * 128) * 64 + 32 * dblk + r;
#pragma unroll
        for (int eb = 0; eb < 4; ++eb)
            { float* oq = o + (32 * eb + 4 * hh) * 64;
#pragma unroll
              for (int i = 0; i < 16; ++i) { *oq = acc[eb][i]; oq += ((i & 3) == 3 ? 5 : 1) * 64; asm volatile("" : "+v"(oq)); } }
        __syncthreads();
    }
}
DEV void ret_scan_phase(const float* __restrict__ KV, bf16_t* __restrict__ PREV, int vcu, int G, int tid) {
    for (int idx = vcu * NTHR + tid; idx < 16 * 8192; idx += G * NTHR) { const int bh = idx >> 13, ed = idx & 8191;
        const float cd = __builtin_amdgcn_exp2f(64.f * lg2gamma(bh & 3)); float st = 0.f;
        const float* kv = KV + (size_t)bh * 128 * 8192 + ed; bf16_t* pv = PREV + (size_t)bh * 128 * 8192 + ed;
#pragma unroll 8
        for (int c = 0; c < 128; ++c) { const float x = kv[(size_t)c * 8192]; pv[(size_t)c * 8192] = f2bf(st); st = st * cd + x; }
    }
}
DEV void ret_out_phase(LAS unsigned char* lds, const bf16_t* __restrict__ HP, const bf16_t* __restrict__ PREV, const float* __restrict__ gng, const float* __restrict__ gnb, bf16_t* __restrict__ MC, int vcu, int G, int tid) {
    constexpr int KSTR = 528;
    const int lane = tid & 63, wave = __builtin_amdgcn_readfirstlane(tid >> 6), h = wave >> 1, lb = wave & 1, r = lane & 31, hh = lane >> 5, p15 = lane & 15, g4 = lane >> 4;
    const float lg = lg2gamma(h);
    const int vlane = 64 * KSTR + (4 * hh + (p15 >> 2)) * VSTR + (h * 128 + 16 * (g4 & 1) + 4 * (p15 & 3)) * 2;
    for (int u = vcu; u < BATCH * 128; u += G) { const int b = u >> 7, c = u & 127; const size_t tok0 = (size_t)b * SEQ + 64 * c;
        stage_kv<KSTR, false>(lds, HP, tok0, tid);
        bf16x8 qf[4];
        { const bf16_t* qp = HP + (tok0 + 32 * lb + r) * IN_ODD + h * 64 + hh * 8;
#pragma unroll
          for (int ds = 0; ds < 4; ++ds) qf[ds] = *(const bf16x8*)(qp + 16 * ds); }
        f32x16 acc[4];
        { const bf16_t* pp = PREV + ((size_t)((b * 4 + h) * 128 + c) * 128 + r) * 64 + hh * 8;
#pragma unroll
          for (int eb = 0; eb < 4; ++eb) {
#pragma unroll
              for (int i = 0; i < 16; ++i) acc[eb][i] = 0.f;
#pragma unroll
              for (int ds = 0; ds < 4; ++ds) { const bf16x8 pf = *(const bf16x8*)(pp + (size_t)(32 * eb) * 64 + 16 * ds); acc[eb] = __builtin_amdgcn_mfma_f32_32x32x16_bf16(qf[ds], pf, acc[eb], 0, 0, 0); } } }
#pragma unroll
        for (int i = 0; i < 16; ++i) { const float qd = __builtin_amdgcn_exp2f((float)(32 * lb + crow(i, hh) + 1) * lg);
#pragma unroll
            for (int eb = 0; eb < 4; ++eb) acc[eb][i] *= qd; }
        __syncthreads();
        for (int mb = 0; mb <= lb; ++mb) {
            f32x16 s;
#pragma unroll
            for (int i = 0; i < 16; ++i) s[i] = 0.f;
#pragma unroll
            for (int ds = 0; ds < 4; ++ds) { const bf16x8 kf = *(const LAS bf16x8*)(lds + (32 * mb + r) * KSTR + (h * 64 + 16 * ds + 8 * hh) * 2); s = __builtin_amdgcn_mfma_f32_32x32x16_bf16(kf, qf[ds], s, 0, 0, 0); }
            const int dbase = 32 * lb + r - 32 * mb - 4 * hh;
#pragma unroll
            for (int i = 0; i < 16; ++i) { const int df = dbase - ((i & 3) + 8 * (i >> 2)); const float w = 0.125f * __builtin_amdgcn_exp2f((float)df * lg); s[i] = df >= 0 ? s[i] * w : 0.f; }
#pragma unroll
            for (int sx = 0; sx < 2; ++sx) { u32x4 w; w.x = pk2(s[8 * sx + 0], s[8 * sx + 1]); w.y = pk2(s[8 * sx + 2], s[8 * sx + 3]); w.z = pk2(s[8 * sx + 4], s[8 * sx + 5]); w.w = pk2(s[8 * sx + 6], s[8 * sx + 7]);
                const bf16x8 pa = __builtin_bit_cast(bf16x8, w);
#pragma unroll
                for (int eb = 0; eb < 4; ++eb) { const bf16x8 vf = trpair(lds + vlane + (32 * mb + 16 * sx) * VSTR + eb * 64, 8 * VSTR); acc[eb] = __builtin_amdgcn_mfma_f32_32x32x16_bf16(pa, vf, acc[eb], 0, 0, 0); } }
        }
        float mu[16], rs[16];
#pragma unroll
        for (int i = 0; i < 16; ++i) { float s1 = (acc[0][i] + acc[1][i]) + (acc[2][i] + acc[3][i]);
#pragma unroll
            for (int o = 1; o < 32; o <<= 1) s1 += __shfl_xor(s1, o);
            const float m = s1 * (1.f / 128.f); float s2 = 0.f;
#pragma unroll
            for (int eb = 0; eb < 4; ++eb) { const float d = acc[eb][i] - m; s2 += d * d; }
#pragma unroll
            for (int o = 1; o < 32; o <<= 1) s2 += __shfl_xor(s2, o);
            mu[i] = m; rs[i] = rsqrtf(s2 * (1.f / 128.f) + LN_EPS); }
        const bf16_t* gp = HP + tok0 * IN_ODD + 1024; bf16_t* mp = MC + tok0 * DM;
#pragma unroll
        for (int eb = 0; eb < 4; ++eb) { const int col = h * 128 + 32 * eb + r; const float gg = gng[col], bb = gnb[col];
            const bf16_t* gq = gp + (32 * lb + 4 * hh) * IN_ODD + col; bf16_t* mq = mp + (32 * lb + 4 * hh) * DM + col;
#pragma unroll
            for (int i = 0; i < 16; ++i) { const float gt = bf2f(*gq);
                const float y = (acc[eb][i] - mu[i]) * rs[i] * gg + bb; *mq = f2bf(y * pg8::e_silu(gt));
                const int step = (i & 3) == 3 ? 5 : 1; gq += step * IN_ODD; mq += step * DM; asm volatile("" : "+v"(gq), "+v"(mq)); } }
        __syncthreads();
    }
}

DEV void sgu_phase(LAS unsigned char* lds, const bf16_t* __restrict__ HP, const bf16_t* __restrict__ WSB, const float* __restrict__ lng, const float* __restrict__ lnb, const float* __restrict__ bs, bf16_t* __restrict__ MC, int vcu, int G, int tid) {
    constexpr int TSTR = 320, TOFF = 1024;
    const int lane = tid & 63, wave = __builtin_amdgcn_readfirstlane(tid >> 6), r = lane & 31, hh = lane >> 5, p15 = lane & 15, g4 = lane >> 4;
    LAS float* stats = (LAS float*)lds;
    const int cb = wave & 3, whalf = wave >> 2;
    for (int u = vcu; u < MTOK / 128; u += G) { const size_t tok0 = (size_t)u * 128;
        const bf16_t* up = HP + tok0 * IN_ODD + 1536; bf16_t* mp = MC + tok0 * DM + 512;
        for (int i = 0; i < 16; ++i) { const int row = 16 * wave + i; const u32x4 v = *(const u32x4*)(HP + (tok0 + row) * IN_ODD + 2048 + lane * 8);
            float x[8] = {__uint_as_float(v.x << 16), __uint_as_float(v.x & 0xffff0000u), __uint_as_float(v.y << 16), __uint_as_float(v.y & 0xffff0000u), __uint_as_float(v.z << 16), __uint_as_float(v.z & 0xffff0000u), __uint_as_float(v.w << 16), __uint_as_float(v.w & 0xffff0000u)};
            float s1 = 0.f;
#pragma unroll
            for (int j = 0; j < 8; ++j) s1 += x[j];
            const float m = wave_sum(s1) * (1.f / 512.f); float s2 = 0.f;
#pragma unroll
            for (int j = 0; j < 8; ++j) { const float d = x[j] - m; s2 += d * d; }
            const float rstd = rsqrtf(wave_sum(s2) * (1.f / 512.f) + LN_EPS);
            if (lane == 0) { stats[2 * row] = m; stats[2 * row + 1] = rstd; } }
        __syncthreads();
        for (int g = 0; g < 4; ++g) {
#pragma unroll
            for (int i = 0; i < 4; ++i) { const int ck = tid + NTHR * i, row = ck >> 4, cc = ck & 15; const int ch = g * 128 + cc * 8;
                const u32x4 v = *(const u32x4*)(HP + (tok0 + row) * IN_ODD + 2048 + ch);
                const float m = stats[2 * row], rstd = stats[2 * row + 1];
                const f32x4 g0 = *(const f32x4*)(lng + ch), g1 = *(const f32x4*)(lng + ch + 4), b0 = *(const f32x4*)(lnb + ch), b1 = *(const f32x4*)(lnb + ch + 4);
                u32x4 w;
                w.x = pk2((__uint_as_float(v.x << 16) - m) * rstd * g0.x + b0.x, (__uint_as_float(v.x & 0xffff0000u) - m) * rstd * g0.y + b0.y);
                w.y = pk2((__uint_as_float(v.y << 16) - m) * rstd * g0.z + b0.z, (__uint_as_float(v.y & 0xffff0000u) - m) * rstd * g0.w + b0.w);
                w.z = pk2((__uint_as_float(v.z << 16) - m) * rstd * g1.x + b1.x, (__uint_as_float(v.z & 0xffff0000u) - m) * rstd * g1.y + b1.y);
                w.w = pk2((__uint_as_float(v.w << 16) - m) * rstd * g1.z + b1.z, (__uint_as_float(v.w & 0xffff0000u) - m) * rstd * g1.w + b1.w);
                *(LAS u32x4*)(lds + TOFF + row * TSTR + cc * 16) = w; }
            __syncthreads();
#pragma unroll
            for (int j = 0; j < 2; ++j) { const int tb = whalf == 0 ? (j == 0 ? 0 : 3) : (j == 0 ? 1 : 2);
                f32x16 acc;
#pragma unroll
                for (int i = 0; i < 16; ++i) acc[i] = 0.f;
                const bf16_t* wp = WSB + ((size_t)g * 128 + 32 * tb + r) * 128 + hh * 8;
                for (int ks = 0; ks < 2 * (tb + 1); ++ks) {
                    const bf16x8 wf = *(const bf16x8*)(wp + 16 * ks);
                    const bf16x8 vf = trpair(lds + TOFF + (16 * ks + 8 * hh + (p15 >> 2)) * TSTR + (32 * cb + 16 * (g4 & 1) + 4 * (p15 & 3)) * 2, 4 * TSTR);
                    acc = __builtin_amdgcn_mfma_f32_32x32x16_bf16(wf, vf, acc, 0, 0, 0);
                }
                const int col = g * 128 + 32 * cb + r;
                const bf16_t* uq = up + (32 * tb + 4 * hh) * IN_ODD + col; bf16_t* mq = mp + (32 * tb + 4 * hh) * DM + col; const float* bq = bs + g * 128 + 32 * tb + 4 * hh;
#pragma unroll
                for (int i = 0; i < 16; ++i) { const float uu = bf2f(*uq); *mq = f2bf(uu * (acc[i] + *bq));
                    const int step = (i & 3) == 3 ? 5 : 1; uq += step * IN_ODD; mq += step * DM; bq += step; asm volatile("" : "+v"(uq), "+v"(mq), "+v"(bq)); }
            }
            __syncthreads();
        }
    }
}
}

#define XB_TMO      128
#define XB_XCNT(j)  (256  + 64 * (j))
#define XB_XSUB(j)  (1280 + 64 * (j))
#define XB_XGEN(j)  (2304 + 64 * (j))
#define XB_TOP      3328
#define XB_TOPGEN   3392
#define XCD_BAR_WORDS 3456
#define XB_SPIN_CAP (1u << 18)

__device__ __forceinline__ unsigned xb_ld(unsigned* p)              { return __hip_atomic_load(p, __ATOMIC_RELAXED, __HIP_MEMORY_SCOPE_AGENT); }
__device__ __forceinline__ unsigned xb_add(unsigned* p, unsigned v) { return __hip_atomic_fetch_add(p, v, __ATOMIC_RELAXED, __HIP_MEMORY_SCOPE_AGENT); }
__device__ __forceinline__ unsigned xb_xcc_id() { return (unsigned)__builtin_amdgcn_s_getreg((3 << 11) | 20) & 0xFu; }
#define XB_SPIN(cond, bar) do { unsigned _sp = 0; while (cond) { __builtin_amdgcn_s_sleep(1); \
    if ((++_sp & 255u) == 0u) { if (xb_ld(&(bar)[XB_TMO])) break; if (_sp > XB_SPIN_CAP) { atomicAdd(&(bar)[XB_TMO], 1u); break; } } } } while (0)

struct XcdBarrier {
    unsigned* bar; unsigned x;
    volatile LAS unsigned* st;
};

__device__ __forceinline__ XcdBarrier xcd_barrier_post(unsigned* bar, volatile LAS unsigned* st) {
    XcdBarrier b; b.bar = bar; b.x = xb_xcc_id(); b.st = st;
    if (threadIdx.x == 0) (void)xb_add(&bar[XB_XCNT(b.x)], 1u);
    return b;
}
__device__ __forceinline__ void xcd_barrier_complete(unsigned* bar, unsigned x, unsigned& nloc, unsigned& nx) {
    const unsigned G = gridDim.x * gridDim.y * gridDim.z;
    unsigned sum, cnt, mine, sp = 0u;
    for (;;) {
        sum = 0u; cnt = 0u; mine = 0u;
#pragma unroll
        for (unsigned j = 0; j < 16; ++j) { const unsigned c = xb_ld(&bar[XB_XCNT(j)]); sum += c; cnt += (c > 0u) ? 1u : 0u; mine = (j == x) ? c : mine; }
        if (sum == G) break;
        __builtin_amdgcn_s_sleep(1);
        if ((++sp & 255u) == 0u) { if (xb_ld(&bar[XB_TMO])) break; if (sp > XB_SPIN_CAP) { atomicAdd(&bar[XB_TMO], 1u); break; } }
    }
    nloc = mine > 0u ? mine : 1u; nx = cnt > 0u ? cnt : 1u;
}

__device__ __forceinline__ void xcd_barrier(const XcdBarrier& b) {
    asm volatile("s_waitcnt vmcnt(0)" ::: "memory");
    __syncthreads();
    if (threadIdx.x == 0) {
        unsigned* bar = b.bar;
        __builtin_amdgcn_s_waitcnt(0);
        unsigned nloc = b.st[0], nx = b.st[1];
        if (nloc == 0u) { xcd_barrier_complete(bar, b.x, nloc, nx); b.st[0] = nloc; b.st[1] = nx; }
        const unsigned old = xb_add(&bar[XB_XSUB(b.x)], 1u);
        const unsigned gen = old / nloc;
        if (old + 1u == (gen + 1u) * nloc) {
            __builtin_amdgcn_fence(__ATOMIC_RELEASE, "agent");
            asm volatile("s_waitcnt vmcnt(0)" ::: "memory");
            const unsigned og = xb_add(&bar[XB_TOP], 1u);
            const unsigned tg = og / nx;
            if (og + 1u == (tg + 1u) * nx) xb_add(&bar[XB_TOPGEN], 1u);
            else XB_SPIN(xb_ld(&bar[XB_TOPGEN]) == tg, bar);
            __builtin_amdgcn_fence(__ATOMIC_ACQUIRE, "agent");
            xb_add(&bar[XB_XGEN(b.x)], 1u);
            asm volatile("s_waitcnt vmcnt(0)" ::: "memory");
        } else {
            XB_SPIN(xb_ld(&bar[XB_XGEN(b.x)]) == gen, bar);
            __builtin_amdgcn_fence(__ATOMIC_ACQUIRE, "agent");
            asm volatile("s_waitcnt vmcnt(0)" ::: "memory");
        }
    }
    __syncthreads();
}

__global__ void __launch_bounds__(NTHR, 2) mk_fwd(Args a) {
    extern __shared__ __attribute__((aligned(16))) unsigned char lds_raw[];
    LAS unsigned char* lds = (LAS unsigned char*)lds_raw;
    volatile LAS unsigned* MISC = (volatile LAS unsigned*)(lds + LDS_BYTES - 64);
    if (threadIdx.x < 16) MISC[threadIdx.x] = 0u;
    __syncthreads();
    XcdBarrier bar; bar.bar = nullptr; bar.x = 0; bar.st = nullptr;
    bar = xcd_barrier_post((unsigned*)(a.ws + WS_CTL) + 1024, MISC + 8);
    for (int ph = a.ph_lo; ph < a.ph_hi; ++ph)
    for (int rep = 0; rep < 1 + (int)((PROBE_DUP >> ph) & 1u); ++rep) {
        int tid = threadIdx.x; asm volatile("" : "+v"(tid));
        kptr_t kp = (kptr_t)__builtin_amdgcn_kernarg_segment_ptr(); asm volatile("" : "+s"(kp));
        unsigned char* ws = kws(kp);
        const int lane = tid & 63, wave = __builtin_amdgcn_readfirstlane(tid >> 6);
        const int G = gridDim.x, bx = blockIdx.x;
        const int vcu = (G % 8 == 0) ? (bx % 8) * (G / 8) + bx / 8 : bx;
        const int gw = vcu * NWAVES + wave, NGW = G * NWAVES;
        bf16_t* XB = (bf16_t*)(ws + WS_XB); bf16_t* HP = (bf16_t*)(ws + WS_HP); bf16_t* MC = (bf16_t*)(ws + WS_MC); float* Y = (float*)(ws + WS_Y); float* XF = kout(kp);
        const int L = ph >= 8 ? 1 : 0;
        switch (ph) {
        case 0: p0_prologue(kp, lds, gw, NGW, wave, lane); break;
        case 1: case 8: {
            const int N = L ? IN_ODD : IN_EVEN;
            pg8::Gemm g{XB, (const bf16_t*)(ws + (L ? WS_WINO : WS_WINE)), MTOK, N, DM}; pg8::StaticOrder S; S.init(MTOK, N, G, bx);
            pg8::EpiBf16G E{HP, N, L ? 6 : (1 << 30)};
            pg8::gemm_phase<pg8::EpiBf16G, pg8::StaticOrder, true, true>(lds, g, S, E, tid);
        } break;
        case 3: case 12: case 6: case 15: {
            const bool dn = (ph == 6 || ph == 15);
            const bf16_t* A = dn ? HP : MC; const int K = dn ? DFF : DM;
            const bf16_t* Bt = (const bf16_t*)(ws + (dn ? (L ? WS_WDN1 : WS_WDN0) : (L ? WS_WOUTO : WS_WOUTE)));
            const float* R = (ph == 3) ? kin(kp, 0) : XF;
            pg8::Gemm g{A, Bt, MTOK, DM, K}; pg8::StaticOrder S; S.init(MTOK, DM, G, bx);
            pg8::EpiResid E{R, Y, DM, ALPHA};
            pg8::gemm_phase<pg8::EpiResid, pg8::StaticOrder, true, true>(lds, g, S, E, tid);
        } break;
        case 4: case 7: case 13: case 16: {
            const bool ffn = (ph == 7 || ph == 16);
            ln_phase(Y, kin(kp, ffn ? 22 : 17) + L * DM, kin(kp, ffn ? 23 : 18) + L * DM, XF, XB, gw, NGW, lane);
        } break;
        case 5: case 14: {
            pg8::Gemm g{XB, (const bf16_t*)(ws + (L ? WS_WGU1 : WS_WGU0)), MTOK, 2 * DFF, DM}; pg8::StaticOrder S; S.init(MTOK, 2 * DFF, G, bx);
            pg8::EpiSwiglu E{HP, DFF};
            pg8::gemm_phase<pg8::EpiSwiglu, pg8::StaticOrder, true, true>(lds, g, S, E, tid);
        } break;
        case 2: { float* KN2 = (float*)(ws + WS_KN2);
                  att::knorm_phase(HP, KN2, gw, NGW, lane); xcd_barrier(bar);
                  att::attn_phase(lds, kp, HP, MC, KN2, (unsigned*)(ws + WS_CTL) + 64 + 64 * rep, tid); } break;
        case 9: mix1::ret_kv_phase(lds, HP, (float*)(ws + WS_Y), vcu, G, tid);
                mix1::sgu_phase(lds, HP, (const bf16_t*)(ws + WS_SGUW), kin(kp, 12), kin(kp, 13), kin(kp, 15), MC, vcu, G, tid); break;
        case 10: mix1::ret_scan_phase((const float*)(ws + WS_Y), (bf16_t*)(ws + WS_Y + 64 * MiB), vcu, G, tid); break;
        case 11: mix1::ret_out_phase(lds, HP, (const bf16_t*)(ws + WS_Y + 64 * MiB), kin(kp, 10), kin(kp, 11), MC, vcu, G, tid); break;
        default: break;
        }
        if (ph + 1 < a.ph_hi || rep < (int)((PROBE_DUP >> ph) & 1u)) xcd_barrier(bar);
    }
}
extern "C" void kernel_launch(void* const* d_in, const int* in_sizes, int n_in, void* d_out, int out_size, void* d_ws, size_t ws_size, hipStream_t stream) {
    static int grid = 0;
    if (grid == 0) {
        if (n_in != 24 || ws_size < WS_END || out_size != MTOK * DM) { fprintf(stderr, "kernel_launch: unexpected shapes (n_in %d ws %zu out %d)\n", n_in, ws_size, out_size); grid = -1; return; }
        int dev = 0, cus = 0, per_cu = 0;
        hipGetDevice(&dev); hipDeviceGetAttribute(&cus, hipDeviceAttributeMultiprocessorCount, dev);
        if (hipFuncSetAttribute((const void*)mk_fwd, hipFuncAttributeMaxDynamicSharedMemorySize, LDS_BYTES) != hipSuccess) { fprintf(stderr, "hipFuncSetAttribute failed\n"); grid = -1; return; }
        hipOccupancyMaxActiveBlocksPerMultiprocessor(&per_cu, (const void*)mk_fwd, NTHR, LDS_BYTES);
        if (per_cu < 1) { fprintf(stderr, "occupancy query says %d blocks/CU\n", per_cu); }
        (void)hipGetLastError();
        grid = cus;
    }
    if (grid < 0) return;
    const float* const* in = (const float* const*)d_in;
    unsigned char* ws = (unsigned char*)d_ws;
    bf16_t* HP = (bf16_t*)(ws + WS_HP); bf16_t* MC = (bf16_t*)(ws + WS_MC); float* Y = (float*)(ws + WS_Y);
    Args a{};
    for (int i = 0; i < 24; ++i) a.in[i] = in[i];
    a.out = (float*)d_out; a.ws = ws;
    auto run = [&](int lo, int hi) { a.ph_lo = lo; a.ph_hi = hi; hipLaunchKernelGGL(mk_fwd, dim3(grid), dim3(NTHR), LDS_BYTES, stream, a); };
    hipMemsetAsync(ws + WS_CTL, 0, 65536, stream);
    run(0, NPHASE);
}
```

```cpp
#include <hip/hip_runtime.h>
#include <cstdio>
#include <cstdint>

typedef unsigned short bf16_t;
#define DEV __device__ __forceinline__

constexpr int BATCH = 4, SEQ = 8192, DM = 1024, MTOK = BATCH * SEQ;
constexpr int IN_EVEN = 3072, IN_ODD = 2560, DFF = 2816;
constexpr float ALPHA = 1.4142135623730951f, LN_EPS = 1e-5f;

constexpr size_t MiB = 1u << 20;
constexpr size_t WS_CTL = 0;
constexpr size_t WS_WINE = 1 * MiB;
constexpr size_t WS_WOUTE = 7 * MiB;
constexpr size_t WS_WINO = 9 * MiB;
constexpr size_t WS_WOUTO = 14 * MiB;
constexpr size_t WS_WGU0 = 16 * MiB;
constexpr size_t WS_WDN0 = 27 * MiB;
constexpr size_t WS_WGU1 = 33 * MiB;
constexpr size_t WS_WDN1 = 44 * MiB;
constexpr size_t WS_SGUW = 50 * MiB;
constexpr size_t WS_KN2 = 50 * MiB + 512 * 1024;
constexpr size_t WS_XB = 52 * MiB;
constexpr size_t WS_HP = 116 * MiB;
constexpr size_t WS_MC = 308 * MiB;
constexpr size_t WS_Y = 372 * MiB;
constexpr size_t WS_END = 500 * MiB;

DEV float bf2f(bf16_t v) { return __uint_as_float(((unsigned)v) << 16); }
DEV bf16_t f2bf(float f) { unsigned u = __float_as_uint(f); return (bf16_t)((u + 0x7fffu + ((u >> 16) & 1u)) >> 16); }
DEV float gelu_tanh(float x) { const float u = 0.7978845608028654f * (x + 0.044715f * x * x * x); return x / (1.f + __expf(-2.f * u)); }
DEV float silu(float x) { return x / (1.f + __expf(-x)); }

__global__ void __launch_bounds__(256) nv_wt(const float* W, int K, int N, bf16_t* WT, int mode) {
    __shared__ float t[32][33];
    const int n0 = blockIdx.x * 32, k0 = blockIdx.y * 32, tx = threadIdx.x & 31, ty = threadIdx.x >> 5;
    for (int i = ty; i < 32; i += 8) t[i][tx] = W[(size_t)(k0 + i) * N + n0 + tx];
    __syncthreads();
    for (int i = ty; i < 32; i += 8) { const int n = n0 + i; const int r = mode == 0 ? n : (256 * (n >> 7) + (n & 127) + (mode == 2 ? 128 : 0));
        WT[(size_t)r * K + k0 + tx] = f2bf(t[tx][i]); }
}
__global__ void __launch_bounds__(256) nv_cvt(const float* x, bf16_t* o, size_t n) {
    size_t i = (size_t)blockIdx.x * 256 + threadIdx.x; const size_t st = (size_t)gridDim.x * 256;
    for (; i < n; i += st) o[i] = f2bf(x[i]);
}
struct GE { int mode; bf16_t* outb; float* outf; const float* resid; int ldc; int gelu_from; };
__global__ void __launch_bounds__(256) nv_gemm(const bf16_t* A, const bf16_t* Bt, int K, GE e) {
    __shared__ float As[64][33], Bs[64][33], Bs2[64][33];
    const int tid = threadIdx.x, tx = tid & 15, ty = tid >> 4, row0 = blockIdx.y * 64, col0 = blockIdx.x * 64;
    const bool dual = e.mode == 1;
    float acc[4][4], acc2[4][4];
#pragma unroll
    for (int i = 0; i < 4; ++i)
#pragma unroll
        for (int j = 0; j < 4; ++j) { acc[i][j] = 0.f; acc2[i][j] = 0.f; }
    for (int k0 = 0; k0 < K; k0 += 32) {
        for (int i = tid; i < 2048; i += 256) { const int r = i >> 5, c = i & 31;
            As[r][c] = bf2f(A[(size_t)(row0 + r) * K + k0 + c]);
            const int col = col0 + r, br = dual ? (256 * (col >> 7) + (col & 127)) : col;
            Bs[r][c] = bf2f(Bt[(size_t)br * K + k0 + c]);
            if (dual) Bs2[r][c] = bf2f(Bt[(size_t)(br + 128) * K + k0 + c]); }
        __syncthreads();
#pragma unroll 4
        for (int kk = 0; kk < 32; ++kk) {
            float a[4], b[4], b2[4];
#pragma unroll
            for (int i = 0; i < 4; ++i) { a[i] = As[ty * 4 + i][kk]; b[i] = Bs[tx * 4 + i][kk]; b2[i] = dual ? Bs2[tx * 4 + i][kk] : 0.f; }
#pragma unroll
            for (int i = 0; i < 4; ++i)
#pragma unroll
                for (int j = 0; j < 4; ++j) { acc[i][j] += a[i] * b[j]; acc2[i][j] += a[i] * b2[j]; }
        }
        __syncthreads();
    }
#pragma unroll
    for (int i = 0; i < 4; ++i)
#pragma unroll
        for (int j = 0; j < 4; ++j) {
            const int r = row0 + ty * 4 + i, c = col0 + tx * 4 + j; const size_t o = (size_t)r * e.ldc + c;
            if (e.mode == 0) { float v = acc[i][j]; if (c >= e.gelu_from) v = gelu_tanh(v); e.outb[o] = f2bf(v); }
            else if (e.mode == 1) { e.outb[o] = f2bf(silu(acc[i][j]) * acc2[i][j]); }
            else { e.outf[o] = ALPHA * e.resid[o] + acc[i][j]; }
        }
}
__global__ void __launch_bounds__(256) nv_ln(const float* Y, const float* g, const float* b, float* XF, bf16_t* XB) {
    const int row = blockIdx.x * 4 + (threadIdx.x >> 6), lane = threadIdx.x & 63;
    const float* y = Y + (size_t)row * DM; float v[16]; float s = 0.f;
#pragma unroll
    for (int j = 0; j < 16; ++j) { v[j] = y[lane + 64 * j]; s += v[j]; }
#pragma unroll
    for (int o = 1; o < 64; o <<= 1) s += __shfl_xor(s, o);
    const float mean = s * (1.f / DM); float q = 0.f;
#pragma unroll
    for (int j = 0; j < 16; ++j) { v[j] -= mean; q += v[j] * v[j]; }
#pragma unroll
    for (int o = 1; o < 64; o <<= 1) q += __shfl_xor(q, o);
    const float rstd = rsqrtf(q * (1.f / DM) + LN_EPS);
#pragma unroll
    for (int j = 0; j < 16; ++j) { const int c = lane + 64 * j; const float o = v[j] * rstd * g[c] + b[c]; XF[(size_t)row * DM + c] = o; XB[(size_t)row * DM + c] = f2bf(o); }
}
template <int MODE, int DVS> __global__ void __launch_bounds__(256) nv_attn(const bf16_t* HP, float* OT, bf16_t* MC, const float* relb) {
    const int tid = threadIdx.x, qi = tid & 63, es = tid >> 6, c = blockIdx.x;
    int b, h, m = 0;
    if (MODE == 0) { m = blockIdx.y & 1; h = (blockIdx.y >> 1) & 3; b = blockIdx.y >> 3; } else { h = blockIdx.y & 7; b = blockIdx.y >> 3; }
    const int tq = c * 64 + qi;
    const bf16_t* base = HP + (size_t)b * SEQ * IN_EVEN;
    int qcol, kcol, vcol;
    if (MODE == 0) { qcol = h * 128 + m * 64; kcol = 512 + h * 128 + m * 64; vcol = 1024 + h * 128 + es * DVS; }
    else { qcol = 1536 + h * 64; kcol = 2048 + h * 64; vcol = 2560 + h * 64 + es * DVS; }
    float q[64];
#pragma unroll
    for (int d = 0; d < 64; ++d) q[d] = bf2f(base[(size_t)tq * IN_EVEN + qcol + d]) * 0.125f;
    float o[DVS];
#pragma unroll
    for (int e = 0; e < DVS; ++e) o[e] = 0.f;
    float mx = -1e30f, l = 0.f;
    const int k_lo = MODE == 0 ? 0 : ((c - 8) * 64 > 0 ? (c - 8) * 64 : 0), k_hi = (c + 1) * 64;
    const float slope = exp2f(-2.0f * (float)(h + 1));
    for (int key = k_lo; key < k_hi; ++key) {
        const bf16_t* kr = base + (size_t)key * IN_EVEN + kcol;
        float s = 0.f;
#pragma unroll
        for (int d = 0; d < 64; ++d) s += q[d] * bf2f(kr[d]);
        if (MODE == 0) s -= slope * fabsf((float)(tq - key));
        else { int rel = tq - key; rel = rel < -128 ? -128 : (rel > 128 ? 128 : rel); s += relb[h * 257 + rel + 128]; }
        if (s > mx) { const float f = expf(mx - s); l *= f;
#pragma unroll
            for (int e = 0; e < DVS; ++e) o[e] *= f;
            mx = s; }
        const float p = expf(s - mx); l += p;
        const bf16_t* vr = base + (size_t)key * IN_EVEN + vcol;
#pragma unroll
        for (int e = 0; e < DVS; ++e) o[e] += p * bf2f(vr[e]);
    }
    const float inv = 1.f / l; const size_t tok = (size_t)b * SEQ + tq;
#pragma unroll
    for (int e = 0; e < DVS; ++e) {
        if (MODE == 0) OT[((size_t)m * MTOK + tok) * 512 + h * 128 + es * DVS + e] = o[e] * inv;
        else MC[tok * DM + 512 + h * 64 + es * DVS + e] = f2bf(o[e] * inv);
    }
}
__global__ void __launch_bounds__(256) nv_diff_combine(const float* OT, const float* lq1, const float* lk1, const float* lq2, const float* lk2, const float* g, bf16_t* MC) {
    const int i = blockIdx.x * 256 + threadIdx.x; const int tok = i >> 2, h = i & 3;
    float s1 = 0.f, s2 = 0.f;
    for (int d = 0; d < 64; ++d) { s1 += lq1[d] * lk1[d]; s2 += lq2[d] * lk2[d]; }
    const float lam = expf(s1) - expf(s2) + 0.2f;
    const float* o1 = OT + (size_t)tok * 512 + h * 128; const float* o2 = o1 + (size_t)MTOK * 512;
    float ss = 0.f;
    for (int e = 0; e < 128; ++e) { const float d = o1[e] - lam * o2[e]; ss += d * d; }
    const float r = rsqrtf(ss * (1.f / 128.f) + LN_EPS) * 0.8f;
    for (int e = 0; e < 128; ++e) { const float d = o1[e] - lam * o2[e]; MC[(size_t)tok * DM + h * 128 + e] = f2bf(d * r * g[e]); }
}
__global__ void __launch_bounds__(128) nv_ret(const bf16_t* HP, float* OT) {
    const int b = blockIdx.x >> 2, h = blockIdx.x & 3, e = threadIdx.x;
    const float gamma = 1.f - exp2f(-5.f - (float)h);
    float S[64];
#pragma unroll
    for (int d = 0; d < 64; ++d) S[d] = 0.f;
    for (int t = 0; t < SEQ; ++t) {
        const bf16_t* row = HP + ((size_t)b * SEQ + t) * IN_ODD;
        const float v = bf2f(row[512 + h * 128 + e]); float o = 0.f;
#pragma unroll
        for (int d = 0; d < 64; ++d) { const float kd = bf2f(row[256 + h * 64 + d]) * 0.125f; S[d] = gamma * S[d] + kd * v; o += bf2f(row[h * 64 + d]) * S[d]; }
        OT[((size_t)b * SEQ + t) * 512 + h * 128 + e] = o;
    }
}
__global__ void __launch_bounds__(256) nv_gn_gate(const float* OT, const bf16_t* HP, const float* g, const float* bb, bf16_t* MC) {
    const int i = blockIdx.x * 256 + threadIdx.x; const int tok = i >> 2, h = i & 3;
    const float* o = OT + (size_t)tok * 512 + h * 128; float s = 0.f;
    for (int e = 0; e < 128; ++e) s += o[e];
    const float mu = s * (1.f / 128.f); float q = 0.f;
    for (int e = 0; e < 128; ++e) { const float d = o[e] - mu; q += d * d; }
    const float r = rsqrtf(q * (1.f / 128.f) + LN_EPS);
    for (int e = 0; e < 128; ++e) { const int c = h * 128 + e; const float y = (o[e] - mu) * r * g[c] + bb[c]; const float gt = bf2f(HP[(size_t)tok * IN_ODD + 1024 + c]);
        MC[(size_t)tok * DM + c] = f2bf(y * silu(gt)); }
}
__global__ void __launch_bounds__(256) nv_sgu_ln(const bf16_t* HP, const float* g, const float* bb, float* VN) {
    const int tok = blockIdx.x * 256 + threadIdx.x; const bf16_t* v = HP + (size_t)tok * IN_ODD + 2048; float s = 0.f;
    for (int c = 0; c < 512; ++c) s += bf2f(v[c]);
    const float mu = s * (1.f / 512.f); float q = 0.f;
    for (int c = 0; c < 512; ++c) { const float d = bf2f(v[c]) - mu; q += d * d; }
    const float r = rsqrtf(q * (1.f / 512.f) + LN_EPS);
    for (int c = 0; c < 512; ++c) VN[(size_t)tok * 512 + c] = (bf2f(v[c]) - mu) * r * g[c] + bb[c];
}
__global__ void __launch_bounds__(256) nv_sgu_mix(const float* VN, const bf16_t* HP, const float* W, const float* bs, bf16_t* MC) {
    const int chunk = blockIdx.x, g = blockIdx.y, c = threadIdx.x & 127, th = threadIdx.x >> 7;
    for (int t = th * 64; t < th * 64 + 64; ++t) {
        float acc = 0.f; const float* w = W + ((size_t)g * 128 + t) * 128;
        for (int s = 0; s <= t; ++s) acc += w[s] * VN[((size_t)chunk * 128 + s) * 512 + g * 128 + c];
        const size_t tok = (size_t)chunk * 128 + t; const float u = bf2f(HP[tok * IN_ODD + 1536 + g * 128 + c]);
        MC[tok * DM + 512 + g * 128 + c] = f2bf(u * (acc + bs[g * 128 + t]));
    }
}

namespace pg8 {
#define PG8_LAS __attribute__((address_space(3)))
typedef unsigned short bf16_t;
typedef short bf16x8 __attribute__((ext_vector_type(8)));
typedef float f32x4 __attribute__((ext_vector_type(4)));
typedef unsigned u32x4 __attribute__((ext_vector_type(4)));
constexpr int BM = 256, BK = 64, HALF = 128, HTB = HALF * BK * 2  , STAGE_BYTES = 8 * HTB, NXCD = 8, WGM = 8;

__host__ __device__ __forceinline__ int lds_byte(int r, int c) { const int st = (r >> 4) * 2 + (c >> 5), rr = r & 15, cc = c & 31, ob = rr * 64 + cc * 2; return st * 1024 + (ob ^ (((ob >> 9) & 1) << 5)); }
__host__ __device__ __forceinline__ void stage_rc(int b, int& R, int& C) { const int st = b / 1024, sb = b % 1024, swz = sb ^ (((sb >> 9) & 1) << 5); R = (st >> 1) * 16 + swz / 64; C = (st & 1) * 32 + (swz % 64) / 2; }
__host__ __device__ __forceinline__ int perm32(int rho) { const int n = rho >> 4, i = rho & 15; return 8 * (i >> 2) + 4 * n + (i & 3); }

struct Unit { int pm, pn; };
struct Gemm { const bf16_t* A; const bf16_t* Bt; int M, N, K; };

struct StaticOrder {
    int nM, nN, nwg, G, c;
    __host__ __device__ void init(int M, int N, int G_, int c_) { nM = M / BM; nN = N / BM; nwg = nM * nN; G = G_; c = c_; }
    __host__ __device__ bool next(int i, Unit& u) const {
        const long L = (long)i * G + c; if (L >= nwg) return false;
        int wgid = (int)L; { const int q = nwg / NXCD, r = nwg % NXCD, xcd = wgid % NXCD, off = wgid / NXCD; wgid = (xcd < r ? xcd * (q + 1) : r * (q + 1) + (xcd - r) * q) + off; }
        const int nig = WGM * nN, gid = wgid / nig, fm = gid * WGM, gsz = (nM - fm) < WGM ? (nM - fm) : WGM;
        u.pm = fm + ((wgid % nig) % gsz); u.pn = (wgid % nig) / gsz; return true;
    }
    __device__ __forceinline__ void a_ready(const Unit&) const {}
    __device__ __forceinline__ void done(const Unit&) const {}
};

__device__ __forceinline__ unsigned cvt_pk_bf16(float lo, float hi) { unsigned r; asm volatile("v_cvt_pk_bf16_f32 %0, %1, %2" : "=v"(r) : "v"(lo), "v"(hi)); return r; }
__device__ __forceinline__ float e_gelu(float x) { const float u = 0.7978845608028654f * (x + 0.044715f * x * x * x); return x * __builtin_amdgcn_rcpf(1.f + __builtin_amdgcn_exp2f(-2.885390081777927f * u)); }
__device__ __forceinline__ float e_silu(float x) { return x * __builtin_amdgcn_rcpf(1.f + __builtin_amdgcn_exp2f(-1.4426950408889634f * x)); }
struct EpiBf16G {
    static constexpr bool PERM = true, AFTER_DRAIN = false;
    bf16_t* O; int ldc; int gelu_from_tile;
    __device__ __forceinline__ void operator()(const f32x4 (&acc)[2][2][4][2], const Unit& u, int wr, int wc, int fr, int fq) const {
        const int row0 = u.pm * BM + wr * 64 + fr, col0 = u.pn * BM + wc * 32 + 8 * fq; const bool g = u.pn >= gelu_from_tile;
#pragma unroll
        for (int ai = 0; ai < 2; ++ai)
#pragma unroll
            for (int m = 0; m < 4; ++m) { bf16_t* rowp = O + (size_t)(row0 + ai * HALF + m * 16) * ldc + col0;
#pragma unroll
                for (int bj = 0; bj < 2; ++bj) { f32x4 v0 = acc[ai][bj][m][0], v1 = acc[ai][bj][m][1];
                    if (g) {
#pragma unroll
                        for (int i = 0; i < 4; ++i) { v0[i] = e_gelu(v0[i]); v1[i] = e_gelu(v1[i]); } }
                    u32x4 w; w.x = cvt_pk_bf16(v0[0], v0[1]); w.y = cvt_pk_bf16(v0[2], v0[3]); w.z = cvt_pk_bf16(v1[0], v1[1]); w.w = cvt_pk_bf16(v1[2], v1[3]);
                    *(u32x4*)(rowp + bj * HALF) = w; } }
    }
};
struct EpiSwiglu {
    static constexpr bool PERM = true, AFTER_DRAIN = false;
    bf16_t* O; int ldc;
    __device__ __forceinline__ void operator()(const f32x4 (&acc)[2][2][4][2], const Unit& u, int wr, int wc, int fr, int fq) const {
        const int row0 = u.pm * BM + wr * 64 + fr, col0 = u.pn * HALF + wc * 32 + 8 * fq;
#pragma unroll
        for (int ai = 0; ai < 2; ++ai)
#pragma unroll
            for (int m = 0; m < 4; ++m) { bf16_t* rowp = O + (size_t)(row0 + ai * HALF + m * 16) * ldc + col0;
                f32x4 h0, h1;
#pragma unroll
                for (int i = 0; i < 4; ++i) { h0[i] = e_silu(acc[ai][0][m][0][i]) * acc[ai][1][m][0][i]; h1[i] = e_silu(acc[ai][0][m][1][i]) * acc[ai][1][m][1][i]; }
                u32x4 w; w.x = cvt_pk_bf16(h0[0], h0[1]); w.y = cvt_pk_bf16(h0[2], h0[3]); w.z = cvt_pk_bf16(h1[0], h1[1]); w.w = cvt_pk_bf16(h1[2], h1[3]);
                *(u32x4*)rowp = w; }
    }
};
struct EpiResid {
    static constexpr bool PERM = false, AFTER_DRAIN = false;
    const float* R; float* Y; int ldc; float alpha;
    __device__ __forceinline__ void operator()(const f32x4 (&acc)[2][2][4][2], const Unit& u, int wr, int wc, int fr, int fq) const {
        const int row0 = u.pm * BM + wr * 64 + fr, col0 = u.pn * BM + wc * 32 + 4 * fq;
#pragma unroll
        for (int ai = 0; ai < 2; ++ai)
#pragma unroll
            for (int m = 0; m < 4; ++m) { const size_t off = (size_t)(row0 + ai * HALF + m * 16) * ldc + col0;
#pragma unroll
                for (int bj = 0; bj < 2; ++bj)
#pragma unroll
                    for (int n = 0; n < 2; ++n) { const f32x4 r = *(const f32x4*)(R + off + bj * HALF + n * 16); *(f32x4*)(Y + off + bj * HALF + n * 16) = r * alpha + acc[ai][bj][m][n]; }
                if (m & 1) asm volatile("" ::: "memory"); }
    }
};
template <class Epi, class Sched, bool ALIGN_EPI = false, bool SP2 = false>
__device__ __forceinline__ void gemm_phase(PG8_LAS unsigned char* lds, const Gemm g, const Sched& S, const Epi& E, const int tid) {
    const int wid = __builtin_amdgcn_readfirstlane(tid >> 6), lane = tid & 63, wr = wid >> 2, wc = wid & 3, fr = lane & 15, fq = lane >> 4;
    const int K = g.K, nt = K / BK;
    unsigned voffA[2], voffB[2];
#pragma unroll
    for (int i = 0; i < 2; ++i) { int R, C; stage_rc(tid * 16 + i * 8192, R, C); const int Rb = Epi::PERM ? ((R & ~31) + perm32(R & 31)) : R;
        voffA[i] = (unsigned)(R * K + C) * 2u; voffB[i] = (unsigned)(Rb * K + C) * 2u; }
    const size_t kstep = (size_t)(BK * 2);
    const size_t hstep = (size_t)HALF * K * 2;
    const size_t tstep = 2 * hstep;
    const unsigned ldsw = (unsigned)wid * 1024u;
    const int aoff = lds_byte(wr * 64 + fr, fq * 8), boff = lds_byte(wc * 32 + fr, fq * 8);
#define PG8_SA(b, h) (((b) * 2 + (h)) * HTB)
#define PG8_SB(b, h) ((4 + (b) * 2 + (h)) * HTB)
#define PG8_STAGE(bufoff, gbase, voff) do { _Pragma("unroll") for (int _i = 0; _i < 2; ++_i) \
        __builtin_amdgcn_global_load_lds((const unsigned*)((const char*)(gbase) + (voff)[_i]), (PG8_LAS unsigned*)(lds + (bufoff) + ldsw + _i * 8192), 16, 0, 0); } while (0)
#define PG8_LDA(dst, b, h) do { _Pragma("unroll") for (int m = 0; m < 4; ++m) _Pragma("unroll") for (int k = 0; k < 2; ++k) dst[m][k] = *(const PG8_LAS bf16x8*)(lds + PG8_SA(b, h) + aoff + m * 2048 + k * 1024); } while (0)
#define PG8_LDB(dst, b, h) do { _Pragma("unroll") for (int n = 0; n < 2; ++n) _Pragma("unroll") for (int k = 0; k < 2; ++k) dst[n][k] = *(const PG8_LAS bf16x8*)(lds + PG8_SB(b, h) + boff + n * 2048 + k * 1024); } while (0)
#define PG8_MMA(ai, bj, At, Bt) do { __builtin_amdgcn_s_setprio(1); _Pragma("unroll") for (int m = 0; m < 4; ++m) _Pragma("unroll") for (int n = 0; n < 2; ++n) _Pragma("unroll") for (int k = 0; k < 2; ++k) \
        acc[ai][bj][m][n] = __builtin_amdgcn_mfma_f32_16x16x32_bf16(Bt[n][k], At[m][k], acc[ai][bj][m][n], 0, 0, 0); __builtin_amdgcn_s_setprio(0); } while (0)
#define PG8_WAIT_V(n) asm volatile("s_waitcnt vmcnt(" #n ")" ::: "memory")
#define PG8_WAIT_L(n) asm volatile("s_waitcnt lgkmcnt(" #n ")" ::: "memory")
#define PG8_BAR __builtin_amdgcn_s_barrier()
#define PG8_SCHED __builtin_amdgcn_sched_barrier(0)
    Unit cur, nxt; int ui = 0;
    if (!S.next(0, cur)) return;
    f32x4 acc[2][2][4][2];
#pragma unroll
    for (int a = 0; a < 2; ++a)
#pragma unroll
        for (int b = 0; b < 2; ++b)
#pragma unroll
            for (int m = 0; m < 4; ++m)
#pragma unroll
                for (int n = 0; n < 2; ++n) acc[a][b][m][n] = (f32x4){0.f, 0.f, 0.f, 0.f};
    bf16x8 At[4][2], B0[2][2], B1[2][2];
    const char* cA = (const char*)g.A + (size_t)cur.pm * tstep; const char* cB = (const char*)g.Bt + (size_t)cur.pn * tstep;
    S.a_ready(cur);
    if constexpr (SP2) {
        PG8_STAGE(PG8_SB(0, 0), cB, voffB); PG8_STAGE(PG8_SB(0, 1), cB + hstep, voffB); PG8_STAGE(PG8_SA(0, 0), cA, voffA); PG8_STAGE(PG8_SA(0, 1), cA + hstep, voffA);
        if (wr == 1) PG8_BAR;
        PG8_WAIT_V(2); PG8_BAR;
        PG8_STAGE(PG8_SB(1, 0), cB + kstep, voffB); PG8_STAGE(PG8_SA(1, 0), cA + kstep, voffA); PG8_STAGE(PG8_SB(1, 1), cB + hstep + kstep, voffB);
        PG8_WAIT_V(6); PG8_BAR;
    } else {
        PG8_STAGE(PG8_SB(0, 0), cB, voffB); PG8_STAGE(PG8_SA(0, 0), cA, voffA); PG8_STAGE(PG8_SB(0, 1), cB + hstep, voffB); PG8_STAGE(PG8_SA(0, 1), cA + hstep, voffA);
        if (wr == 1) PG8_BAR;
        PG8_WAIT_V(4); PG8_BAR;
        PG8_STAGE(PG8_SB(1, 0), cB + kstep, voffB); PG8_STAGE(PG8_SA(1, 0), cA + kstep, voffA); PG8_STAGE(PG8_SB(1, 1), cB + hstep + kstep, voffB);
        PG8_WAIT_V(6); PG8_BAR;
    }
    for (;;) {
        const bool has_next = S.next(ui + 1, nxt);
        const char* nA = has_next ? (const char*)g.A + (size_t)nxt.pm * tstep : cA; const char* nB = has_next ? (const char*)g.Bt + (size_t)nxt.pn * tstep : cB;
        for (int t = 0; t < nt; t += 2) {
            const bool last = (t == nt - 2);
            const char* a1 = cA + (size_t)(t + 1) * kstep;
            const char* a2 = last ? nA : cA + (size_t)(t + 2) * kstep; const char* b2 = last ? nB : cB + (size_t)(t + 2) * kstep;
            const char* a3 = a2 + kstep; const char* b3 = b2 + kstep;
            if (last && has_next) S.a_ready(nxt);
            if constexpr (SP2) {
            PG8_LDB(B0, 0, 0); PG8_LDB(B1, 0, 1); PG8_SCHED; PG8_LDA(At, 0, 0); PG8_STAGE(PG8_SA(1, 1), a1 + hstep, voffA);
            PG8_WAIT_V(8); PG8_WAIT_L(0); PG8_BAR; PG8_MMA(0, 0, At, B0); PG8_MMA(0, 1, At, B1); PG8_BAR; PG8_SCHED;
            PG8_LDA(At, 0, 1); PG8_STAGE(PG8_SB(0, 0), b2, voffB); PG8_STAGE(PG8_SB(0, 1), b2 + hstep, voffB); PG8_STAGE(PG8_SA(0, 0), a2, voffA);
            PG8_WAIT_V(8); PG8_WAIT_L(0); PG8_BAR; PG8_MMA(1, 0, At, B0); PG8_MMA(1, 1, At, B1); PG8_BAR; PG8_SCHED;
            PG8_LDB(B0, 1, 0); PG8_LDB(B1, 1, 1); PG8_SCHED; PG8_LDA(At, 1, 0); PG8_STAGE(PG8_SA(0, 1), a2 + hstep, voffA);
            PG8_WAIT_V(8); PG8_WAIT_L(0); PG8_BAR; PG8_MMA(0, 0, At, B0); PG8_MMA(0, 1, At, B1); PG8_BAR; PG8_SCHED;
            PG8_LDA(At, 1, 1); PG8_STAGE(PG8_SB(1, 0), b3, voffB); PG8_STAGE(PG8_SB(1, 1), b3 + hstep, voffB); PG8_STAGE(PG8_SA(1, 0), a3, voffA);
            PG8_WAIT_V(8); PG8_WAIT_L(0); PG8_BAR; PG8_MMA(1, 0, At, B0); PG8_MMA(1, 1, At, B1); PG8_BAR; PG8_SCHED;
            } else {
            PG8_LDB(B0, 0, 0); PG8_SCHED; PG8_LDA(At, 0, 0); PG8_STAGE(PG8_SA(1, 1), a1 + hstep, voffA);
            PG8_WAIT_L(8); PG8_BAR; PG8_WAIT_L(0); PG8_MMA(0, 0, At, B0); PG8_BAR; PG8_SCHED;
            PG8_LDB(B1, 0, 1); PG8_STAGE(PG8_SB(0, 0), b2, voffB);
            PG8_BAR; PG8_WAIT_L(0); PG8_MMA(0, 1, At, B1); PG8_BAR;
            PG8_LDA(At, 0, 1); PG8_STAGE(PG8_SA(0, 0), a2, voffA);
            PG8_BAR; PG8_WAIT_L(0); PG8_MMA(1, 0, At, B0); PG8_BAR; PG8_SCHED;
            PG8_STAGE(PG8_SB(0, 1), b2 + hstep, voffB);
            PG8_WAIT_V(6); PG8_BAR; PG8_MMA(1, 1, At, B1); PG8_BAR;
            PG8_LDB(B0, 1, 0); PG8_SCHED; PG8_LDA(At, 1, 0); PG8_STAGE(PG8_SA(0, 1), a2 + hstep, voffA);
            PG8_WAIT_L(8); PG8_BAR; PG8_WAIT_L(0); PG8_MMA(0, 0, At, B0); PG8_BAR; PG8_SCHED;
            PG8_LDB(B1, 1, 1); PG8_STAGE(PG8_SB(1, 0), b3, voffB);
            PG8_BAR; PG8_WAIT_L(0); PG8_MMA(0, 1, At, B1); PG8_BAR;
            PG8_LDA(At, 1, 1); PG8_STAGE(PG8_SA(1, 0), a3, voffA);
            PG8_BAR; PG8_WAIT_L(0); PG8_MMA(1, 0, At, B0); PG8_BAR; PG8_SCHED;
            PG8_STAGE(PG8_SB(1, 1), b3 + hstep, voffB);
            PG8_WAIT_V(6); PG8_BAR; PG8_MMA(1, 1, At, B1); PG8_BAR;
            }
        }
        if constexpr (ALIGN_EPI) { if (wr == 0) PG8_BAR; }
        if constexpr (!Epi::AFTER_DRAIN) { E(acc, cur, wr, wc, fr, fq); S.done(cur); }
        if (!has_next) break;
#pragma unroll
        for (int a = 0; a < 2; ++a)
#pragma unroll
            for (int b = 0; b < 2; ++b)
#pragma unroll
                for (int m = 0; m < 4; ++m)
#pragma unroll
                    for (int n = 0; n < 2; ++n) acc[a][b][m][n] = (f32x4){0.f, 0.f, 0.f, 0.f};
        cur = nxt; cA = nA; cB = nB; ++ui;
        if constexpr (ALIGN_EPI) { if (wr == 1) PG8_BAR; }
    }
    PG8_WAIT_V(0);
    if constexpr (!ALIGN_EPI) { if (wr == 0) PG8_BAR; }
    PG8_BAR;
    if constexpr (Epi::AFTER_DRAIN) { E.fused(acc, cur, wr, wc, fr, fq, lds, wid, lane); S.done(cur); }
#undef PG8_SA
#undef PG8_SB
#undef PG8_STAGE
#undef PG8_LDA
#undef PG8_LDB
#undef PG8_MMA
#undef PG8_WAIT_V
#undef PG8_WAIT_L
#undef PG8_BAR
#undef PG8_SCHED
}
}
#define LAS __attribute__((address_space(3)))
typedef float f32x4 __attribute__((ext_vector_type(4)));
typedef unsigned u32x4 __attribute__((ext_vector_type(4)));
typedef unsigned u32x2 __attribute__((ext_vector_type(2)));
constexpr int NWAVES = 8, NTHR = 512;
constexpr int LDS_BYTES = 147456;
constexpr int NPHASE = 17;
#ifndef PROBE_DUP
#define PROBE_DUP 0u
#endif
#define ATT_PROBE 0

struct Args { const float* in[24]; float* out; unsigned char* ws; int ph_lo, ph_hi; };
typedef const __attribute__((address_space(4))) unsigned char* kptr_t;
DEV const float* kin(kptr_t kp, int k) { return *(const float* const __attribute__((address_space(4)))*)(kp + 8 * k); }
DEV float* kout(kptr_t kp) { return *(float* const __attribute__((address_space(4)))*)(kp + 192); }
DEV unsigned char* kws(kptr_t kp) { return *(unsigned char* const __attribute__((address_space(4)))*)(kp + 200); }
static_assert(sizeof(Args) == 216, "Args layout");

DEV float wave_sum(float v) {
#pragma unroll
    for (int o = 1; o < 64; o <<= 1) v += __shfl_xor(v, o);
    return v;
}
DEV unsigned pk2(float lo, float hi) { return pg8::cvt_pk_bf16(lo, hi); }

DEV void p0_transpose_item(const float* W, int K, int N, bf16_t* WT, int mode, LAS float* scr, int item, int lane) {
    const int nblk = N / 32, kb = item / nblk, nb = item % nblk, k0 = 64 * kb, n0 = 32 * nb;
#pragma unroll 8
    for (int i = 0; i < 32; ++i) { const int kk = 2 * i + (lane >> 5); scr[kk * 33 + (lane & 31)] = W[(size_t)(k0 + kk) * N + n0 + (lane & 31)]; }
    asm volatile("s_waitcnt lgkmcnt(0)" ::: "memory");
    const int c = lane & 7;
#pragma unroll
    for (int j = 0; j < 4; ++j) { const int nl = (lane >> 3) + 8 * j, n = n0 + nl; const LAS float* s = scr + (8 * c) * 33 + nl;
        const int r = mode == 0 ? n : (256 * (n >> 7) + (n & 127) + (mode == 2 ? 128 : 0));
        u32x4 o; o.x = pk2(s[0 * 33], s[1 * 33]); o.y = pk2(s[2 * 33], s[3 * 33]); o.z = pk2(s[4 * 33], s[5 * 33]); o.w = pk2(s[6 * 33], s[7 * 33]);
        *(u32x4*)(WT + (size_t)r * K + k0 + 8 * c) = o; }
    asm volatile("s_waitcnt lgkmcnt(0)" ::: "memory");
}
DEV void p0_prologue(kptr_t kp, LAS unsigned char* lds, int gw, int NGW, int wave, int lane) {
    LAS float* scr = (LAS float*)(lds + wave * 16384);
    unsigned char* ws = kws(kp);
    constexpr int I_INE = (DM / 64) * (IN_EVEN / 32), I_SQ = (DM / 64) * (DM / 32), I_INO = (DM / 64) * (IN_ODD / 32), I_GU = (DM / 64) * (DFF / 32), I_DN = (DFF / 64) * (DM / 32);
    constexpr int NITEMS = I_INE + 2 * I_SQ + I_INO + 4 * I_GU + 2 * I_DN;
    for (int it = gw; it < NITEMS; it += NGW) {
        int r = it; const float* W; int K, N, mode = 0; bf16_t* dst;
        if (r < I_INE) { W = kin(kp, 1); K = DM; N = IN_EVEN; dst = (bf16_t*)(ws + WS_WINE); }
        else if ((r -= I_INE) < I_SQ) { W = kin(kp, 8); K = DM; N = DM; dst = (bf16_t*)(ws + WS_WOUTE); }
        else if ((r -= I_SQ) < I_INO) { W = kin(kp, 9); K = DM; N = IN_ODD; dst = (bf16_t*)(ws + WS_WINO); }
        else if ((r -= I_INO) < I_SQ) { W = kin(kp, 16); K = DM; N = DM; dst = (bf16_t*)(ws + WS_WOUTO); }
        else if ((r -= I_SQ) < I_GU) { W = kin(kp, 19); K = DM; N = DFF; mode = 1; dst = (bf16_t*)(ws + WS_WGU0); }
        else if ((r -= I_GU) < I_GU) { W = kin(kp, 20); K = DM; N = DFF; mode = 2; dst = (bf16_t*)(ws + WS_WGU0); }
        else if ((r -= I_GU) < I_GU) { W = kin(kp, 19) + (size_t)DM * DFF; K = DM; N = DFF; mode = 1; dst = (bf16_t*)(ws + WS_WGU1); }
        else if ((r -= I_GU) < I_GU) { W = kin(kp, 20) + (size_t)DM * DFF; K = DM; N = DFF; mode = 2; dst = (bf16_t*)(ws + WS_WGU1); }
        else if ((r -= I_GU) < I_DN) { W = kin(kp, 21); K = DFF; N = DM; dst = (bf16_t*)(ws + WS_WDN0); }
        else { r -= I_DN; W = kin(kp, 21) + (size_t)DM * DFF; K = DFF; N = DM; dst = (bf16_t*)(ws + WS_WDN1); }
        p0_transpose_item(W, K, N, dst, mode, scr, r, lane);
    }
    { bf16_t* wsb = (bf16_t*)(ws + WS_SGUW);
      for (int i = gw * 64 + lane; i < 4 * 128 * 128; i += NGW * 64) { const int t = (i >> 7) & 127, sx = i & 127; wsb[i] = sx <= t ? f2bf(kin(kp, 14)[i]) : (bf16_t)0; } }
    const f32x4* x4 = (const f32x4*)kin(kp, 0); u32x2* o2 = (u32x2*)(ws + WS_XB);
    for (size_t i = (size_t)gw * 64 + lane; i < (size_t)MTOK * DM / 4; i += (size_t)NGW * 64) { const f32x4 v = x4[i]; u32x2 w; w.x = pk2(v.x, v.y); w.y = pk2(v.z, v.w); o2[i] = w; }
}
DEV void ln_phase(const float* Y, const float* g, const float* b, float* XF, bf16_t* XB, int gw, int NGW, int lane) {
    f32x4 gv[4], bv[4];
#pragma unroll
    for (int j = 0; j < 4; ++j) { gv[j] = ((const f32x4*)g)[lane + 64 * j]; bv[j] = ((const f32x4*)b)[lane + 64 * j]; }
    for (int m = gw; m < MTOK; m += NGW) {
        const f32x4* xr = (const f32x4*)(Y + (size_t)m * DM) + lane;
        f32x4 v[4]; float s = 0.f;
#pragma unroll
        for (int j = 0; j < 4; ++j) { v[j] = xr[64 * j]; s += (v[j].x + v[j].y) + (v[j].z + v[j].w); }
        const float mean = wave_sum(s) * (1.f / DM); float s2 = 0.f;
#pragma unroll
        for (int j = 0; j < 4; ++j) { v[j] = v[j] - mean; s2 += (v[j].x * v[j].x + v[j].y * v[j].y) + (v[j].z * v[j].z + v[j].w * v[j].w); }
        const float rstd = rsqrtf(wave_sum(s2) * (1.f / DM) + LN_EPS);
        f32x4* of = (f32x4*)(XF + (size_t)m * DM) + lane; u32x2* ob = (u32x2*)(XB + (size_t)m * DM) + lane;
#pragma unroll
        for (int j = 0; j < 4; ++j) { const f32x4 o = v[j] * rstd * gv[j] + bv[j]; of[64 * j] = o; u32x2 w; w.x = pk2(o.x, o.y); w.y = pk2(o.z, o.w); ob[64 * j] = w; }
    }
}

namespace att {
typedef short bf16x8 __attribute__((ext_vector_type(8)));
typedef short s16x4 __attribute__((ext_vector_type(4)));
typedef float f32x16 __attribute__((ext_vector_type(16)));
constexpr int KT_BYTES = 16384, SLOT = 32768, NSLOT = 4;
constexpr int LDS_WSF = NSLOT * SLOT;
constexpr int LDS_TAB = LDS_WSF + 8 * 256;
constexpr int LDS_PM = LDS_TAB + 2064;
constexpr int LDS_FLAG = LDS_PM + 1024;
static_assert(LDS_FLAG + 128 <= LDS_BYTES - 64, "attention LDS map");
DEV void glds16(const void* gsrc, unsigned lds_dst) { unsigned keep;
    asm volatile("s_mov_b32 %0, m0\n\ts_mov_b32 m0, %2\n\ts_nop 0\n\tglobal_load_lds_dwordx4 %1, off\n\ts_mov_b32 m0, %0" : "=&s"(keep) : "v"(gsrc), "s"(lds_dst) : "memory"); }
#define ATT_WAITBAR(N) asm volatile("s_waitcnt vmcnt(" #N ") lgkmcnt(0)\n\ts_barrier" ::: "memory")
constexpr int XROW = 132;
constexpr float LOG2E = 1.4426950408889634f, C1 = 0.125f * LOG2E;
constexpr float SKIP_T = 40.f;
DEV int crow(int reg, int hh) { return (reg & 3) + 8 * (reg >> 2) + 4 * hh; }
DEV s16x4 vtr(const LAS unsigned char* p) { typedef short v4i16_t __attribute__((ext_vector_type(4))); return __builtin_bit_cast(s16x4, __builtin_amdgcn_ds_read_tr16_b64_v4i16((LAS v4i16_t*)p)); }
#define ATT_SB() __builtin_amdgcn_sched_barrier(0)

DEV void knorm_phase(const bf16_t* __restrict__ HP, float* __restrict__ KN2, int gw, int NGW, int lane) {
    for (int t = gw; t < BATCH * 128; t += NGW) {
        float mx = 0.f;
        for (int st = 0; st < 8; ++st) { const u32x4* p = (const u32x4*)(HP + ((size_t)t * 64 + st * 8 + (lane >> 3)) * IN_EVEN + 512 + (lane & 7) * 64); float ss = 0.f;
#pragma unroll
            for (int j = 0; j < 8; ++j) { const u32x4 v = p[j]; const unsigned w[4] = {v.x, v.y, v.z, v.w};
#pragma unroll
                for (int q = 0; q < 4; ++q) { const float a = __uint_as_float(w[q] << 16), c = __uint_as_float(w[q] & 0xffff0000u); ss += a * a + c * c; } }
            mx = __builtin_fmaxf(mx, ss); }
        mx = __builtin_fmaxf(mx, __shfl_xor(mx, 8)); mx = __builtin_fmaxf(mx, __shfl_xor(mx, 16)); mx = __builtin_fmaxf(mx, __shfl_xor(mx, 32));
        if (lane < 8) KN2[(size_t)t * 8 + lane] = mx;
    }
}

template <int MODE> DEV void attn_unit(LAS unsigned char* lds, const bf16_t* __restrict__ HP, bf16_t* __restrict__ MC, int b, int hx, int qb, float lam, const float* __restrict__ subg, const float* __restrict__ relb, const float* __restrict__ KN2, int tid) {
    const int lane = tid & 63, wave = __builtin_amdgcn_readfirstlane(tid >> 6), g = wave >> 2, wq = wave & 3, r = lane & 31, hh = lane >> 5;
    constexpr int QOFF = MODE == 0 ? 0 : 1536, KOFF = MODE == 0 ? 512 : 2048, VOFF = MODE == 0 ? 1024 : 2560, NEB = MODE == 0 ? 4 : 2;
    const size_t row0 = (size_t)b * SEQ; const int q0 = qb * 128;
    const int cw = 2 * qb + (wq >> 1);
    const int kt_lo = MODE == 0 ? 0 : (2 * qb - 8 > 0 ? 2 * qb - 8 : 0), kt_hi = 2 * qb + 1;
    LAS float* wsf = (LAS float*)(lds + LDS_WSF) + wave * 64;
    LAS float* tab = (LAS float*)(lds + LDS_TAB);
    LAS float* PM = (LAS float*)(lds + LDS_PM);
    volatile LAS unsigned* flag = (volatile LAS unsigned*)(lds + LDS_FLAG);
    if (MODE == 1) { for (int i = tid; i < 514; i += NTHR) tab[i] = relb[(2 * hx + (i >= 257 ? 1 : 0)) * 257 + (i >= 257 ? i - 257 : i)] * LOG2E; }
    if (MODE == 0 && wq == 0) {
        float v0 = __builtin_sqrtf(KN2[((size_t)b * 128 + lane) * 8 + hx * 2 + g]), v1 = __builtin_sqrtf(KN2[((size_t)b * 128 + 64 + lane) * 8 + hx * 2 + g]);
#pragma unroll
        for (int o = 1; o < 64; o <<= 1) { const float t0 = __shfl_up(v0, o), t1 = __shfl_up(v1, o); if (lane >= o) { v0 = __builtin_fmaxf(v0, t0); v1 = __builtin_fmaxf(v1, t1); } }
        v1 = __builtin_fmaxf(v1, __shfl(v0, 63));
        PM[g * 128 + lane] = v0; PM[g * 128 + 64 + lane] = v1;
    }
    bf16x8 qf[4]; float qn = 0.f;
    { const bf16_t* qp = HP + (row0 + q0 + 32 * wq + r) * IN_EVEN + QOFF + hx * 128 + g * 64 + hh * 8; float ss = 0.f;
#pragma unroll
      for (int ds = 0; ds < 4; ++ds) { const u32x4 w4 = *(const u32x4*)(qp + 16 * ds); const unsigned w[4] = {w4.x, w4.y, w4.z, w4.w}; unsigned o4[4];
#pragma unroll
          for (int q = 0; q < 4; ++q) { o4[q] = pk2(__uint_as_float(w[q] << 16) * C1, __uint_as_float(w[q] & 0xffff0000u) * C1);
              const float a = __uint_as_float(o4[q] << 16), c = __uint_as_float(o4[q] & 0xffff0000u); ss += a * a + c * c; }
          qf[ds] = __builtin_bit_cast(bf16x8, (u32x4){o4[0], o4[1], o4[2], o4[3]}); }
      ss += __shfl_xor(ss, 32); qn = __builtin_sqrtf(ss) * 1.001f; }
    f32x16 o[NEB];
#pragma unroll
    for (int eb = 0; eb < NEB; ++eb)
#pragma unroll
        for (int i = 0; i < 16; ++i) o[eb][i] = 0.f;
    float mhat = 0.f, mtrue = -1e30f, l = 0.f, fpend = 1.f; bool pend = false, have = false; int vlast = 0, plast = 0;
    const int tq = q0 + 32 * wq + r;
    const float sl2 = exp2f(-2.0f * (float)(hx + 1)) * LOG2E;
    const unsigned lds0 = (unsigned)(unsigned long long)lds;
    const bf16_t* ksrc[2]; const bf16_t* vsrc[2];
#pragma unroll
    for (int j = 0; j < 2; ++j) { const int srow = 8 * wave + 4 * j + (lane >> 4), pc = lane & 15;
        ksrc[j] = HP + (row0 + srow) * IN_EVEN + KOFF + hx * 128 + (pc ^ (srow & 15)) * 8;
        vsrc[j] = HP + (row0 + srow) * IN_EVEN + VOFF + hx * 128 + (pc ^ ((srow & 3) << 2)) * 8; }
    const unsigned dst0 = (unsigned)__builtin_amdgcn_readfirstlane((int)(lds0 + wave * 2048));
#define ATT_ISSUE(ktr, slot) do { const int ktc_ = (ktr) > kt_lo ? (ktr) : kt_lo; const size_t to_ = (size_t)(64 * ktc_) * IN_EVEN; const unsigned sd_ = dst0 + (unsigned)(slot) * SLOT; \
        glds16(ksrc[0] + to_, sd_); glds16(ksrc[1] + to_, sd_ + 1024); glds16(vsrc[0] + to_, sd_ + KT_BYTES); glds16(vsrc[1] + to_, sd_ + KT_BYTES + 1024); } while (0)
    ATT_ISSUE(kt_hi, 0); ATT_ISSUE(kt_hi - 1, 1);
    const int p15 = lane & 15, g4 = lane >> 4;
    int kaddr[4], vaddr[NEB];
#pragma unroll
    for (int ds = 0; ds < 4; ++ds) kaddr[ds] = r * 256 + (((g * 8 + ds * 2 + hh) ^ (r & 15)) << 4);
#pragma unroll
    for (int eb = 0; eb < NEB; ++eb) vaddr[eb] = KT_BYTES + (4 * hh + (p15 >> 2)) * 256 + ((((MODE == 1 ? 8 * g : 0) + 4 * eb + 2 * (g4 & 1) + ((p15 & 3) >> 1)) ^ ((p15 >> 2) << 2)) << 4) + 8 * (p15 & 1);
    ATT_WAITBAR(4);
    u32x4 paA[4], paB[4];
#pragma unroll
    for (int n = 0; n < 4; ++n) { paA[n] = (u32x4){0u, 0u, 0u, 0u}; paB[n] = paA[n]; }
    int it = 0, kt = kt_hi; bool fin = false;
#define ATT_LOADV(dst, VB, u) do { _Pragma("unroll") for (int e_ = 0; e_ < 2; ++e_) { const LAS unsigned char* vp_ = (VB) + vaddr[2 * ((u) % (NEB / 2)) + e_] + 4096 * ((u) / (NEB / 2)); \
        const s16x4 lo_ = vtr(vp_), hi_ = vtr(vp_ + 2048); dst[e_] = (bf16x8){lo_[0], lo_[1], lo_[2], lo_[3], hi_[0], hi_[1], hi_[2], hi_[3]}; } } while (0)
#define ATT_MMA(PP, vf, u) do { _Pragma("unroll") for (int e_ = 0; e_ < 2; ++e_) { const int eb_ = 2 * ((u) % (NEB / 2)) + e_; o[eb_] = __builtin_amdgcn_mfma_f32_32x32x16_bf16(__builtin_bit_cast(bf16x8, PP[(u) / (NEB / 2)]), vf[e_], o[eb_], 0, 0, 0); } } while (0)
#define ATT_CHUNK(POUT, c) do { constexpr int j_ = (c) & 7; float x0_, x1_; if ((c) < 8) { x0_ = s0[2 * j_]; x1_ = s0[2 * j_ + 1]; } else { x0_ = s1[2 * j_]; x1_ = s1[2 * j_ + 1]; } \
        rm = __builtin_fmaxf(rm, __builtin_fmaxf(x0_, x1_)); const float p0_ = __builtin_amdgcn_exp2f(x0_), p1_ = __builtin_amdgcn_exp2f(x1_); ls += p0_ + p1_; POUT[(c) >> 2][(c) & 3] = pk2(p0_, p1_); } while (0)
#define ATT_ITER(PIN, POUT, PSEL) do { \
        ATT_ISSUE(kt - 2, (it + 2) & 3);                  \
        const bool active = MODE == 0 ? (kt <= cw) : (kt <= cw && kt >= cw - 8); \
        if (active) { \
            const LAS unsigned char* Kb = lds + (it & 3) * SLOT; const LAS unsigned char* Vp = lds + vlast * SLOT; \
            f32x16 s0, s1; const int dbase = tq - (64 * kt + 4 * hh); \
            if (MODE == 0) { const float bl = -sl2 * (float)dbase - mhat, bl1 = bl + 32.f * sl2;        \
                _Pragma("unroll") for (int i = 0; i < 16; ++i) { const float of = (float)((i & 3) + 8 * (i >> 2)); s0[i] = __builtin_fmaf(of, sl2, bl); s1[i] = __builtin_fmaf(of, sl2, bl1); } \
                if (kt == cw) { const float df = (float)dbase, s2 = 2.f * sl2;                            \
                    _Pragma("unroll") for (int i = 0; i < 16; ++i) { const float of = (float)((i & 3) + 8 * (i >> 2)); s0[i] = __builtin_fmaf(__builtin_fminf(df - of, 0.f), s2, s0[i]); s1[i] = __builtin_fmaf(__builtin_fminf(df - of - 32.f, 0.f), s2, s1[i]); } } \
            } else { \
                if (kt <= cw - 3) { const float tf = tab[g * 257 + 256] - mhat; _Pragma("unroll") for (int i = 0; i < 16; ++i) { s0[i] = tf; s1[i] = tf; } } \
                else { _Pragma("unroll") for (int i = 0; i < 16; ++i) { const int off = (i & 3) + 8 * (i >> 2); int r0 = dbase - off, r1 = r0 - 32; \
                        r0 = r0 < -128 ? -128 : (r0 > 128 ? 128 : r0); r1 = r1 < -128 ? -128 : (r1 > 128 ? 128 : r1); s0[i] = tab[g * 257 + 128 + r0] - mhat; s1[i] = tab[g * 257 + 128 + r1] - mhat; } } \
            } \
            { bf16x8 ka0, ka1, kb0, kb1;                   \
              ATT_SB(); ka0 = *(const LAS bf16x8*)(Kb + kaddr[0]); ka1 = *(const LAS bf16x8*)(Kb + kaddr[0] + 8192); kb0 = *(const LAS bf16x8*)(Kb + kaddr[1]); kb1 = *(const LAS bf16x8*)(Kb + kaddr[1] + 8192); ATT_SB(); \
              s0 = __builtin_amdgcn_mfma_f32_32x32x16_bf16(ka0, qf[0], s0, 0, 0, 0); s1 = __builtin_amdgcn_mfma_f32_32x32x16_bf16(ka1, qf[0], s1, 0, 0, 0); ATT_SB(); \
              ka0 = *(const LAS bf16x8*)(Kb + kaddr[2]); ka1 = *(const LAS bf16x8*)(Kb + kaddr[2] + 8192); ATT_SB(); \
              s0 = __builtin_amdgcn_mfma_f32_32x32x16_bf16(kb0, qf[1], s0, 0, 0, 0); s1 = __builtin_amdgcn_mfma_f32_32x32x16_bf16(kb1, qf[1], s1, 0, 0, 0); ATT_SB(); \
              kb0 = *(const LAS bf16x8*)(Kb + kaddr[3]); kb1 = *(const LAS bf16x8*)(Kb + kaddr[3] + 8192); ATT_SB(); \
              s0 = __builtin_amdgcn_mfma_f32_32x32x16_bf16(ka0, qf[2], s0, 0, 0, 0); s1 = __builtin_amdgcn_mfma_f32_32x32x16_bf16(ka1, qf[2], s1, 0, 0, 0); ATT_SB(); \
              s0 = __builtin_amdgcn_mfma_f32_32x32x16_bf16(kb0, qf[3], s0, 0, 0, 0); s1 = __builtin_amdgcn_mfma_f32_32x32x16_bf16(kb1, qf[3], s1, 0, 0, 0); ATT_SB(); } \
            float rm = -1e30f, ls = 0.f; \
            { bf16x8 vfa[2], vfb[2];                     \
                ATT_SB(); ATT_LOADV(vfa, Vp, 0); ATT_LOADV(vfb, Vp, 1); ATT_SB(); \
                if constexpr (NEB == 4) { \
                    ATT_MMA(PIN, vfa, 0); ATT_SB(); ATT_CHUNK(POUT, 0); ATT_CHUNK(POUT, 1); ATT_SB(); ATT_LOADV(vfa, Vp, 2); ATT_SB(); ATT_MMA(PIN, vfb, 1); ATT_SB(); ATT_CHUNK(POUT, 2); ATT_CHUNK(POUT, 3); ATT_SB(); ATT_LOADV(vfb, Vp, 3); ATT_SB(); \
                    ATT_MMA(PIN, vfa, 2); ATT_SB(); ATT_CHUNK(POUT, 4); ATT_CHUNK(POUT, 5); ATT_SB(); ATT_LOADV(vfa, Vp, 4); ATT_SB(); ATT_MMA(PIN, vfb, 3); ATT_SB(); ATT_CHUNK(POUT, 6); ATT_CHUNK(POUT, 7); ATT_SB(); ATT_LOADV(vfb, Vp, 5); ATT_SB(); \
                    ATT_MMA(PIN, vfa, 4); ATT_SB(); ATT_CHUNK(POUT, 8); ATT_CHUNK(POUT, 9); ATT_SB(); ATT_LOADV(vfa, Vp, 6); ATT_SB(); ATT_MMA(PIN, vfb, 5); ATT_SB(); ATT_CHUNK(POUT, 10); ATT_CHUNK(POUT, 11); ATT_SB(); ATT_LOADV(vfb, Vp, 7); ATT_SB(); \
                    ATT_MMA(PIN, vfa, 6); ATT_SB(); ATT_CHUNK(POUT, 12); ATT_CHUNK(POUT, 13); ATT_SB(); ATT_MMA(PIN, vfb, 7); ATT_SB(); ATT_CHUNK(POUT, 14); ATT_CHUNK(POUT, 15); ATT_SB(); \
                } else { \
                    ATT_MMA(PIN, vfa, 0); ATT_SB(); ATT_CHUNK(POUT, 0); ATT_CHUNK(POUT, 1); ATT_CHUNK(POUT, 2); ATT_CHUNK(POUT, 3); ATT_SB(); ATT_LOADV(vfa, Vp, 2); ATT_SB(); ATT_MMA(PIN, vfb, 1); ATT_SB(); ATT_CHUNK(POUT, 4); ATT_CHUNK(POUT, 5); ATT_CHUNK(POUT, 6); ATT_CHUNK(POUT, 7); ATT_SB(); ATT_LOADV(vfb, Vp, 3); ATT_SB(); \
                    ATT_MMA(PIN, vfa, 2); ATT_SB(); ATT_CHUNK(POUT, 8); ATT_CHUNK(POUT, 9); ATT_CHUNK(POUT, 10); ATT_CHUNK(POUT, 11); ATT_SB(); ATT_MMA(PIN, vfb, 3); ATT_SB(); ATT_CHUNK(POUT, 12); ATT_CHUNK(POUT, 13); ATT_CHUNK(POUT, 14); ATT_CHUNK(POUT, 15); ATT_SB(); \
                } \
            } \
            have = true; vlast = it & 3; plast = PSEL; \
            rm = __builtin_fmaxf(rm, __shfl_xor(rm, 32)); mtrue = __builtin_fmaxf(mtrue, mhat + rm); l += ls; \
            if (pend) {                                    \
                if (hh == 0) wsf[r] = fpend; \
                _Pragma("unroll") for (int i = 0; i < 16; ++i) { const float fr = wsf[crow(i, hh)]; _Pragma("unroll") for (int eb = 0; eb < NEB; ++eb) o[eb][i] *= fr; } } \
            pend = __any(rm > 8.f);                       \
            if (pend) { const float dl = __builtin_fmaxf(rm, 0.f); fpend = __builtin_amdgcn_exp2f(-dl); mhat += dl; l *= fpend; } \
        } \
        if (MODE == 0) {                                   \
            bool dn = true; \
            if (kt > 0) { const float ub = qn * PM[g * 128 + kt - 1] - sl2 * (float)(tq - (64 * kt - 1)); dn = ub < mtrue - SKIP_T; } \
            const bool wd = __all(dn); \
            if (lane == 0) flag[(it & 1) * 8 + wave] = wd ? 1u : 0u; } \
        ATT_WAITBAR(4);                                    \
        fin = (kt == kt_lo); \
        if (MODE == 0) { unsigned a_ = 1u; _Pragma("unroll") for (int w = 0; w < 8; ++w) a_ &= flag[(it & 1) * 8 + w]; fin = fin || (a_ != 0u); } \
        --kt; ++it; } while (0)
    for (;;) { ATT_ITER(paA, paB, 1); if (fin) break; ATT_ITER(paB, paA, 0); if (fin) break; }
#undef ATT_ITER
#undef ATT_CHUNK
#undef ATT_ISSUE
    ATT_WAITBAR(0);
    if (have) { const LAS unsigned char* Vp = lds + vlast * SLOT; bf16x8 vf[2];
        if (plast == 1) {
#pragma unroll
            for (int u = 0; u < 2 * NEB; ++u) { ATT_LOADV(vf, Vp, u); ATT_MMA(paB, vf, u); } }
        else {
#pragma unroll
            for (int u = 0; u < 2 * NEB; ++u) { ATT_LOADV(vf, Vp, u); ATT_MMA(paA, vf, u); } }
        if (pend) { if (hh == 0) wsf[r] = fpend;
#pragma unroll
            for (int i = 0; i < 16; ++i) { const float fr = wsf[crow(i, hh)];
#pragma unroll
                for (int eb = 0; eb < NEB; ++eb) o[eb][i] *= fr; } } }
#undef ATT_MMA
#undef ATT_LOADV
    l += __shfl_xor(l, 32);
    if (hh == 0) wsf[r] = 1.0f / l;
#pragma unroll
    for (int i = 0; i < 16; ++i) { const float fr = wsf[crow(i, hh)];
#pragma unroll
        for (int eb = 0; eb < NEB; ++eb) o[eb][i] *= fr; }
    __syncthreads();
    LAS float* X = (LAS float*)lds;
    const int xr = 32 * wq, rrow = xr + (lane >> 1), half = lane & 1;
    const size_t tok = row0 + q0 + rrow;
    if (MODE == 0) {
        if (g == 1) {
#pragma unroll
            for (int eb = 0; eb < NEB; ++eb)
#pragma unroll
                for (int i = 0; i < 16; ++i) X[(xr + crow(i, hh)) * XROW + 32 * eb + r] = o[eb][i];
        }
        __syncthreads();
        if (g == 0) {
#pragma unroll
            for (int eb = 0; eb < NEB; ++eb)
#pragma unroll
                for (int i = 0; i < 16; ++i) { const int ix = (xr + crow(i, hh)) * XROW + 32 * eb + r; X[ix] = o[eb][i] - lam * X[ix]; }
            f32x4 v[16]; float ss = 0.f;
#pragma unroll
            for (int j = 0; j < 16; ++j) { v[j] = *(const LAS f32x4*)(X + rrow * XROW + 64 * half + 4 * j); ss += (v[j].x * v[j].x + v[j].y * v[j].y) + (v[j].z * v[j].z + v[j].w * v[j].w); }
            ss += __shfl_xor(ss, 1);
            const float rs = rsqrtf(ss * (1.f / 128.f) + LN_EPS) * 0.8f;
            bf16_t* op = MC + tok * DM + hx * 128 + 64 * half;
#pragma unroll
            for (int j = 0; j < 8; ++j) { const f32x4 g0 = *(const f32x4*)(subg + 64 * half + 8 * j), g1 = *(const f32x4*)(subg + 64 * half + 8 * j + 4); const f32x4 a0 = v[2 * j] * rs * g0, a1 = v[2 * j + 1] * rs * g1;
                u32x4 w; w.x = pk2(a0.x, a0.y); w.y = pk2(a0.z, a0.w); w.z = pk2(a1.x, a1.y); w.w = pk2(a1.z, a1.w); *(u32x4*)(op + 8 * j) = w; }
        }
    } else {
#pragma unroll
        for (int eb = 0; eb < NEB; ++eb)
#pragma unroll
            for (int i = 0; i < 16; ++i) X[(xr + crow(i, hh)) * XROW + g * 64 + 32 * eb + r] = o[eb][i];
        f32x4 v[8];
#pragma unroll
        for (int j = 0; j < 8; ++j) v[j] = *(const LAS f32x4*)(X + rrow * XROW + g * 64 + 32 * half + 4 * j);
        bf16_t* op = MC + tok * DM + 512 + hx * 128 + g * 64 + 32 * half;
#pragma unroll
        for (int j = 0; j < 4; ++j) { const f32x4 a0 = v[2 * j], a1 = v[2 * j + 1]; u32x4 w; w.x = pk2(a0.x, a0.y); w.y = pk2(a0.z, a0.w); w.z = pk2(a1.x, a1.y); w.w = pk2(a1.z, a1.w); *(u32x4*)(op + 8 * j) = w; }
    }
    __syncthreads();
}

DEV void attn_phase(LAS unsigned char* lds, kptr_t kp, const bf16_t* HP, bf16_t* MC, const float* KN2, unsigned* qctr, int tid) {
    float s1 = 0.f, s2 = 0.f;
    { const float* q1 = kin(kp, 2); const float* k1 = kin(kp, 3); const float* q2 = kin(kp, 4); const float* k2 = kin(kp, 5);
      for (int d = 0; d < 64; ++d) { s1 += q1[d] * k1[d]; s2 += q2[d] * k2[d]; } }
    const float lam = expf(s1) - expf(s2) + 0.2f;
    volatile LAS unsigned* slot = (volatile LAS unsigned*)(lds + LDS_FLAG + 64);
    for (;;) {
        if (tid == 0) *slot = __hip_atomic_fetch_add(qctr, 1u, __ATOMIC_RELAXED, __HIP_MEMORY_SCOPE_AGENT);
        __syncthreads();
        int idx = (int)*slot;
#if ATT_PROBE
        if (idx >= 3072) break;
        if (idx >= 2048) idx = idx - 2048 + (ATT_PROBE == 2 ? 1024 : 0);
#else
        if (idx >= 2048) break;
#endif
        if (idx < 1024) { const int qb = 63 - (idx >> 4), hx = 3 - ((idx >> 2) & 3), b = idx & 3;
            attn_unit<0>(lds, HP, MC, b, hx, qb, lam, kin(kp, 6), nullptr, KN2, tid); }
        else { const int id = idx - 1024;
            attn_unit<1>(lds, HP, MC, id >> 8, (id >> 6) & 3, id & 63, 0.f, nullptr, kin(kp, 7), nullptr, tid); }
    }
    __syncthreads();
}
#undef ATT_SB
}

namespace mix1 {
using att::bf16x8; using att::s16x4; using att::f32x16; using att::crow; using att::vtr;
constexpr int VSTR = 1088;
constexpr float LOG2E = 1.4426950408889634f;
DEV float lg2gamma(int h) { return __builtin_log2f(1.f - __builtin_amdgcn_exp2f(-5.f - (float)h)); }
DEV bf16x8 trpair(const LAS unsigned char* p, int hi_off) { const s16x4 lo = vtr(p), hi = vtr(p + hi_off); return (bf16x8){lo[0], lo[1], lo[2], lo[3], hi[0], hi[1], hi[2], hi[3]}; }

template <int KSTR, bool KSCALE> DEV void stage_kv(LAS unsigned char* lds, const bf16_t* __restrict__ HP, size_t tok0, int tid) {
    constexpr int VOFFB = 64 * KSTR;
#pragma unroll
    for (int i = 0; i < 4; ++i) { const int ck = tid + NTHR * i, row = ck >> 5, cc = ck & 31;
        u32x4 v = *(const u32x4*)(HP + (tok0 + row) * IN_ODD + 256 + cc * 8);
        if (KSCALE) { const float f = 0.125f * __builtin_amdgcn_exp2f((float)(63 - row) * lg2gamma(cc >> 3));
            unsigned w[4] = {v.x, v.y, v.z, v.w};
#pragma unroll
            for (int j = 0; j < 4; ++j) w[j] = pk2(__uint_as_float(w[j] << 16) * f, __uint_as_float(w[j] & 0xffff0000u) * f);
            v = (u32x4){w[0], w[1], w[2], w[3]}; }
        *(LAS u32x4*)(lds + row * KSTR + cc * 16) = v; }
#pragma unroll
    for (int i = 0; i < 8; ++i) { const int ck = tid + NTHR * i, row = ck >> 6, cc = ck & 63;
        *(LAS u32x4*)(lds + VOFFB + row * VSTR + cc * 16) = *(const u32x4*)(HP + (tok0 + row) * IN_ODD + 512 + cc * 8); }
}

DEV void ret_kv_phase(LAS unsigned char* lds, const bf16_t* __restrict__ HP, float* __restrict__ KV, int vcu, int G, int tid) {
    constexpr int KSTR = 576;
    const int lane = tid & 63, wave = __builtin_amdgcn_readfirstlane(tid >> 6), h = wave >> 1, dblk = wave & 1, r = lane & 31, hh = lane >> 5, p15 = lane & 15, g4 = lane >> 4;
    const int rowl = 4 * hh + (p15 >> 2), coll = 16 * (g4 & 1) + 4 * (p15 & 3);
    for (int u = vcu; u < BATCH * 128; u += G) { const int b = u >> 7, c = u & 127; const size_t tok0 = (size_t)b * SEQ + 64 * c;
        stage_kv<KSTR, true>(lds, HP, tok0, tid);
        __syncthreads();
        f32x16 acc[4];
#pragma unroll
        for (int eb = 0; eb < 4; ++eb)
#pragma unroll
            for (int i = 0; i < 16; ++i) acc[eb][i] = 0.f;
#pragma unroll
        for (int ks = 0; ks < 4; ++ks) {
            const bf16x8 kf = trpair(lds + (16 * ks + rowl) * KSTR + (h * 64 + 32 * dblk + coll) * 2, 8 * KSTR);
#pragma unroll
            for (int eb = 0; eb < 4; ++eb) { const bf16x8 vf = trpair(lds + 64 * KSTR + (16 * ks + rowl) * VSTR + (h * 128 + 32 * eb + coll) * 2, 8 * VSTR);
                acc[eb] = __builtin_amdgcn_mfma_f32_32x32x16_bf16(vf, kf, acc[eb], 0, 0, 0); }
        }
        float* o = KV + ((size_t)((b * 4 + h) * 128 + c) * 128) * 64 + 32 * dblk + r;
#pragma unroll
        for (int eb = 0; eb < 4; ++eb)
            { float* oq = o + (32 * eb + 4 * hh) * 64;
#pragma unroll
              for (int i = 0; i < 16; ++i) { *oq = acc[eb][i]; oq += ((i & 3) == 3 ? 5 : 1) * 64; asm volatile("" : "+v"(oq)); } }
        __syncthreads();
    }
}
DEV void ret_scan_phase(const float* __restrict__ KV, bf16_t* __restrict__ PREV, int vcu, int G, int tid) {
    for (int idx = vcu * NTHR + tid; idx < 16 * 8192; idx += G * NTHR) { const int bh = idx >> 13, ed = idx & 8191;
        const float cd = __builtin_amdgcn_exp2f(64.f * lg2gamma(bh & 3)); float st = 0.f;
        const float* kv = KV + (size_t)bh * 128 * 8192 + ed; bf16_t* pv = PREV + (size_t)bh * 128 * 8192 + ed;
#pragma unroll 8
        for (int c = 0; c < 128; ++c) { const float x = kv[(size_t)c * 8192]; pv[(size_t)c * 8192] = f2bf(st); st = st * cd + x; }
    }
}
DEV void ret_out_phase(LAS unsigned char* lds, const bf16_t* __restrict__ HP, const bf16_t* __restrict__ PREV, const float* __restrict__ gng, const float* __restrict__ gnb, bf16_t* __restrict__ MC, int vcu, int G, int tid) {
    constexpr int KSTR = 528;
    const int lane = tid & 63, wave = __builtin_amdgcn_readfirstlane(tid >> 6), h = wave >> 1, lb = wave & 1, r = lane & 31, hh = lane >> 5, p15 = lane & 15, g4 = lane >> 4;
    const float lg = lg2gamma(h);
    const int vlane = 64 * KSTR + (4 * hh + (p15 >> 2)) * VSTR + (h * 128 + 16 * (g4 & 1) + 4 * (p15 & 3)) * 2;
    for (int u = vcu; u < BATCH * 128; u += G) { const int b = u >> 7, c = u & 127; const size_t tok0 = (size_t)b * SEQ + 64 * c;
        stage_kv<KSTR, false>(lds, HP, tok0, tid);
        bf16x8 qf[4];
        { const bf16_t* qp = HP + (tok0 + 32 * lb + r) * IN_ODD + h * 64 + hh * 8;
#pragma unroll
          for (int ds = 0; ds < 4; ++ds) qf[ds] = *(const bf16x8*)(qp + 16 * ds); }
        f32x16 acc[4];
        { const bf16_t* pp = PREV + ((size_t)((b * 4 + h) * 128 + c) * 128 + r) * 64 + hh * 8;
#pragma unroll
          for (int eb = 0; eb < 4; ++eb) {
#pragma unroll
              for (int i = 0; i < 16; ++i) acc[eb][i] = 0.f;
#pragma unroll
              for (int ds = 0; ds < 4; ++ds) { const bf16x8 pf = *(const bf16x8*)(pp + (size_t)(32 * eb) * 64 + 16 * ds); acc[eb] = __builtin_amdgcn_mfma_f32_32x32x16_bf16(qf[ds], pf, acc[eb], 0, 0, 0); } } }
#pragma unroll
        for (int i = 0; i < 16; ++i) { const float qd = __builtin_amdgcn_exp2f((float)(32 * lb + crow(i, hh) + 1) * lg);
#pragma unroll
            for (int eb = 0; eb < 4; ++eb) acc[eb][i] *= qd; }
        __syncthreads();
        for (int mb = 0; mb <= lb; ++mb) {
            f32x16 s;
#pragma unroll
            for (int i = 0; i < 16; ++i) s[i] = 0.f;
#pragma unroll
            for (int ds = 0; ds < 4; ++ds) { const bf16x8 kf = *(const LAS bf16x8*)(lds + (32 * mb + r) * KSTR + (h * 64 + 16 * ds + 8 * hh) * 2); s = __builtin_amdgcn_mfma_f32_32x32x16_bf16(kf, qf[ds], s, 0, 0, 0); }
            const int dbase = 32 * lb + r - 32 * mb - 4 * hh;
#pragma unroll
            for (int i = 0; i < 16; ++i) { const int df = dbase - ((i & 3) + 8 * (i >> 2)); const float w = 0.125f * __builtin_amdgcn_exp2f((float)df * lg); s[i] = df >= 0 ? s[i] * w : 0.f; }
#pragma unroll
            for (int sx = 0; sx < 2; ++sx) { u32x4 w; w.x = pk2(s[8 * sx + 0], s[8 * sx + 1]); w.y = pk2(s[8 * sx + 2], s[8 * sx + 3]); w.z = pk2(s[8 * sx + 4], s[8 * sx + 5]); w.w = pk2(s[8 * sx + 6], s[8 * sx + 7]);
                const bf16x8 pa = __builtin_bit_cast(bf16x8, w);
#pragma unroll
                for (int eb = 0; eb < 4; ++eb) { const bf16x8 vf = trpair(lds + vlane + (32 * mb + 16 * sx) * VSTR + eb * 64, 8 * VSTR); acc[eb] = __builtin_amdgcn_mfma_f32_32x32x16_bf16(pa, vf, acc[eb], 0, 0, 0); } }
        }
        float mu[16], rs[16];
#pragma unroll
        for (int i = 0; i < 16; ++i) { float s1 = (acc[0][i] + acc[1][i]) + (acc[2][i] + acc[3][i]);
#pragma unroll
            for (int o = 1; o < 32; o <<= 1) s1 += __shfl_xor(s1, o);
            const float m = s1 * (1.f / 128.f); float s2 = 0.f;
#pragma unroll
            for (int eb = 0; eb < 4; ++eb) { const float d = acc[eb][i] - m; s2 += d * d; }
#pragma unroll
            for (int o = 1; o < 32; o <<= 1) s2 += __shfl_xor(s2, o);
            mu[i] = m; rs[i] = rsqrtf(s2 * (1.f / 128.f) + LN_EPS); }
        const bf16_t* gp = HP + tok0 * IN_ODD + 1024; bf16_t* mp = MC + tok0 * DM;
#pragma unroll
        for (int eb = 0; eb < 4; ++eb) { const int col = h * 128 + 32 * eb + r; const float gg = gng[col], bb = gnb[col];
            const bf16_t* gq = gp + (32 * lb + 4 * hh) * IN_ODD + col; bf16_t* mq = mp + (32 * lb + 4 * hh) * DM + col;
#pragma unroll
            for (int i = 0; i < 16; ++i) { const float gt = bf2f(*gq);
                const float y = (acc[eb][i] - mu[i]) * rs[i] * gg + bb; *mq = f2bf(y * pg8::e_silu(gt));
                const int step = (i & 3) == 3 ? 5 : 1; gq += step * IN_ODD; mq += step * DM; asm volatile("" : "+v"(gq), "+v"(mq)); } }
        __syncthreads();
    }
}

DEV void sgu_phase(LAS unsigned char* lds, const bf16_t* __restrict__ HP, const bf16_t* __restrict__ WSB, const float* __restrict__ lng, const float* __restrict__ lnb, const float* __restrict__ bs, bf16_t* __restrict__ MC, int vcu, int G, int tid) {
    constexpr int TSTR = 320, TOFF = 1024;
    const int lane = tid & 63, wave = __builtin_amdgcn_readfirstlane(tid >> 6), r = lane & 31, hh = lane >> 5, p15 = lane & 15, g4 = lane >> 4;
    LAS float* stats = (LAS float*)lds;
    const int cb = wave & 3, whalf = wave >> 2;
    for (int u = vcu; u < MTOK / 128; u += G) { const size_t tok0 = (size_t)u * 128;
        const bf16_t* up = HP + tok0 * IN_ODD + 1536; bf16_t* mp = MC + tok0 * DM + 512;
        for (int i = 0; i < 16; ++i) { const int row = 16 * wave + i; const u32x4 v = *(const u32x4*)(HP + (tok0 + row) * IN_ODD + 2048 + lane * 8);
            float x[8] = {__uint_as_float(v.x << 16), __uint_as_float(v.x & 0xffff0000u), __uint_as_float(v.y << 16), __uint_as_float(v.y & 0xffff0000u), __uint_as_float(v.z << 16), __uint_as_float(v.z & 0xffff0000u), __uint_as_float(v.w << 16), __uint_as_float(v.w & 0xffff0000u)};
            float s1 = 0.f;
#pragma unroll
            for (int j = 0; j < 8; ++j) s1 += x[j];
            const float m = wave_sum(s1) * (1.f / 512.f); float s2 = 0.f;
#pragma unroll
            for (int j = 0; j < 8; ++j) { const float d = x[j] - m; s2 += d * d; }
            const float rstd = rsqrtf(wave_sum(s2) * (1.f / 512.f) + LN_EPS);
            if (lane == 0) { stats[2 * row] = m; stats[2 * row + 1] = rstd; } }
        __syncthreads();
        for (int g = 0; g < 4; ++g) {
#pragma unroll
            for (int i = 0; i < 4; ++i) { const int ck = tid + NTHR * i, row = ck >> 4, cc = ck & 15; const int ch = g * 128 + cc * 8;
                const u32x4 v = *(const u32x4*)(HP + (tok0 + row) * IN_ODD + 2048 + ch);
                const float m = stats[2 * row], rstd = stats[2 * row + 1];
                const f32x4 g0 = *(const f32x4*)(lng + ch), g1 = *(const f32x4*)(lng + ch + 4), b0 = *(const f32x4*)(lnb + ch), b1 = *(const f32x4*)(lnb + ch + 4);
                u32x4 w;
                w.x = pk2((__uint_as_float(v.x << 16) - m) * rstd * g0.x + b0.x, (__uint_as_float(v.x & 0xffff0000u) - m) * rstd * g0.y + b0.y);
                w.y = pk2((__uint_as_float(v.y << 16) - m) * rstd * g0.z + b0.z, (__uint_as_float(v.y & 0xffff0000u) - m) * rstd * g0.w + b0.w);
                w.z = pk2((__uint_as_float(v.z << 16) - m) * rstd * g1.x + b1.x, (__uint_as_float(v.z & 0xffff0000u) - m) * rstd * g1.y + b1.y);
                w.w = pk2((__uint_as_float(v.w << 16) - m) * rstd * g1.z + b1.z, (__uint_as_float(v.w & 0xffff0000u) - m) * rstd * g1.w + b1.w);
                *(LAS u32x4*)(lds + TOFF + row * TSTR + cc * 16) = w; }
            __syncthreads();
#pragma unroll
            for (int j = 0; j < 2; ++j) { const int tb = whalf == 0 ? (j == 0 ? 0 : 3) : (j == 0 ? 1 : 2);
                f32x16 acc;
#pragma unroll
                for (int i = 0; i < 16; ++i) acc[i] = 0.f;
                const bf16_t* wp = WSB + ((size_t)g * 128 + 32 * tb + r) * 128 + hh * 8;
                for (int ks = 0; ks < 2 * (tb + 1); ++ks) {
                    const bf16x8 wf = *(const bf16x8*)(wp + 16 * ks);
                    const bf16x8 vf = trpair(lds + TOFF + (16 * ks + 8 * hh + (p15 >> 2)) * TSTR + (32 * cb + 16 * (g4 & 1) + 4 * (p15 & 3)) * 2, 4 * TSTR);
                    acc = __builtin_amdgcn_mfma_f32_32x32x16_bf16(wf, vf, acc, 0, 0, 0);
                }
                const int col = g * 128 + 32 * cb + r;
                const bf16_t* uq = up + (32 * tb + 4 * hh) * IN_ODD + col; bf16_t* mq = mp + (32 * tb + 4 * hh) * DM + col; const float* bq = bs + g * 128 + 32 * tb + 4 * hh;
#pragma unroll
                for (int i = 0; i < 16; ++i) { const float uu = bf2f(*uq); *mq = f2bf(uu * (acc[i] + *bq));
                    const int step = (i & 3) == 3 ? 5 : 1; uq += step * IN_ODD; mq += step * DM; bq += step; asm volatile("" : "+v"(uq), "+v"(mq), "+v"(bq)); }
            }
            __syncthreads();
        }
    }
}
}

#define XB_TMO      128
#define XB_XCNT(j)  (256  + 64 * (j))
#define XB_XSUB(j)  (1280 + 64 * (j))
#define XB_XGEN(j)  (2304 + 64 * (j))
#define XB_TOP      3328
#define XB_TOPGEN   3392
#define XCD_BAR_WORDS 3456
#define XB_SPIN_CAP (1u << 18)

__device__ __forceinline__ unsigned xb_ld(unsigned* p)              { return __hip_atomic_load(p, __ATOMIC_RELAXED, __HIP_MEMORY_SCOPE_AGENT); }
__device__ __forceinline__ unsigned xb_add(unsigned* p, unsigned v) { return __hip_atomic_fetch_add(p, v, __ATOMIC_RELAXED, __HIP_MEMORY_SCOPE_AGENT); }
__device__ __forceinline__ unsigned xb_xcc_id() { return (unsigned)__builtin_amdgcn_s_getreg((3 << 11) | 20) & 0xFu; }
#define XB_SPIN(cond, bar) do { unsigned _sp = 0; while (cond) { __builtin_amdgcn_s_sleep(1); \
    if ((++_sp & 255u) == 0u) { if (xb_ld(&(bar)[XB_TMO])) break; if (_sp > XB_SPIN_CAP) { atomicAdd(&(bar)[XB_TMO], 1u); break; } } } } while (0)

struct XcdBarrier {
    unsigned* bar; unsigned x;
    volatile LAS unsigned* st;
};

__device__ __forceinline__ XcdBarrier xcd_barrier_post(unsigned* bar, volatile LAS unsigned* st) {
    XcdBarrier b; b.bar = bar; b.x = xb_xcc_id(); b.st = st;
    if (threadIdx.x == 0) (void)xb_add(&bar[XB_XCNT(b.x)], 1u);
    return b;
}
__device__ __forceinline__ void xcd_barrier_complete(unsigned* bar, unsigned x, unsigned& nloc, unsigned& nx) {
    const unsigned G = gridDim.x * gridDim.y * gridDim.z;
    unsigned sum, cnt, mine, sp = 0u;
    for (;;) {
        sum = 0u; cnt = 0u; mine = 0u;
#pragma unroll
        for (unsigned j = 0; j < 16; ++j) { const unsigned c = xb_ld(&bar[XB_XCNT(j)]); sum += c; cnt += (c > 0u) ? 1u : 0u; mine = (j == x) ? c : mine; }
        if (sum == G) break;
        __builtin_amdgcn_s_sleep(1);
        if ((++sp & 255u) == 0u) { if (xb_ld(&bar[XB_TMO])) break; if (sp > XB_SPIN_CAP) { atomicAdd(&bar[XB_TMO], 1u); break; } }
    }
    nloc = mine > 0u ? mine : 1u; nx = cnt > 0u ? cnt : 1u;
}

__device__ __forceinline__ void xcd_barrier(const XcdBarrier& b) {
    asm volatile("s_waitcnt vmcnt(0)" ::: "memory");
    __syncthreads();
    if (threadIdx.x == 0) {
        unsigned* bar = b.bar;
        __builtin_amdgcn_s_waitcnt(0);
        unsigned nloc = b.st[0], nx = b.st[1];
        if (nloc == 0u) { xcd_barrier_complete(bar, b.x, nloc, nx); b.st[0] = nloc; b.st[1] = nx; }
        const unsigned old = xb_add(&bar[XB_XSUB(b.x)], 1u);
        const unsigned gen = old / nloc;
        if (old + 1u == (gen + 1u) * nloc) {
            __builtin_amdgcn_fence(__ATOMIC_RELEASE, "agent");
            asm volatile("s_waitcnt vmcnt(0)" ::: "memory");
            const unsigned og = xb_add(&bar[XB_TOP], 1u);
            const unsigned tg = og / nx;
            if (og + 1u == (tg + 1u) * nx) xb_add(&bar[XB_TOPGEN], 1u);
            else XB_SPIN(xb_ld(&bar[XB_TOPGEN]) == tg, bar);
            __builtin_amdgcn_fence(__ATOMIC_ACQUIRE, "agent");
            xb_add(&bar[XB_XGEN(b.x)], 1u);
            asm volatile("s_waitcnt vmcnt(0)" ::: "memory");
        } else {
            XB_SPIN(xb_ld(&bar[XB_XGEN(b.x)]) == gen, bar);
            __builtin_amdgcn_fence(__ATOMIC_ACQUIRE, "agent");
            asm volatile("s_waitcnt vmcnt(0)" ::: "memory");
        }
    }
    __syncthreads();
}

__global__ void __launch_bounds__(NTHR, 2) mk_fwd(Args a) {
    extern __shared__ __attribute__((aligned(16))) unsigned char lds_raw[];
    LAS unsigned char* lds = (LAS unsigned char*)lds_raw;
    volatile LAS unsigned* MISC = (volatile LAS unsigned*)(lds + LDS_BYTES - 64);
    if (threadIdx.x < 16) MISC[threadIdx.x] = 0u;
    __syncthreads();
    XcdBarrier bar; bar.bar = nullptr; bar.x = 0; bar.st = nullptr;
    bar = xcd_barrier_post((unsigned*)(a.ws + WS_CTL) + 1024, MISC + 8);
    for (int ph = a.ph_lo; ph < a.ph_hi; ++ph)
    for (int rep = 0; rep < 1 + (int)((PROBE_DUP >> ph) & 1u); ++rep) {
        int tid = threadIdx.x; asm volatile("" : "+v"(tid));
        kptr_t kp = (kptr_t)__builtin_amdgcn_kernarg_segment_ptr(); asm volatile("" : "+s"(kp));
        unsigned char* ws = kws(kp);
        const int lane = tid & 63, wave = __builtin_amdgcn_readfirstlane(tid >> 6);
        const int G = gridDim.x, bx = blockIdx.x;
        const int vcu = (G % 8 == 0) ? (bx % 8) * (G / 8) + bx / 8 : bx;
        const int gw = vcu * NWAVES + wave, NGW = G * NWAVES;
        bf16_t* XB = (bf16_t*)(ws + WS_XB); bf16_t* HP = (bf16_t*)(ws + WS_HP); bf16_t* MC = (bf16_t*)(ws + WS_MC); float* Y = (float*)(ws + WS_Y); float* XF = kout(kp);
        const int L = ph >= 8 ? 1 : 0;
        switch (ph) {
        case 0: p0_prologue(kp, lds, gw, NGW, wave, lane); break;
        case 1: case 8: {
            const int N = L ? IN_ODD : IN_EVEN;
            pg8::Gemm g{XB, (const bf16_t*)(ws + (L ? WS_WINO : WS_WINE)), MTOK, N, DM}; pg8::StaticOrder S; S.init(MTOK, N, G, bx);
            pg8::EpiBf16G E{HP, N, L ? 6 : (1 << 30)};
            pg8::gemm_phase<pg8::EpiBf16G, pg8::StaticOrder, true, true>(lds, g, S, E, tid);
        } break;
        case 3: case 12: case 6: case 15: {
            const bool dn = (ph == 6 || ph == 15);
            const bf16_t* A = dn ? HP : MC; const int K = dn ? DFF : DM;
            const bf16_t* Bt = (const bf16_t*)(ws + (dn ? (L ? WS_WDN1 : WS_WDN0) : (L ? WS_WOUTO : WS_WOUTE)));
            const float* R = (ph == 3) ? kin(kp, 0) : XF;
            pg8::Gemm g{A, Bt, MTOK, DM, K}; pg8::StaticOrder S; S.init(MTOK, DM, G, bx);
            pg8::EpiResid E{R, Y, DM, ALPHA};
            pg8::gemm_phase<pg8::EpiResid, pg8::StaticOrder, true, true>(lds, g, S, E, tid);
        } break;
        case 4: case 7: case 13: case 16: {
            const bool ffn = (ph == 7 || ph == 16);
            ln_phase(Y, kin(kp, ffn ? 22 : 17) + L * DM, kin(kp, ffn ? 23 : 18) + L * DM, XF, XB, gw, NGW, lane);
        } break;
        case 5: case 14: {
            pg8::Gemm g{XB, (const bf16_t*)(ws + (L ? WS_WGU1 : WS_WGU0)), MTOK, 2 * DFF, DM}; pg8::StaticOrder S; S.init(MTOK, 2 * DFF, G, bx);
            pg8::EpiSwiglu E{HP, DFF};
            pg8::gemm_phase<pg8::EpiSwiglu, pg8::StaticOrder, true, true>(lds, g, S, E, tid);
        } break;
        case 2: { float* KN2 = (float*)(ws + WS_KN2);
                  att::knorm_phase(HP, KN2, gw, NGW, lane); xcd_barrier(bar);
                  att::attn_phase(lds, kp, HP, MC, KN2, (unsigned*)(ws + WS_CTL) + 64 + 64 * rep, tid); } break;
        case 9: mix1::ret_kv_phase(lds, HP, (float*)(ws + WS_Y), vcu, G, tid);
                mix1::sgu_phase(lds, HP, (const bf16_t*)(ws + WS_SGUW), kin(kp, 12), kin(kp, 13), kin(kp, 15), MC, vcu, G, tid); break;
        case 10: mix1::ret_scan_phase((const float*)(ws + WS_Y), (bf16_t*)(ws + WS_Y + 64 * MiB), vcu, G, tid); break;
        case 11: mix1::ret_out_phase(lds, HP, (const bf16_t*)(ws + WS_Y + 64 * MiB), kin(kp, 10), kin(kp, 11), MC, vcu, G, tid); break;
        default: break;
        }
        if (ph + 1 < a.ph_hi || rep < (int)((PROBE_DUP >> ph) & 1u)) xcd_barrier(bar);
    }
}
extern "C" void kernel_launch(void* const* d_in, const int* in_sizes, int n_in, void* d_out, int out_size, void* d_ws, size_t ws_size, hipStream_t stream) {
    static int grid = 0;
    if (grid == 0) {
        if (n_in != 24 || ws_size < WS_END || out_size != MTOK * DM) { fprintf(stderr, "kernel_launch: unexpected shapes (n_in %d ws %zu out %d)\n", n_in, ws_size, out_size); grid = -1; return; }
        int dev = 0, cus = 0, per_cu = 0;
        hipGetDevice(&dev); hipDeviceGetAttribute(&cus, hipDeviceAttributeMultiprocessorCount, dev);
        if (hipFuncSetAttribute((const void*)mk_fwd, hipFuncAttributeMaxDynamicSharedMemorySize, LDS_BYTES) != hipSuccess) { fprintf(stderr, "hipFuncSetAttribute failed\n"); grid = -1; return; }
        hipOccupancyMaxActiveBlocksPerMultiprocessor(&per_cu, (const void*)mk_fwd, NTHR, LDS_BYTES);
        if (per_cu < 1) { fprintf(stderr, "occupancy query says %d blocks/CU\n", per_cu); }
        (void)hipGetLastError();
        grid = cus;
    }
    if (grid < 0) return;
    const float* const* in = (const float* const*)d_in;
    unsigned char* ws = (unsigned char*)d_ws;
    bf16_t* HP = (bf16_t*)(ws + WS_HP); bf16_t* MC = (bf16_t*)(ws + WS_MC); float* Y = (float*)(ws + WS_Y);
    Args a{};
    for (int i = 0; i < 24; ++i) a.in[i] = in[i];
    a.out = (float*)d_out; a.ws = ws;
    auto run = [&](int lo, int hi) { a.ph_lo = lo; a.ph_hi = hi; hipLaunchKernelGGL(mk_fwd, dim3(grid), dim3(NTHR), LDS_BYTES, stream, a); };
    hipMemsetAsync(ws + WS_CTL, 0, 65536, stream);
    run(0, NPHASE);
}
```

```cpp
#include <hip/hip_runtime.h>
#include <cstdio>
#include <cstdint>

typedef unsigned short bf16_t;
#define DEV __device__ __forceinline__

constexpr int BATCH = 4, SEQ = 8192, DM = 1024, MTOK = BATCH * SEQ;
constexpr int IN_EVEN = 3072, IN_ODD = 2560, DFF = 2816;
constexpr float ALPHA = 1.4142135623730951f, LN_EPS = 1e-5f;

constexpr size_t MiB = 1u << 20;
constexpr size_t WS_CTL = 0;
constexpr size_t WS_WINE = 1 * MiB;
constexpr size_t WS_WOUTE = 7 * MiB;
constexpr size_t WS_WINO = 9 * MiB;
constexpr size_t WS_WOUTO = 14 * MiB;
constexpr size_t WS_WGU0 = 16 * MiB;
constexpr size_t WS_WDN0 = 27 * MiB;
constexpr size_t WS_WGU1 = 33 * MiB;
constexpr size_t WS_WDN1 = 44 * MiB;
constexpr size_t WS_SGUW = 50 * MiB;
constexpr size_t WS_KN2 = 50 * MiB + 512 * 1024;
constexpr size_t WS_XB = 52 * MiB;
constexpr size_t WS_HP = 116 * MiB;
constexpr size_t WS_MC = 308 * MiB;
constexpr size_t WS_Y = 372 * MiB;
constexpr size_t WS_END = 500 * MiB;

DEV float bf2f(bf16_t v) { return __uint_as_float(((unsigned)v) << 16); }
DEV bf16_t f2bf(float f) { unsigned u = __float_as_uint(f); return (bf16_t)((u + 0x7fffu + ((u >> 16) & 1u)) >> 16); }
DEV float gelu_tanh(float x) { const float u = 0.7978845608028654f * (x + 0.044715f * x * x * x); return x / (1.f + __expf(-2.f * u)); }
DEV float silu(float x) { return x / (1.f + __expf(-x)); }

__global__ void __launch_bounds__(256) nv_wt(const float* W, int K, int N, bf16_t* WT, int mode) {
    __shared__ float t[32][33];
    const int n0 = blockIdx.x * 32, k0 = blockIdx.y * 32, tx = threadIdx.x & 31, ty = threadIdx.x >> 5;
    for (int i = ty; i < 32; i += 8) t[i][tx] = W[(size_t)(k0 + i) * N + n0 + tx];
    __syncthreads();
    for (int i = ty; i < 32; i += 8) { const int n = n0 + i; const int r = mode == 0 ? n : (256 * (n >> 7) + (n & 127) + (mode == 2 ? 128 : 0));
        WT[(size_t)r * K + k0 + tx] = f2bf(t[tx][i]); }
}
__global__ void __launch_bounds__(256) nv_cvt(const float* x, bf16_t* o, size_t n) {
    size_t i = (size_t)blockIdx.x * 256 + threadIdx.x; const size_t st = (size_t)gridDim.x * 256;
    for (; i < n; i += st) o[i] = f2bf(x[i]);
}
struct GE { int mode; bf16_t* outb; float* outf; const float* resid; int ldc; int gelu_from; };
__global__ void __launch_bounds__(256) nv_gemm(const bf16_t* A, const bf16_t* Bt, int K, GE e) {
    __shared__ float As[64][33], Bs[64][33], Bs2[64][33];
    const int tid = threadIdx.x, tx = tid & 15, ty = tid >> 4, row0 = blockIdx.y * 64, col0 = blockIdx.x * 64;
    const bool dual = e.mode == 1;
    float acc[4][4], acc2[4][4];
#pragma unroll
    for (int i = 0; i < 4; ++i)
#pragma unroll
        for (int j = 0; j < 4; ++j) { acc[i][j] = 0.f; acc2[i][j] = 0.f; }
    for (int k0 = 0; k0 < K; k0 += 32) {
        for (int i = tid; i < 2048; i += 256) { const int r = i >> 5, c = i & 31;
            As[r][c] = bf2f(A[(size_t)(row0 + r) * K + k0 + c]);
            const int col = col0 + r, br = dual ? (256 * (col >> 7) + (col & 127)) : col;
            Bs[r][c] = bf2f(Bt[(size_t)br * K + k0 + c]);
            if (dual) Bs2[r][c] = bf2f(Bt[(size_t)(br + 128) * K + k0 + c]); }
        __syncthreads();
#pragma unroll 4
        for (int kk = 0; kk < 32; ++kk) {
            float a[4], b[4], b2[4];
#pragma unroll
            for (int i = 0; i < 4; ++i) { a[i] = As[ty * 4 + i][kk]; b[i] = Bs[tx * 4 + i][kk]; b2[i] = dual ? Bs2[tx * 4 + i][kk] : 0.f; }
#pragma unroll
            for (int i = 0; i < 4; ++i)
#pragma unroll
                for (int j = 0; j < 4; ++j) { acc[i][j] += a[i] * b[j]; acc2[i][j] += a[i] * b2[j]; }
        }
        __syncthreads();
    }
#pragma unroll
    for (int i = 0; i < 4; ++i)
#pragma unroll
        for (int j = 0; j < 4; ++j) {
            const int r = row0 + ty * 4 + i, c = col0 + tx * 4 + j; const size_t o = (size_t)r * e.ldc + c;
            if (e.mode == 0) { float v = acc[i][j]; if (c >= e.gelu_from) v = gelu_tanh(v); e.outb[o] = f2bf(v); }
            else if (e.mode == 1) { e.outb[o] = f2bf(silu(acc[i][j]) * acc2[i][j]); }
            else { e.outf[o] = ALPHA * e.resid[o] + acc[i][j]; }
        }
}
__global__ void __launch_bounds__(256) nv_ln(const float* Y, const float* g, const float* b, float* XF, bf16_t* XB) {
    const int row = blockIdx.x * 4 + (threadIdx.x >> 6), lane = threadIdx.x & 63;
    const float* y = Y + (size_t)row * DM; float v[16]; float s = 0.f;
#pragma unroll
    for (int j = 0; j < 16; ++j) { v[j] = y[lane + 64 * j]; s += v[j]; }
#pragma unroll
    for (int o = 1; o < 64; o <<= 1) s += __shfl_xor(s, o);
    const float mean = s * (1.f / DM); float q = 0.f;
#pragma unroll
    for (int j = 0; j < 16; ++j) { v[j] -= mean; q += v[j] * v[j]; }
#pragma unroll
    for (int o = 1; o < 64; o <<= 1) q += __shfl_xor(q, o);
    const float rstd = rsqrtf(q * (1.f / DM) + LN_EPS);
#pragma unroll
    for (int j = 0; j < 16; ++j) { const int c = lane + 64 * j; const float o = v[j] * rstd * g[c] + b[c]; XF[(size_t)row * DM + c] = o; XB[(size_t)row * DM + c] = f2bf(o); }
}
template <int MODE, int DVS> __global__ void __launch_bounds__(256) nv_attn(const bf16_t* HP, float* OT, bf16_t* MC, const float* relb) {
    const int tid = threadIdx.x, qi = tid & 63, es = tid >> 6, c = blockIdx.x;
    int b, h, m = 0;
    if (MODE == 0) { m = blockIdx.y & 1; h = (blockIdx.y >> 1) & 3; b = blockIdx.y >> 3; } else { h = blockIdx.y & 7; b = blockIdx.y >> 3; }
    const int tq = c * 64 + qi;
    const bf16_t* base = HP + (size_t)b * SEQ * IN_EVEN;
    int qcol, kcol, vcol;
    if (MODE == 0) { qcol = h * 128 + m * 64; kcol = 512 + h * 128 + m * 64; vcol = 1024 + h * 128 + es * DVS; }
    else { qcol = 1536 + h * 64; kcol = 2048 + h * 64; vcol = 2560 + h * 64 + es * DVS; }
    float q[64];
#pragma unroll
    for (int d = 0; d < 64; ++d) q[d] = bf2f(base[(size_t)tq * IN_EVEN + qcol + d]) * 0.125f;
    float o[DVS];
#pragma unroll
    for (int e = 0; e < DVS; ++e) o[e] = 0.f;
    float mx = -1e30f, l = 0.f;
    const int k_lo = MODE == 0 ? 0 : ((c - 8) * 64 > 0 ? (c - 8) * 64 : 0), k_hi = (c + 1) * 64;
    const float slope = exp2f(-2.0f * (float)(h + 1));
    for (int key = k_lo; key < k_hi; ++key) {
        const bf16_t* kr = base + (size_t)key * IN_EVEN + kcol;
        float s = 0.f;
#pragma unroll
        for (int d = 0; d < 64; ++d) s += q[d] * bf2f(kr[d]);
        if (MODE == 0) s -= slope * fabsf((float)(tq - key));
        else { int rel = tq - key; rel = rel < -128 ? -128 : (rel > 128 ? 128 : rel); s += relb[h * 257 + rel + 128]; }
        if (s > mx) { const float f = expf(mx - s); l *= f;
#pragma unroll
            for (int e = 0; e < DVS; ++e) o[e] *= f;
            mx = s; }
        const float p = expf(s - mx); l += p;
        const bf16_t* vr = base + (size_t)key * IN_EVEN + vcol;
#pragma unroll
        for (int e = 0; e < DVS; ++e) o[e] += p * bf2f(vr[e]);
    }
    const float inv = 1.f / l; const size_t tok = (size_t)b * SEQ + tq;
#pragma unroll
    for (int e = 0; e < DVS; ++e) {
        if (MODE == 0) OT[((size_t)m * MTOK + tok) * 512 + h * 128 + es * DVS + e] = o[e] * inv;
        else MC[tok * DM + 512 + h * 64 + es * DVS + e] = f2bf(o[e] * inv);
    }
}
__global__ void __launch_bounds__(256) nv_diff_combine(const float* OT, const float* lq1, const float* lk1, const float* lq2, const float* lk2, const float* g, bf16_t* MC) {
    const int i = blockIdx.x * 256 + threadIdx.x; const int tok = i >> 2, h = i & 3;
    float s1 = 0.f, s2 = 0.f;
    for (int d = 0; d < 64; ++d) { s1 += lq1[d] * lk1[d]; s2 += lq2[d] * lk2[d]; }
    const float lam = expf(s1) - expf(s2) + 0.2f;
    const float* o1 = OT + (size_t)tok * 512 + h * 128; const float* o2 = o1 + (size_t)MTOK * 512;
    float ss = 0.f;
    for (int e = 0; e < 128; ++e) { const float d = o1[e] - lam * o2[e]; ss += d * d; }
    const float r = rsqrtf(ss * (1.f / 128.f) + LN_EPS) * 0.8f;
    for (int e = 0; e < 128; ++e) { const float d = o1[e] - lam * o2[e]; MC[(size_t)tok * DM + h * 128 + e] = f2bf(d * r * g[e]); }
}
__global__ void __launch_bounds__(128) nv_ret(const bf16_t* HP, float* OT) {
    const int b = blockIdx.x >> 2, h = blockIdx.x & 3, e = threadIdx.x;
    const float gamma = 1.f - exp2f(-5.f - (float)h);
    float S[64];
#pragma unroll
    for (int d = 0; d < 64; ++d) S[d] = 0.f;
    for (int t = 0; t < SEQ; ++t) {
        const bf16_t* row = HP + ((size_t)b * SEQ + t) * IN_ODD;
        const float v = bf2f(row[512 + h * 128 + e]); float o = 0.f;
#pragma unroll
        for (int d = 0; d < 64; ++d) { const float kd = bf2f(row[256 + h * 64 + d]) * 0.125f; S[d] = gamma * S[d] + kd * v; o += bf2f(row[h * 64 + d]) * S[d]; }
        OT[((size_t)b * SEQ + t) * 512 + h * 128 + e] = o;
    }
}
__global__ void __launch_bounds__(256) nv_gn_gate(const float* OT, const bf16_t* HP, const float* g, const float* bb, bf16_t* MC) {
    const int i = blockIdx.x * 256 + threadIdx.x; const int tok = i >> 2, h = i & 3;
    const float* o = OT + (size_t)tok * 512 + h * 128; float s = 0.f;
    for (int e = 0; e < 128; ++e) s += o[e];
    const float mu = s * (1.f / 128.f); float q = 0.f;
    for (int e = 0; e < 128; ++e) { const float d = o[e] - mu; q += d * d; }
    const float r = rsqrtf(q * (1.f / 128.f) + LN_EPS);
    for (int e = 0; e < 128; ++e) { const int c = h * 128 + e; const float y = (o[e] - mu) * r * g[c] + bb[c]; const float gt = bf2f(HP[(size_t)tok * IN_ODD + 1024 + c]);
        MC[(size_t)tok * DM + c] = f2bf(y * silu(gt)); }
}
__global__ void __launch_bounds__(256) nv_sgu_ln(const bf16_t* HP, const float* g, const float* bb, float* VN) {
    const int tok = blockIdx.x * 256 + threadIdx.x; const bf16_t* v = HP + (size_t)tok * IN_ODD + 2048; float s = 0.f;
    for (int c = 0; c < 512; ++c) s += bf2f(v[c]);
    const float mu = s * (1.f / 512.f); float q = 0.f;
    for (int c = 0; c < 512; ++c) { const float d = bf2f(v[c]) - mu; q += d * d; }
    const float r = rsqrtf(q * (1.f / 512.f) + LN_EPS);
    for (int c = 0; c < 512; ++c) VN[(size_t)tok * 512 + c] = (bf2f(v[c]) - mu) * r * g[c] + bb[c];
}
__global__ void __launch_bounds__(256) nv_sgu_mix(const float* VN, const bf16_t* HP, const float* W, const float* bs, bf16_t* MC) {
    const int chunk = blockIdx.x, g = blockIdx.y, c = threadIdx.x & 127, th = threadIdx.x >> 7;
    for (int t = th * 64; t < th * 64 + 64; ++t) {
        float acc = 0.f; const float* w = W + ((size_t)g * 128 + t) * 128;
        for (int s = 0; s <= t; ++s) acc += w[s] * VN[((size_t)chunk * 128 + s) * 512 + g * 128 + c];
        const size_t tok = (size_t)chunk * 128 + t; const float u = bf2f(HP[tok * IN_ODD + 1536 + g * 128 + c]);
        MC[tok * DM + 512 + g * 128 + c] = f2bf(u * (acc + bs[g * 128 + t]));
    }
}

namespace pg8 {
#define PG8_LAS __attribute__((address_space(3)))
typedef unsigned short bf16_t;
typedef short bf16x8 __attribute__((ext_vector_type(8)));
typedef float f32x4 __attribute__((ext_vector_type(4)));
typedef unsigned u32x4 __attribute__((ext_vector_type(4)));
constexpr int BM = 256, BK = 64, HALF = 128, HTB = HALF * BK * 2  , STAGE_BYTES = 8 * HTB, NXCD = 8, WGM = 8;

__host__ __device__ __forceinline__ int lds_byte(int r, int c) { const int st = (r >> 4) * 2 + (c >> 5), rr = r & 15, cc = c & 31, ob = rr * 64 + cc * 2; return st * 1024 + (ob ^ (((ob >> 9) & 1) << 5)); }
__host__ __device__ __forceinline__ void stage_rc(int b, int& R, int& C) { const int st = b / 1024, sb = b % 1024, swz = sb ^ (((sb >> 9) & 1) << 5); R = (st >> 1) * 16 + swz / 64; C = (st & 1) * 32 + (swz % 64) / 2; }
__host__ __device__ __forceinline__ int perm32(int rho) { const int n = rho >> 4, i = rho & 15; return 8 * (i >> 2) + 4 * n + (i & 3); }

struct Unit { int pm, pn; };
struct Gemm { const bf16_t* A; const bf16_t* Bt; int M, N, K; };

struct StaticOrder {
    int nM, nN, nwg, G, c;
    __host__ __device__ void init(int M, int N, int G_, int c_) { nM = M / BM; nN = N / BM; nwg = nM * nN; G = G_; c = c_; }
    __host__ __device__ bool next(int i, Unit& u) const {
        const long L = (long)i * G + c; if (L >= nwg) return false;
        int wgid = (int)L; { const int q = nwg / NXCD, r = nwg % NXCD, xcd = wgid % NXCD, off = wgid / NXCD; wgid = (xcd < r ? xcd * (q + 1) : r * (q + 1) + (xcd - r) * q) + off; }
        const int nig = WGM * nN, gid = wgid / nig, fm = gid * WGM, gsz = (nM - fm) < WGM ? (nM - fm) : WGM;
        u.pm = fm + ((wgid % nig) % gsz); u.pn = (wgid % nig) / gsz; return true;
    }
    __device__ __forceinline__ void a_ready(const Unit&) const {}
    __device__ __forceinline__ void done(const Unit&) const {}
};

__device__ __forceinline__ unsigned cvt_pk_bf16(float lo, float hi) { unsigned r; asm volatile("v_cvt_pk_bf16_f32 %0, %1, %2" : "=v"(r) : "v"(lo), "v"(hi)); return r; }
__device__ __forceinline__ float e_gelu(float x) { const float u = 0.7978845608028654f * (x + 0.044715f * x * x * x); return x * __builtin_amdgcn_rcpf(1.f + __builtin_amdgcn_exp2f(-2.885390081777927f * u)); }
__device__ __forceinline__ float e_silu(float x) { return x * __builtin_amdgcn_rcpf(1.f + __builtin_amdgcn_exp2f(-1.4426950408889634f * x)); }
struct EpiBf16G {
    static constexpr bool PERM = true, AFTER_DRAIN = false;
    bf16_t* O; int ldc; int gelu_from_tile;
    __device__ __forceinline__ void operator()(const f32x4 (&acc)[2][2][4][2], const Unit& u, int wr, int wc, int fr, int fq) const {
        const int row0 = u.pm * BM + wr * 64 + fr, col0 = u.pn * BM + wc * 32 + 8 * fq; const bool g = u.pn >= gelu_from_tile;
#pragma unroll
        for (int ai = 0; ai < 2; ++ai)
#pragma unroll
            for (int m = 0; m < 4; ++m) { bf16_t* rowp = O + (size_t)(row0 + ai * HALF + m * 16) * ldc + col0;
#pragma unroll
                for (int bj = 0; bj < 2; ++bj) { f32x4 v0 = acc[ai][bj][m][0], v1 = acc[ai][bj][m][1];
                    if (g) {
#pragma unroll
                        for (int i = 0; i < 4; ++i) { v0[i] = e_gelu(v0[i]); v1[i] = e_gelu(v1[i]); } }
                    u32x4 w; w.x = cvt_pk_bf16(v0[0], v0[1]); w.y = cvt_pk_bf16(v0[2], v0[3]); w.z = cvt_pk_bf16(v1[0], v1[1]); w.w = cvt_pk_bf16(v1[2], v1[3]);
                    *(u32x4*)(rowp + bj * HALF) = w; } }
    }
};
struct EpiSwiglu {
    static constexpr bool PERM = true, AFTER_DRAIN = false;
    bf16_t* O; int ldc;
    __device__ __forceinline__ void operator()(const f32x4 (&acc)[2][2][4][2], const Unit& u, int wr, int wc, int fr, int fq) const {
        const int row0 = u.pm * BM + wr * 64 + fr, col0 = u.pn * HALF + wc * 32 + 8 * fq;
#pragma unroll
        for (int ai = 0; ai < 2; ++ai)
#pragma unroll
            for (int m = 0; m < 4; ++m) { bf16_t* rowp = O + (size_t)(row0 + ai * HALF + m * 16) * ldc + col0;
                f32x4 h0, h1;
#pragma unroll
                for (int i = 0; i < 4; ++i) { h0[i] = e_silu(acc[ai][0][m][0][i]) * acc[ai][1][m][0][i]; h1[i] = e_silu(acc[ai][0][m][1][i]) * acc[ai][1][m][1][i]; }
                u32x4 w; w.x = cvt_pk_bf16(h0[0], h0[1]); w.y = cvt_pk_bf16(h0[2], h0[3]); w.z = cvt_pk_bf16(h1[0], h1[1]); w.w = cvt_pk_bf16(h1[2], h1[3]);
                *(u32x4*)rowp = w; }
    }
};
struct EpiResid {
    static constexpr bool PERM = false, AFTER_DRAIN = false;
    const float* R; float* Y; int ldc; float alpha;
    __device__ __forceinline__ void operator()(const f32x4 (&acc)[2][2][4][2], const Unit& u, int wr, int wc, int fr, int fq) const {
        const int row0 = u.pm * BM + wr * 64 + fr, col0 = u.pn * BM + wc * 32 + 4 * fq;
#pragma unroll
        for (int ai = 0; ai < 2; ++ai)
#pragma unroll
            for (int m = 0; m < 4; ++m) { const size_t off = (size_t)(row0 + ai * HALF + m * 16) * ldc + col0;
#pragma unroll
                for (int bj = 0; bj < 2; ++bj)
#pragma unroll
                    for (int n = 0; n < 2; ++n) { const f32x4 r = *(const f32x4*)(R + off + bj * HALF + n * 16); *(f32x4*)(Y + off + bj * HALF + n * 16) = r * alpha + acc[ai][bj][m][n]; }
                if (m & 1) asm volatile("" ::: "memory"); }
    }
};
template <class Epi, class Sched, bool ALIGN_EPI = false, bool SP2 = false>
__device__ __forceinline__ void gemm_phase(PG8_LAS unsigned char* lds, const Gemm g, const Sched& S, const Epi& E, const int tid) {
    const int wid = __builtin_amdgcn_readfirstlane(tid >> 6), lane = tid & 63, wr = wid >> 2, wc = wid & 3, fr = lane & 15, fq = lane >> 4;
    const int K = g.K, nt = K / BK;
    unsigned voffA[2], voffB[2];
#pragma unroll
    for (int i = 0; i < 2; ++i) { int R, C; stage_rc(tid * 16 + i * 8192, R, C); const int Rb = Epi::PERM ? ((R & ~31) + perm32(R & 31)) : R;
        voffA[i] = (unsigned)(R * K + C) * 2u; voffB[i] = (unsigned)(Rb * K + C) * 2u; }
    const size_t kstep = (size_t)(BK * 2);
    const size_t hstep = (size_t)HALF * K * 2;
    const size_t tstep = 2 * hstep;
    const unsigned ldsw = (unsigned)wid * 1024u;
    const int aoff = lds_byte(wr * 64 + fr, fq * 8), boff = lds_byte(wc * 32 + fr, fq * 8);
#define PG8_SA(b, h) (((b) * 2 + (h)) * HTB)
#define PG8_SB(b, h) ((4 + (b) * 2 + (h)) * HTB)
#define PG8_STAGE(bufoff, gbase, voff) do { _Pragma("unroll") for (int _i = 0; _i < 2; ++_i) \
        __builtin_amdgcn_global_load_lds((const unsigned*)((const char*)(gbase) + (voff)[_i]), (PG8_LAS unsigned*)(lds + (bufoff) + ldsw + _i * 8192), 16, 0, 0); } while (0)
#define PG8_LDA(dst, b, h) do { _Pragma("unroll") for (int m = 0; m < 4; ++m) _Pragma("unroll") for (int k = 0; k < 2; ++k) dst[m][k] = *(const PG8_LAS bf16x8*)(lds + PG8_SA(b, h) + aoff + m * 2048 + k * 1024); } while (0)
#define PG8_LDB(dst, b, h) do { _Pragma("unroll") for (int n = 0; n < 2; ++n) _Pragma("unroll") for (int k = 0; k < 2; ++k) dst[n][k] = *(const PG8_LAS bf16x8*)(lds + PG8_SB(b, h) + boff + n * 2048 + k * 1024); } while (0)
#define PG8_MMA(ai, bj, At, Bt) do { __builtin_amdgcn_s_setprio(1); _Pragma("unroll") for (int m = 0; m < 4; ++m) _Pragma("unroll") for (int n = 0; n < 2; ++n) _Pragma("unroll") for (int k = 0; k < 2; ++k) \
        acc[ai][bj][m][n] = __builtin_amdgcn_mfma_f32_16x16x32_bf16(Bt[n][k], At[m][k], acc[ai][bj][m][n], 0, 0, 0); __builtin_amdgcn_s_setprio(0); } while (0)
#define PG8_WAIT_V(n) asm volatile("s_waitcnt vmcnt(" #n ")" ::: "memory")
#define PG8_WAIT_L(n) asm volatile("s_waitcnt lgkmcnt(" #n ")" ::: "memory")
#define PG8_BAR __builtin_amdgcn_s_barrier()
#define PG8_SCHED __builtin_amdgcn_sched_barrier(0)
    Unit cur, nxt; int ui = 0;
    if (!S.next(0, cur)) return;
    f32x4 acc[2][2][4][2];
#pragma unroll
    for (int a = 0; a < 2; ++a)
#pragma unroll
        for (int b = 0; b < 2; ++b)
#pragma unroll
            for (int m = 0; m < 4; ++m)
#pragma unroll
                for (int n = 0; n < 2; ++n) acc[a][b][m][n] = (f32x4){0.f, 0.f, 0.f, 0.f};
    bf16x8 At[4][2], B0[2][2], B1[2][2];
    const char* cA = (const char*)g.A + (size_t)cur.pm * tstep; const char* cB = (const char*)g.Bt + (size_t)cur.pn * tstep;
    S.a_ready(cur);
    if constexpr (SP2) {
        PG8_STAGE(PG8_SB(0, 0), cB, voffB); PG8_STAGE(PG8_SB(0, 1), cB + hstep, voffB); PG8_STAGE(PG8_SA(0, 0), cA, voffA); PG8_STAGE(PG8_SA(0, 1), cA + hstep, voffA);
        if (wr == 1) PG8_BAR;
        PG8_WAIT_V(2); PG8_BAR;
        PG8_STAGE(PG8_SB(1, 0), cB + kstep, voffB); PG8_STAGE(PG8_SA(1, 0), cA + kstep, voffA); PG8_STAGE(PG8_SB(1, 1), cB + hstep + kstep, voffB);
        PG8_WAIT_V(6); PG8_BAR;
    } else {
        PG8_STAGE(PG8_SB(0, 0), cB, voffB); PG8_STAGE(PG8_SA(0, 0), cA, voffA); PG8_STAGE(PG8_SB(0, 1), cB + hstep, voffB); PG8_STAGE(PG8_SA(0, 1), cA + hstep, voffA);
        if (wr == 1) PG8_BAR;
        PG8_WAIT_V(4); PG8_BAR;
        PG8_STAGE(PG8_SB(1, 0), cB + kstep, voffB); PG8_STAGE(PG8_SA(1, 0), cA + kstep, voffA); PG8_STAGE(PG8_SB(1, 1), cB + hstep + kstep, voffB);
        PG8_WAIT_V(6); PG8_BAR;
    }
    for (;;) {
        const bool has_next = S.next(ui + 1, nxt);
        const char* nA = has_next ? (const char*)g.A + (size_t)nxt.pm * tstep : cA; const char* nB = has_next ? (const char*)g.Bt + (size_t)nxt.pn * tstep : cB;
        for (int t = 0; t < nt; t += 2) {
            const bool last = (t == nt - 2);
            const char* a1 = cA + (size_t)(t + 1) * kstep;
            const char* a2 = last ? nA : cA + (size_t)(t + 2) * kstep; const char* b2 = last ? nB : cB + (size_t)(t + 2) * kstep;
            const char* a3 = a2 + kstep; const char* b3 = b2 + kstep;
            if (last && has_next) S.a_ready(nxt);
            if constexpr (SP2) {
            PG8_LDB(B0, 0, 0); PG8_LDB(B1, 0, 1); PG8_SCHED; PG8_LDA(At, 0, 0); PG8_STAGE(PG8_SA(1, 1), a1 + hstep, voffA);
            PG8_WAIT_V(8); PG8_WAIT_L(0); PG8_BAR; PG8_MMA(0, 0, At, B0); PG8_MMA(0, 1, At, B1); PG8_BAR; PG8_SCHED;
            PG8_LDA(At, 0, 1); PG8_STAGE(PG8_SB(0, 0), b2, voffB); PG8_STAGE(PG8_SB(0, 1), b2 + hstep, voffB); PG8_STAGE(PG8_SA(0, 0), a2, voffA);
            PG8_WAIT_V(8); PG8_WAIT_L(0); PG8_BAR; PG8_MMA(1, 0, At, B0); PG8_MMA(1, 1, At, B1); PG8_BAR; PG8_SCHED;
            PG8_LDB(B0, 1, 0); PG8_LDB(B1, 1, 1); PG8_SCHED; PG8_LDA(At, 1, 0); PG8_STAGE(PG8_SA(0, 1), a2 + hstep, voffA);
            PG8_WAIT_V(8); PG8_WAIT_L(0); PG8_BAR; PG8_MMA(0, 0, At, B0); PG8_MMA(0, 1, At, B1); PG8_BAR; PG8_SCHED;
            PG8_LDA(At, 1, 1); PG8_STAGE(PG8_SB(1, 0), b3, voffB); PG8_STAGE(PG8_SB(1, 1), b3 + hstep, voffB); PG8_STAGE(PG8_SA(1, 0), a3, voffA);
            PG8_WAIT_V(8); PG8_WAIT_L(0); PG8_BAR; PG8_MMA(1, 0, At, B0); PG8_MMA(1, 1, At, B1); PG8_BAR; PG8_SCHED;
            } else {
            PG8_LDB(B0, 0, 0); PG8_SCHED; PG8_LDA(At, 0, 0); PG8_STAGE(PG8_SA(1, 1), a1 + hstep, voffA);
            PG8_WAIT_L(8); PG8_BAR; PG8_WAIT_L(0); PG8_MMA(0, 0, At, B0); PG8_BAR; PG8_SCHED;
            PG8_LDB(B1, 0, 1); PG8_STAGE(PG8_SB(0, 0), b2, voffB);
            PG8_BAR; PG8_WAIT_L(0); PG8_MMA(0, 1, At, B1); PG8_BAR;
            PG8_LDA(At, 0, 1); PG8_STAGE(PG8_SA(0, 0), a2, voffA);
            PG8_BAR; PG8_WAIT_L(0); PG8_MMA(1, 0, At, B0); PG8_BAR; PG8_SCHED;
            PG8_STAGE(PG8_SB(0, 1), b2 + hstep, voffB);
            PG8_WAIT_V(6); PG8_BAR; PG8_MMA(1, 1, At, B1); PG8_BAR;
            PG8_LDB(B0, 1, 0); PG8_SCHED; PG8_LDA(At, 1, 0); PG8_STAGE(PG8_SA(0, 1), a2 + hstep, voffA);
            PG8_WAIT_L(8); PG8_BAR; PG8_WAIT_L(0); PG8_MMA(0, 0, At, B0); PG8_BAR; PG8_SCHED;
            PG8_LDB(B1, 1, 1); PG8_STAGE(PG8_SB(1, 0), b3, voffB);
            PG8_BAR; PG8_WAIT_L(0); PG8_MMA(0, 1, At, B1); PG8_BAR;
            PG8_LDA(At, 1, 1); PG8_STAGE(PG8_SA(1, 0), a3, voffA);
            PG8_BAR; PG8_WAIT_L(0); PG8_MMA(1, 0, At, B0); PG8_BAR; PG8_SCHED;
            PG8_STAGE(PG8_SB(1, 1), b3 + hstep, voffB);
            PG8_WAIT_V(6); PG8_BAR; PG8_MMA(1, 1, At, B1); PG8_BAR;
            }
        }
        if constexpr (ALIGN_EPI) { if (wr == 0) PG8_BAR; }
        if constexpr (!Epi::AFTER_DRAIN) { E(acc, cur, wr, wc, fr, fq); S.done(cur); }
        if (!has_next) break;
#pragma unroll
        for (int a = 0; a < 2; ++a)
#pragma unroll
            for (int b = 0; b < 2; ++b)
#pragma unroll
                for (int m = 0; m < 4; ++m)
#pragma unroll
                    for (int n = 0; n < 2; ++n) acc[a][b][m][n] = (f32x4){0.f, 0.f, 0.f, 0.f};
        cur = nxt; cA = nA; cB = nB; ++ui;
        if constexpr (ALIGN_EPI) { if (wr == 1) PG8_BAR; }
    }
    PG8_WAIT_V(0);
    if constexpr (!ALIGN_EPI) { if (wr == 0) PG8_BAR; }
    PG8_BAR;
    if constexpr (Epi::AFTER_DRAIN) { E.fused(acc, cur, wr, wc, fr, fq, lds, wid, lane); S.done(cur); }
#undef PG8_SA
#undef PG8_SB
#undef PG8_STAGE
#undef PG8_LDA
#undef PG8_LDB
#undef PG8_MMA
#undef PG8_WAIT_V
#undef PG8_WAIT_L
#undef PG8_BAR
#undef PG8_SCHED
}
}
#define LAS __attribute__((address_space(3)))
typedef float f32x4 __attribute__((ext_vector_type(4)));
typedef unsigned u32x4 __attribute__((ext_vector_type(4)));
typedef unsigned u32x2 __attribute__((ext_vector_type(2)));
constexpr int NWAVES = 8, NTHR = 512;
constexpr int LDS_BYTES = 147456;
constexpr int NPHASE = 17;
#ifndef PROBE_DUP
#define PROBE_DUP 0u
#endif
#define ATT_PROBE 0
#define ATT_TIMING 0

struct Args { const float* in[24]; float* out; unsigned char* ws; int ph_lo, ph_hi; };
typedef const __attribute__((address_space(4))) unsigned char* kptr_t;
DEV const float* kin(kptr_t kp, int k) { return *(const float* const __attribute__((address_space(4)))*)(kp + 8 * k); }
DEV float* kout(kptr_t kp) { return *(float* const __attribute__((address_space(4)))*)(kp + 192); }
DEV unsigned char* kws(kptr_t kp) { return *(unsigned char* const __attribute__((address_space(4)))*)(kp + 200); }
static_assert(sizeof(Args) == 216, "Args layout");

DEV float wave_sum(float v) {
#pragma unroll
    for (int o = 1; o < 64; o <<= 1) v += __shfl_xor(v, o);
    return v;
}
DEV unsigned pk2(float lo, float hi) { return pg8::cvt_pk_bf16(lo, hi); }

DEV void p0_transpose_item(const float* W, int K, int N, bf16_t* WT, int mode, LAS float* scr, int item, int lane) {
    const int nblk = N / 32, kb = item / nblk, nb = item % nblk, k0 = 64 * kb, n0 = 32 * nb;
#pragma unroll 8
    for (int i = 0; i < 32; ++i) { const int kk = 2 * i + (lane >> 5); scr[kk * 33 + (lane & 31)] = W[(size_t)(k0 + kk) * N + n0 + (lane & 31)]; }
    asm volatile("s_waitcnt lgkmcnt(0)" ::: "memory");
    const int c = lane & 7;
#pragma unroll
    for (int j = 0; j < 4; ++j) { const int nl = (lane >> 3) + 8 * j, n = n0 + nl; const LAS float* s = scr + (8 * c) * 33 + nl;
        const int r = mode == 0 ? n : (256 * (n >> 7) + (n & 127) + (mode == 2 ? 128 : 0));
        u32x4 o; o.x = pk2(s[0 * 33], s[1 * 33]); o.y = pk2(s[2 * 33], s[3 * 33]); o.z = pk2(s[4 * 33], s[5 * 33]); o.w = pk2(s[6 * 33], s[7 * 33]);
        *(u32x4*)(WT + (size_t)r * K + k0 + 8 * c) = o; }
    asm volatile("s_waitcnt lgkmcnt(0)" ::: "memory");
}
DEV void p0_prologue(kptr_t kp, LAS unsigned char* lds, int gw, int NGW, int wave, int lane) {
    LAS float* scr = (LAS float*)(lds + wave * 16384);
    unsigned char* ws = kws(kp);
    constexpr int I_INE = (DM / 64) * (IN_EVEN / 32), I_SQ = (DM / 64) * (DM / 32), I_INO = (DM / 64) * (IN_ODD / 32), I_GU = (DM / 64) * (DFF / 32), I_DN = (DFF / 64) * (DM / 32);
    constexpr int NITEMS = I_INE + 2 * I_SQ + I_INO + 4 * I_GU + 2 * I_DN;
    for (int it = gw; it < NITEMS; it += NGW) {
        int r = it; const float* W; int K, N, mode = 0; bf16_t* dst;
        if (r < I_INE) { W = kin(kp, 1); K = DM; N = IN_EVEN; dst = (bf16_t*)(ws + WS_WINE); }
        else if ((r -= I_INE) < I_SQ) { W = kin(kp, 8); K = DM; N = DM; dst = (bf16_t*)(ws + WS_WOUTE); }
        else if ((r -= I_SQ) < I_INO) { W = kin(kp, 9); K = DM; N = IN_ODD; dst = (bf16_t*)(ws + WS_WINO); }
        else if ((r -= I_INO) < I_SQ) { W = kin(kp, 16); K = DM; N = DM; dst = (bf16_t*)(ws + WS_WOUTO); }
        else if ((r -= I_SQ) < I_GU) { W = kin(kp, 19); K = DM; N = DFF; mode = 1; dst = (bf16_t*)(ws + WS_WGU0); }
        else if ((r -= I_GU) < I_GU) { W = kin(kp, 20); K = DM; N = DFF; mode = 2; dst = (bf16_t*)(ws + WS_WGU0); }
        else if ((r -= I_GU) < I_GU) { W = kin(kp, 19) + (size_t)DM * DFF; K = DM; N = DFF; mode = 1; dst = (bf16_t*)(ws + WS_WGU1); }
        else if ((r -= I_GU) < I_GU) { W = kin(kp, 20) + (size_t)DM * DFF; K = DM; N = DFF; mode = 2; dst = (bf16_t*)(ws + WS_WGU1); }
        else if ((r -= I_GU) < I_DN) { W = kin(kp, 21); K = DFF; N = DM; dst = (bf16_t*)(ws + WS_WDN0); }
        else { r -= I_DN; W = kin(kp, 21) + (size_t)DM * DFF; K = DFF; N = DM; dst = (bf16_t*)(ws + WS_WDN1); }
        p0_transpose_item(W, K, N, dst, mode, scr, r, lane);
    }
    { bf16_t* wsb = (bf16_t*)(ws + WS_SGUW);
      for (int i = gw * 64 + lane; i < 4 * 128 * 128; i += NGW * 64) { const int t = (i >> 7) & 127, sx = i & 127; wsb[i] = sx <= t ? f2bf(kin(kp, 14)[i]) : (bf16_t)0; } }
    const f32x4* x4 = (const f32x4*)kin(kp, 0); u32x2* o2 = (u32x2*)(ws + WS_XB);
    for (size_t i = (size_t)gw * 64 + lane; i < (size_t)MTOK * DM / 4; i += (size_t)NGW * 64) { const f32x4 v = x4[i]; u32x2 w; w.x = pk2(v.x, v.y); w.y = pk2(v.z, v.w); o2[i] = w; }
}
DEV void ln_phase(const float* Y, const float* g, const float* b, float* XF, bf16_t* XB, int gw, int NGW, int lane) {
    f32x4 gv[4], bv[4];
#pragma unroll
    for (int j = 0; j < 4; ++j) { gv[j] = ((const f32x4*)g)[lane + 64 * j]; bv[j] = ((const f32x4*)b)[lane + 64 * j]; }
    for (int m = gw; m < MTOK; m += NGW) {
        const f32x4* xr = (const f32x4*)(Y + (size_t)m * DM) + lane;
        f32x4 v[4]; float s = 0.f;
#pragma unroll
        for (int j = 0; j < 4; ++j) { v[j] = xr[64 * j]; s += (v[j].x + v[j].y) + (v[j].z + v[j].w); }
        const float mean = wave_sum(s) * (1.f / DM); float s2 = 0.f;
#pragma unroll
        for (int j = 0; j < 4; ++j) { v[j] = v[j] - mean; s2 += (v[j].x * v[j].x + v[j].y * v[j].y) + (v[j].z * v[j].z + v[j].w * v[j].w); }
        const float rstd = rsqrtf(wave_sum(s2) * (1.f / DM) + LN_EPS);
        f32x4* of = (f32x4*)(XF + (size_t)m * DM) + lane; u32x2* ob = (u32x2*)(XB + (size_t)m * DM) + lane;
#pragma unroll
        for (int j = 0; j < 4; ++j) { const f32x4 o = v[j] * rstd * gv[j] + bv[j]; of[64 * j] = o; u32x2 w; w.x = pk2(o.x, o.y); w.y = pk2(o.z, o.w); ob[64 * j] = w; }
    }
}

namespace att {
typedef short bf16x8 __attribute__((ext_vector_type(8)));
typedef short s16x4 __attribute__((ext_vector_type(4)));
typedef float f32x16 __attribute__((ext_vector_type(16)));
constexpr int KT_BYTES = 16384, SLOT = 32768, NSLOT = 4;
constexpr int LDS_WSF = NSLOT * SLOT;
constexpr int LDS_TAB = LDS_WSF + 8 * 256;
constexpr int LDS_PM = LDS_TAB + 2064;
constexpr int LDS_FLAG = LDS_PM + 1024;
static_assert(LDS_FLAG + 128 <= LDS_BYTES - 64, "attention LDS map");
DEV void glds16(const void* gsrc, unsigned lds_dst) { unsigned keep;
    asm volatile("s_mov_b32 %0, m0\n\ts_mov_b32 m0, %2\n\ts_nop 0\n\tglobal_load_lds_dwordx4 %1, off\n\ts_mov_b32 m0, %0" : "=&s"(keep) : "v"(gsrc), "s"(lds_dst) : "memory"); }
#define ATT_WAITBAR(N) asm volatile("s_waitcnt vmcnt(" #N ") lgkmcnt(0)\n\ts_barrier" ::: "memory")
constexpr int XROW = 132;
constexpr float LOG2E = 1.4426950408889634f, C1 = 0.125f * LOG2E;
constexpr float SKIP_T = 40.f;
DEV int crow(int reg, int hh) { return (reg & 3) + 8 * (reg >> 2) + 4 * hh; }
DEV float max3f(float a, float b, float c) { float r; asm("v_max3_f32 %0, %1, %2, %3" : "=v"(r) : "v"(a), "v"(b), "v"(c)); return r; }
DEV s16x4 vtr(const LAS unsigned char* p) { typedef short v4i16_t __attribute__((ext_vector_type(4))); return __builtin_bit_cast(s16x4, __builtin_amdgcn_ds_read_tr16_b64_v4i16((LAS v4i16_t*)p)); }
#define ATT_SB() __builtin_amdgcn_sched_barrier(0)

DEV void knorm_phase(const bf16_t* __restrict__ HP, float* __restrict__ KN2, int gw, int NGW, int lane) {
    for (int t = gw; t < BATCH * 128; t += NGW) {
        float mx = 0.f;
        for (int st = 0; st < 8; ++st) { const u32x4* p = (const u32x4*)(HP + ((size_t)t * 64 + st * 8 + (lane >> 3)) * IN_EVEN + 512 + (lane & 7) * 64); float ss = 0.f;
#pragma unroll
            for (int j = 0; j < 8; ++j) { const u32x4 v = p[j]; const unsigned w[4] = {v.x, v.y, v.z, v.w};
#pragma unroll
                for (int q = 0; q < 4; ++q) { const float a = __uint_as_float(w[q] << 16), c = __uint_as_float(w[q] & 0xffff0000u); ss += a * a + c * c; } }
            mx = __builtin_fmaxf(mx, ss); }
        mx = __builtin_fmaxf(mx, __shfl_xor(mx, 8)); mx = __builtin_fmaxf(mx, __shfl_xor(mx, 16)); mx = __builtin_fmaxf(mx, __shfl_xor(mx, 32));
        if (lane < 8) KN2[(size_t)t * 8 + lane] = mx;
    }
}

template <int MODE> DEV void attn_unit(LAS unsigned char* lds, const bf16_t* __restrict__ HP, bf16_t* __restrict__ MC, int b, int hx, int qb, float lam, const float* __restrict__ subg, const float* __restrict__ relb, const float* __restrict__ KN2, int tid) {
    const int lane = tid & 63, wave = __builtin_amdgcn_readfirstlane(tid >> 6), g = wave >> 2, wq = wave & 3, r = lane & 31, hh = lane >> 5;
    constexpr int QOFF = MODE == 0 ? 0 : 1536, KOFF = MODE == 0 ? 512 : 2048, VOFF = MODE == 0 ? 1024 : 2560, NEB = MODE == 0 ? 4 : 2;
    const size_t row0 = (size_t)b * SEQ; const int q0 = qb * 128;
    const int cw = 2 * qb + (wq >> 1);
    const int kt_lo = MODE == 0 ? 0 : (2 * qb - 8 > 0 ? 2 * qb - 8 : 0), kt_hi = 2 * qb + 1;
    LAS float* wsf = (LAS float*)(lds + LDS_WSF) + wave * 64;
    LAS float* tab = (LAS float*)(lds + LDS_TAB);
    LAS float* PM = (LAS float*)(lds + LDS_PM);
    volatile LAS unsigned* flag = (volatile LAS unsigned*)(lds + LDS_FLAG);
    if (MODE == 1) { for (int i = tid; i < 514; i += NTHR) tab[i] = relb[(2 * hx + (i >= 257 ? 1 : 0)) * 257 + (i >= 257 ? i - 257 : i)] * LOG2E; }
    if (MODE == 0 && wq == 0) {
        float v0 = __builtin_sqrtf(KN2[((size_t)b * 128 + lane) * 8 + hx * 2 + g]), v1 = __builtin_sqrtf(KN2[((size_t)b * 128 + 64 + lane) * 8 + hx * 2 + g]);
#pragma unroll
        for (int o = 1; o < 64; o <<= 1) { const float t0 = __shfl_up(v0, o), t1 = __shfl_up(v1, o); if (lane >= o) { v0 = __builtin_fmaxf(v0, t0); v1 = __builtin_fmaxf(v1, t1); } }
        v1 = __builtin_fmaxf(v1, __shfl(v0, 63));
        PM[g * 128 + lane] = v0; PM[g * 128 + 64 + lane] = v1;
    }
    bf16x8 qf[4]; float qn = 0.f;
    { const bf16_t* qp = HP + (row0 + q0 + 32 * wq + r) * IN_EVEN + QOFF + hx * 128 + g * 64 + hh * 8; float ss = 0.f;
#pragma unroll
      for (int ds = 0; ds < 4; ++ds) { const u32x4 w4 = *(const u32x4*)(qp + 16 * ds); const unsigned w[4] = {w4.x, w4.y, w4.z, w4.w}; unsigned o4[4];
#pragma unroll
          for (int q = 0; q < 4; ++q) { o4[q] = pk2(__uint_as_float(w[q] << 16) * C1, __uint_as_float(w[q] & 0xffff0000u) * C1);
              const float a = __uint_as_float(o4[q] << 16), c = __uint_as_float(o4[q] & 0xffff0000u); ss += a * a + c * c; }
          qf[ds] = __builtin_bit_cast(bf16x8, (u32x4){o4[0], o4[1], o4[2], o4[3]}); }
      ss += __shfl_xor(ss, 32); qn = __builtin_sqrtf(ss) * 1.001f; }
    f32x16 o[NEB];
#pragma unroll
    for (int eb = 0; eb < NEB; ++eb)
#pragma unroll
        for (int i = 0; i < 16; ++i) o[eb][i] = 0.f;
    float mhat = 0.f, mtrue = -1e30f, l = 0.f, fpend = 1.f; bool pend = false, have = false; int vlast = 0, plast = 0;
    const int tq = q0 + 32 * wq + r;
    const float sl2 = exp2f(-2.0f * (float)(hx + 1)) * LOG2E;
    const unsigned lds0 = (unsigned)(unsigned long long)lds;
    const bf16_t* ksrc[2]; const bf16_t* vsrc[2];
#pragma unroll
    for (int j = 0; j < 2; ++j) { const int srow = 8 * wave + 4 * j + (lane >> 4), pc = lane & 15;
        ksrc[j] = HP + (row0 + srow) * IN_EVEN + KOFF + hx * 128 + (pc ^ (srow & 15)) * 8;
        vsrc[j] = HP + (row0 + srow) * IN_EVEN + VOFF + hx * 128 + (pc ^ ((srow & 3) << 2)) * 8; }
    const unsigned dst0 = (unsigned)__builtin_amdgcn_readfirstlane((int)(lds0 + wave * 2048));
#define ATT_ISSUE(ktr, slot) do { const int ktc_ = (ktr) > kt_lo ? (ktr) : kt_lo; const size_t to_ = (size_t)(64 * ktc_) * IN_EVEN; const unsigned sd_ = dst0 + (unsigned)(slot) * SLOT; \
        glds16(ksrc[0] + to_, sd_); glds16(ksrc[1] + to_, sd_ + 1024); glds16(vsrc[0] + to_, sd_ + KT_BYTES); glds16(vsrc[1] + to_, sd_ + KT_BYTES + 1024); } while (0)
    ATT_ISSUE(kt_hi, 0); ATT_ISSUE(kt_hi - 1, 1);
    const int p15 = lane & 15, g4 = lane >> 4;
    int kaddr[4], vaddr[NEB];
#pragma unroll
    for (int ds = 0; ds < 4; ++ds) kaddr[ds] = r * 256 + (((g * 8 + ds * 2 + hh) ^ (r & 15)) << 4);
#pragma unroll
    for (int eb = 0; eb < NEB; ++eb) vaddr[eb] = KT_BYTES + (4 * hh + (p15 >> 2)) * 256 + ((((MODE == 1 ? 8 * g : 0) + 4 * eb + 2 * (g4 & 1) + ((p15 & 3) >> 1)) ^ ((p15 >> 2) << 2)) << 4) + 8 * (p15 & 1);
    ATT_WAITBAR(4);
    u32x4 paA[4], paB[4];
#pragma unroll
    for (int n = 0; n < 4; ++n) { paA[n] = (u32x4){0u, 0u, 0u, 0u}; paB[n] = paA[n]; }
    int it = 0, kt = kt_hi; bool fin = false;
#define ATT_LOADV(dst, VB, u) do { _Pragma("unroll") for (int e_ = 0; e_ < 2; ++e_) { const LAS unsigned char* vp_ = (VB) + vaddr[2 * ((u) % (NEB / 2)) + e_] + 4096 * ((u) / (NEB / 2)); \
        const s16x4 lo_ = vtr(vp_), hi_ = vtr(vp_ + 2048); dst[e_] = (bf16x8){lo_[0], lo_[1], lo_[2], lo_[3], hi_[0], hi_[1], hi_[2], hi_[3]}; } } while (0)
#define ATT_MMA(PP, vf, u) do { _Pragma("unroll") for (int e_ = 0; e_ < 2; ++e_) { const int eb_ = 2 * ((u) % (NEB / 2)) + e_; o[eb_] = __builtin_amdgcn_mfma_f32_32x32x16_bf16(__builtin_bit_cast(bf16x8, PP[(u) / (NEB / 2)]), vf[e_], o[eb_], 0, 0, 0); } } while (0)
#define ATT_CHUNK(POUT, c) do { constexpr int j_ = (c) & 7; float x0_, x1_; if ((c) < 8) { x0_ = s0[2 * j_]; x1_ = s0[2 * j_ + 1]; } else { x0_ = s1[2 * j_]; x1_ = s1[2 * j_ + 1]; } \
        rm = max3f(rm, x0_, x1_); const float p0_ = __builtin_amdgcn_exp2f(x0_), p1_ = __builtin_amdgcn_exp2f(x1_); ls += p0_ + p1_; POUT[(c) >> 2][(c) & 3] = pk2(p0_, p1_); } while (0)
#define ATT_ITER(PIN, POUT, PSEL) do { \
        ATT_ISSUE(kt - 2, (it + 2) & 3);                  \
        const bool active = MODE == 0 ? (kt <= cw) : (kt <= cw && kt >= cw - 8); \
        if (active) { \
            const LAS unsigned char* Kb = lds + (it & 3) * SLOT; const LAS unsigned char* Vp = lds + vlast * SLOT; \
            f32x16 s0, s1; const int dbase = tq - (64 * kt + 4 * hh); \
            if (MODE == 0) { const float bl = -sl2 * (float)dbase - mhat, bl1 = bl + 32.f * sl2;        \
                _Pragma("unroll") for (int i = 0; i < 16; ++i) { const float of = (float)((i & 3) + 8 * (i >> 2)); s0[i] = __builtin_fmaf(of, sl2, bl); s1[i] = __builtin_fmaf(of, sl2, bl1); } \
                if (kt == cw) { const float df = (float)dbase, s2 = 2.f * sl2;                            \
                    _Pragma("unroll") for (int i = 0; i < 16; ++i) { const float of = (float)((i & 3) + 8 * (i >> 2)); s0[i] = __builtin_fmaf(__builtin_fminf(df - of, 0.f), s2, s0[i]); s1[i] = __builtin_fmaf(__builtin_fminf(df - of - 32.f, 0.f), s2, s1[i]); } } \
            } else { \
                if (kt <= cw - 3) { const float tf = tab[g * 257 + 256] - mhat; _Pragma("unroll") for (int i = 0; i < 16; ++i) { s0[i] = tf; s1[i] = tf; } } \
                else { _Pragma("unroll") for (int i = 0; i < 16; ++i) { const int off = (i & 3) + 8 * (i >> 2); int r0 = dbase - off, r1 = r0 - 32; \
                        r0 = r0 < -128 ? -128 : (r0 > 128 ? 128 : r0); r1 = r1 < -128 ? -128 : (r1 > 128 ? 128 : r1); s0[i] = tab[g * 257 + 128 + r0] - mhat; s1[i] = tab[g * 257 + 128 + r1] - mhat; } } \
            } \
            { bf16x8 ka0, ka1, kb0, kb1;                   \
              ATT_SB(); ka0 = *(const LAS bf16x8*)(Kb + kaddr[0]); ka1 = *(const LAS bf16x8*)(Kb + kaddr[0] + 8192); kb0 = *(const LAS bf16x8*)(Kb + kaddr[1]); kb1 = *(const LAS bf16x8*)(Kb + kaddr[1] + 8192); ATT_SB(); \
              s0 = __builtin_amdgcn_mfma_f32_32x32x16_bf16(ka0, qf[0], s0, 0, 0, 0); s1 = __builtin_amdgcn_mfma_f32_32x32x16_bf16(ka1, qf[0], s1, 0, 0, 0); ATT_SB(); \
              ka0 = *(const LAS bf16x8*)(Kb + kaddr[2]); ka1 = *(const LAS bf16x8*)(Kb + kaddr[2] + 8192); ATT_SB(); \
              s0 = __builtin_amdgcn_mfma_f32_32x32x16_bf16(kb0, qf[1], s0, 0, 0, 0); s1 = __builtin_amdgcn_mfma_f32_32x32x16_bf16(kb1, qf[1], s1, 0, 0, 0); ATT_SB(); \
              kb0 = *(const LAS bf16x8*)(Kb + kaddr[3]); kb1 = *(const LAS bf16x8*)(Kb + kaddr[3] + 8192); ATT_SB(); \
              s0 = __builtin_amdgcn_mfma_f32_32x32x16_bf16(ka0, qf[2], s0, 0, 0, 0); s1 = __builtin_amdgcn_mfma_f32_32x32x16_bf16(ka1, qf[2], s1, 0, 0, 0); ATT_SB(); \
              s0 = __builtin_amdgcn_mfma_f32_32x32x16_bf16(kb0, qf[3], s0, 0, 0, 0); s1 = __builtin_amdgcn_mfma_f32_32x32x16_bf16(kb1, qf[3], s1, 0, 0, 0); ATT_SB(); } \
            float rm = -1e30f, ls = 0.f; \
            { bf16x8 vfa[2], vfb[2];                     \
                ATT_SB(); ATT_LOADV(vfa, Vp, 0); ATT_LOADV(vfb, Vp, 1); ATT_SB(); \
                if constexpr (NEB == 4) { \
                    ATT_MMA(PIN, vfa, 0); ATT_SB(); ATT_CHUNK(POUT, 0); ATT_CHUNK(POUT, 1); ATT_SB(); ATT_LOADV(vfa, Vp, 2); ATT_SB(); ATT_MMA(PIN, vfb, 1); ATT_SB(); ATT_CHUNK(POUT, 2); ATT_CHUNK(POUT, 3); ATT_SB(); ATT_LOADV(vfb, Vp, 3); ATT_SB(); \
                    ATT_MMA(PIN, vfa, 2); ATT_SB(); ATT_CHUNK(POUT, 4); ATT_CHUNK(POUT, 5); ATT_SB(); ATT_LOADV(vfa, Vp, 4); ATT_SB(); ATT_MMA(PIN, vfb, 3); ATT_SB(); ATT_CHUNK(POUT, 6); ATT_CHUNK(POUT, 7); ATT_SB(); ATT_LOADV(vfb, Vp, 5); ATT_SB(); \
                    ATT_MMA(PIN, vfa, 4); ATT_SB(); ATT_CHUNK(POUT, 8); ATT_CHUNK(POUT, 9); ATT_SB(); ATT_LOADV(vfa, Vp, 6); ATT_SB(); ATT_MMA(PIN, vfb, 5); ATT_SB(); ATT_CHUNK(POUT, 10); ATT_CHUNK(POUT, 11); ATT_SB(); ATT_LOADV(vfb, Vp, 7); ATT_SB(); \
                    ATT_MMA(PIN, vfa, 6); ATT_SB(); ATT_CHUNK(POUT, 12); ATT_CHUNK(POUT, 13); ATT_SB(); ATT_MMA(PIN, vfb, 7); ATT_SB(); ATT_CHUNK(POUT, 14); ATT_CHUNK(POUT, 15); ATT_SB(); \
                } else { \
                    ATT_MMA(PIN, vfa, 0); ATT_SB(); ATT_CHUNK(POUT, 0); ATT_CHUNK(POUT, 1); ATT_CHUNK(POUT, 2); ATT_CHUNK(POUT, 3); ATT_SB(); ATT_LOADV(vfa, Vp, 2); ATT_SB(); ATT_MMA(PIN, vfb, 1); ATT_SB(); ATT_CHUNK(POUT, 4); ATT_CHUNK(POUT, 5); ATT_CHUNK(POUT, 6); ATT_CHUNK(POUT, 7); ATT_SB(); ATT_LOADV(vfb, Vp, 3); ATT_SB(); \
                    ATT_MMA(PIN, vfa, 2); ATT_SB(); ATT_CHUNK(POUT, 8); ATT_CHUNK(POUT, 9); ATT_CHUNK(POUT, 10); ATT_CHUNK(POUT, 11); ATT_SB(); ATT_MMA(PIN, vfb, 3); ATT_SB(); ATT_CHUNK(POUT, 12); ATT_CHUNK(POUT, 13); ATT_CHUNK(POUT, 14); ATT_CHUNK(POUT, 15); ATT_SB(); \
                } \
            } \
            have = true; vlast = it & 3; plast = PSEL; \
            rm = __builtin_fmaxf(rm, __shfl_xor(rm, 32)); mtrue = __builtin_fmaxf(mtrue, mhat + rm); l += ls; \
            if (pend) {                                    \
                if (hh == 0) wsf[r] = fpend; \
                _Pragma("unroll") for (int i = 0; i < 16; ++i) { const float fr = wsf[crow(i, hh)]; _Pragma("unroll") for (int eb = 0; eb < NEB; ++eb) o[eb][i] *= fr; } } \
            pend = __any(rm > 8.f);                       \
            if (pend) { const float dl = __builtin_fmaxf(rm, 0.f); fpend = __builtin_amdgcn_exp2f(-dl); mhat += dl; l *= fpend; } \
        } \
        if (MODE == 0) {                                   \
            bool dn = true; \
            if (kt > 0) { const float ub = qn * PM[g * 128 + kt - 1] - sl2 * (float)(tq - (64 * kt - 1)); dn = ub < mtrue - SKIP_T; } \
            const bool wd = __all(dn); \
            if (lane == 0) flag[(it & 1) * 8 + wave] = wd ? 1u : 0u; } \
        if (ATT_TIMING) { const unsigned long long t1_ = __builtin_amdgcn_s_memtime(); if (tid == 0 && blockIdx.x == 0) tmisc[0] += (unsigned)(t1_ - tstamp); tstamp = t1_; } \
        ATT_WAITBAR(4);                                    \
        if (ATT_TIMING) { const unsigned long long t2_ = __builtin_amdgcn_s_memtime(); if (tid == 0 && blockIdx.x == 0) tmisc[1] += (unsigned)(t2_ - tstamp); tstamp = t2_; } \
        fin = (kt == kt_lo); \
        if (MODE == 0) { const u32x4 f0_ = *(const LAS u32x4*)(lds + LDS_FLAG + (it & 1) * 32), f1_ = *(const LAS u32x4*)(lds + LDS_FLAG + (it & 1) * 32 + 16); \
            fin = fin || (((f0_.x & f0_.y) & (f0_.z & f0_.w)) & ((f1_.x & f1_.y) & (f1_.z & f1_.w))) != 0u; } \
        --kt; ++it; } while (0)
    volatile LAS unsigned* tmisc = (volatile LAS unsigned*)(lds + LDS_BYTES - 64); unsigned long long tstamp = 0;
    if (ATT_TIMING) { tstamp = __builtin_amdgcn_s_memtime(); if (tid == 0 && blockIdx.x == 0) tmisc[2] += (unsigned)(tstamp - *(volatile LAS unsigned long long*)(lds + LDS_BYTES - 64 + 16)); }
    for (;;) { ATT_ITER(paA, paB, 1); if (fin) break; ATT_ITER(paB, paA, 0); if (fin) break; }
    if (ATT_TIMING) { if (tid == 0 && blockIdx.x == 0) *(volatile LAS unsigned long long*)(lds + LDS_BYTES - 64 + 16) = tstamp; }
#undef ATT_ITER
#undef ATT_CHUNK
#undef ATT_ISSUE
    ATT_WAITBAR(0);
    if (have) { const LAS unsigned char* Vp = lds + vlast * SLOT; bf16x8 vf[2];
        if (plast == 1) {
#pragma unroll
            for (int u = 0; u < 2 * NEB; ++u) { ATT_LOADV(vf, Vp, u); ATT_MMA(paB, vf, u); } }
        else {
#pragma unroll
            for (int u = 0; u < 2 * NEB; ++u) { ATT_LOADV(vf, Vp, u); ATT_MMA(paA, vf, u); } }
        if (pend) { if (hh == 0) wsf[r] = fpend;
#pragma unroll
            for (int i = 0; i < 16; ++i) { const float fr = wsf[crow(i, hh)];
#pragma unroll
                for (int eb = 0; eb < NEB; ++eb) o[eb][i] *= fr; } } }
#undef ATT_MMA
#undef ATT_LOADV
    l += __shfl_xor(l, 32);
    if (hh == 0) wsf[r] = 1.0f / l;
#pragma unroll
    for (int i = 0; i < 16; ++i) { const float fr = wsf[crow(i, hh)];
#pragma unroll
        for (int eb = 0; eb < NEB; ++eb) o[eb][i] *= fr; }
    __syncthreads();
    LAS float* X = (LAS float*)lds;
    const int xr = 32 * wq, rrow = xr + (lane >> 1), half = lane & 1;
    const size_t tok = row0 + q0 + rrow;
    if (MODE == 0) {
        if (g == 1) {
#pragma unroll
            for (int eb = 0; eb < NEB; ++eb)
#pragma unroll
                for (int i = 0; i < 16; ++i) X[(xr + crow(i, hh)) * XROW + 32 * eb + r] = o[eb][i];
        }
        __syncthreads();
        if (g == 0) {
#pragma unroll
            for (int eb = 0; eb < NEB; ++eb)
#pragma unroll
                for (int i = 0; i < 16; ++i) { const int ix = (xr + crow(i, hh)) * XROW + 32 * eb + r; X[ix] = o[eb][i] - lam * X[ix]; }
            f32x4 v[16]; float ss = 0.f;
#pragma unroll
            for (int j = 0; j < 16; ++j) { v[j] = *(const LAS f32x4*)(X + rrow * XROW + 64 * half + 4 * j); ss += (v[j].x * v[j].x + v[j].y * v[j].y) + (v[j].z * v[j].z + v[j].w * v[j].w); }
            ss += __shfl_xor(ss, 1);
            const float rs = rsqrtf(ss * (1.f / 128.f) + LN_EPS) * 0.8f;
            bf16_t* op = MC + tok * DM + hx * 128 + 64 * half;
#pragma unroll
            for (int j = 0; j < 8; ++j) { const f32x4 g0 = *(const f32x4*)(subg + 64 * half + 8 * j), g1 = *(const f32x4*)(subg + 64 * half + 8 * j + 4); const f32x4 a0 = v[2 * j] * rs * g0, a1 = v[2 * j + 1] * rs * g1;
                u32x4 w; w.x = pk2(a0.x, a0.y); w.y = pk2(a0.z, a0.w); w.z = pk2(a1.x, a1.y); w.w = pk2(a1.z, a1.w); *(u32x4*)(op + 8 * j) = w; }
        }
    } else {
#pragma unroll
        for (int eb = 0; eb < NEB; ++eb)
#pragma unroll
            for (int i = 0; i < 16; ++i) X[(xr + crow(i, hh)) * XROW + g * 64 + 32 * eb + r] = o[eb][i];
        f32x4 v[8];
#pragma unroll
        for (int j = 0; j < 8; ++j) v[j] = *(const LAS f32x4*)(X + rrow * XROW + g * 64 + 32 * half + 4 * j);
        bf16_t* op = MC + tok * DM + 512 + hx * 128 + g * 64 + 32 * half;
#pragma unroll
        for (int j = 0; j < 4; ++j) { const f32x4 a0 = v[2 * j], a1 = v[2 * j + 1]; u32x4 w; w.x = pk2(a0.x, a0.y); w.y = pk2(a0.z, a0.w); w.z = pk2(a1.x, a1.y); w.w = pk2(a1.z, a1.w); *(u32x4*)(op + 8 * j) = w; }
    }
    __syncthreads();
}

DEV void attn_phase(LAS unsigned char* lds, kptr_t kp, const bf16_t* HP, bf16_t* MC, const float* KN2, unsigned* qctr, int tid) {
    float s1 = 0.f, s2 = 0.f;
    { const float* q1 = kin(kp, 2); const float* k1 = kin(kp, 3); const float* q2 = kin(kp, 4); const float* k2 = kin(kp, 5);
      for (int d = 0; d < 64; ++d) { s1 += q1[d] * k1[d]; s2 += q2[d] * k2[d]; } }
    const float lam = expf(s1) - expf(s2) + 0.2f;
    volatile LAS unsigned* slot = (volatile LAS unsigned*)(lds + LDS_FLAG + 64);
    if (ATT_TIMING && tid == 0 && blockIdx.x == 0) *(volatile LAS unsigned long long*)(lds + LDS_BYTES - 64 + 16) = __builtin_amdgcn_s_memtime();
    for (;;) {
        if (tid == 0) *slot = __hip_atomic_fetch_add(qctr, 1u, __ATOMIC_RELAXED, __HIP_MEMORY_SCOPE_AGENT);
        __syncthreads();
        int idx = (int)*slot;
#if ATT_PROBE
        if (idx >= 3072) break;
        if (idx >= 2048) idx = idx - 2048 + (ATT_PROBE == 2 ? 1024 : 0);
#else
        if (idx >= 2048) break;
#endif
        if (idx < 1024) { const int qb = 63 - (idx >> 4), hx = 3 - ((idx >> 2) & 3), b = idx & 3;
            attn_unit<0>(lds, HP, MC, b, hx, qb, lam, kin(kp, 6), nullptr, KN2, tid); }
        else { const int id = idx - 1024;
            attn_unit<1>(lds, HP, MC, id >> 8, (id >> 6) & 3, id & 63, 0.f, nullptr, kin(kp, 7), nullptr, tid); }
    }
    if (ATT_TIMING && tid == 0 && blockIdx.x == 0) { volatile LAS unsigned* tm = (volatile LAS unsigned*)(lds + LDS_BYTES - 64); tm[2] += (unsigned)(__builtin_amdgcn_s_memtime() - *(volatile LAS unsigned long long*)(lds + LDS_BYTES - 64 + 16)); }
    __syncthreads();
}
#undef ATT_SB
}

namespace mix1 {
using att::bf16x8; using att::s16x4; using att::f32x16; using att::crow; using att::vtr;
constexpr int VSTR = 1088;
constexpr float LOG2E = 1.4426950408889634f;
DEV float lg2gamma(int h) { return __builtin_log2f(1.f - __builtin_amdgcn_exp2f(-5.f - (float)h)); }
DEV bf16x8 trpair(const LAS unsigned char* p, int hi_off) { const s16x4 lo = vtr(p), hi = vtr(p + hi_off); return (bf16x8){lo[0], lo[1], lo[2], lo[3], hi[0], hi[1], hi[2], hi[3]}; }

template <int KSTR, bool KSCALE> DEV void stage_kv(LAS unsigned char* lds, const bf16_t* __restrict__ HP, size_t tok0, int tid) {
    constexpr int VOFFB = 64 * KSTR;
#pragma unroll
    for (int i = 0; i < 4; ++i) { const int ck = tid + NTHR * i, row = ck >> 5, cc = ck & 31;
        u32x4 v = *(const u32x4*)(HP + (tok0 + row) * IN_ODD + 256 + cc * 8);
        if (KSCALE) { const float f = 0.125f * __builtin_amdgcn_exp2f((float)(63 - row) * lg2gamma(cc >> 3));
            unsigned w[4] = {v.x, v.y, v.z, v.w};
#pragma unroll
            for (int j = 0; j < 4; ++j) w[j] = pk2(__uint_as_float(w[j] << 16) * f, __uint_as_float(w[j] & 0xffff0000u) * f);
            v = (u32x4){w[0], w[1], w[2], w[3]}; }
        *(LAS u32x4*)(lds + row * KSTR + cc * 16) = v; }
#pragma unroll
    for (int i = 0; i < 8; ++i) { const int ck = tid + NTHR * i, row = ck >> 6, cc = ck & 63;
        *(LAS u32x4*)(lds + VOFFB + row * VSTR + cc * 16) = *(const u32x4*)(HP + (tok0 + row) * IN_ODD + 512 + cc * 8); }
}

DEV void ret_kv_phase(LAS unsigned char* lds, const bf16_t* __restrict__ HP, float* __restrict__ KV, int vcu, int G, int tid) {
    constexpr int KSTR = 576;
    const int lane = tid & 63, wave = __builtin_amdgcn_readfirstlane(tid >> 6), h = wave >> 1, dblk = wave & 1, r = lane & 31, hh = lane >> 5, p15 = lane & 15, g4 = lane >> 4;
    const int rowl = 4 * hh + (p15 >> 2), coll = 16 * (g4 & 1) + 4 * (p15 & 3);
    for (int u = vcu; u < BATCH * 128; u += G) { const int b = u >> 7, c = u & 127; const size_t tok0 = (size_t)b * SEQ + 64 * c;
        stage_kv<KSTR, true>(lds, HP, tok0, tid);
        __syncthreads();
        f32x16 acc[4];
#pragma unroll
        for (int eb = 0; eb < 4; ++eb)
#pragma unroll
            for (int i = 0; i < 16; ++i) acc[eb][i] = 0.f;
#pragma unroll
        for (int ks = 0; ks < 4; ++ks) {
            const bf16x8 kf = trpair(lds + (16 * ks + rowl) * KSTR + (h * 64 + 32 * dblk + coll) * 2, 8 * KSTR);
#pragma unroll
            for (int eb = 0; eb < 4; ++eb) { const bf16x8 vf = trpair(lds + 64 * KSTR + (16 * ks + rowl) * VSTR + (h * 128 + 32 * eb + coll) * 2, 8 * VSTR);
                acc[eb] = __builtin_amdgcn_mfma_f32_32x32x16_bf16(vf, kf, acc[eb], 0, 0, 0); }
        }
        float* o = KV + ((size_t)((b * 4 + h) * 128 + c) * 128) * 64 + 32 * dblk + r;
#pragma unroll
        for (int eb = 0; eb < 4; ++eb)
            { float* oq = o + (32 * eb + 4 * hh) * 64;
#pragma unroll
              for (int i = 0; i < 16; ++i) { *oq = acc[eb][i]; oq += ((i & 3) == 3 ? 5 : 1) * 64; asm volatile("" : "+v"(oq)); } }
        __syncthreads();
    }
}
DEV void ret_scan_phase(const float* __restrict__ KV, bf16_t* __restrict__ PREV, int vcu, int G, int tid) {
    for (int idx = vcu * NTHR + tid; idx < 16 * 8192; idx += G * NTHR) { const int bh = idx >> 13, ed = idx & 8191;
        const float cd = __builtin_amdgcn_exp2f(64.f * lg2gamma(bh & 3)); float st = 0.f;
        const float* kv = KV + (size_t)bh * 128 * 8192 + ed; bf16_t* pv = PREV + (size_t)bh * 128 * 8192 + ed;
#pragma unroll 8
        for (int c = 0; c < 128; ++c) { const float x = kv[(size_t)c * 8192]; pv[(size_t)c * 8192] = f2bf(st); st = st * cd + x; }
    }
}
DEV void ret_out_phase(LAS unsigned char* lds, const bf16_t* __restrict__ HP, const bf16_t* __restrict__ PREV, const float* __restrict__ gng, const float* __restrict__ gnb, bf16_t* __restrict__ MC, int vcu, int G, int tid) {
    constexpr int KSTR = 528;
    const int lane = tid & 63, wave = __builtin_amdgcn_readfirstlane(tid >> 6), h = wave >> 1, lb = wave & 1, r = lane & 31, hh = lane >> 5, p15 = lane & 15, g4 = lane >> 4;
    const float lg = lg2gamma(h);
    const int vlane = 64 * KSTR + (4 * hh + (p15 >> 2)) * VSTR + (h * 128 + 16 * (g4 & 1) + 4 * (p15 & 3)) * 2;
    for (int u = vcu; u < BATCH * 128; u += G) { const int b = u >> 7, c = u & 127; const size_t tok0 = (size_t)b * SEQ + 64 * c;
        stage_kv<KSTR, false>(lds, HP, tok0, tid);
        bf16x8 qf[4];
        { const bf16_t* qp = HP + (tok0 + 32 * lb + r) * IN_ODD + h * 64 + hh * 8;
#pragma unroll
          for (int ds = 0; ds < 4; ++ds) qf[ds] = *(const bf16x8*)(qp + 16 * ds); }
        f32x16 acc[4];
        { const bf16_t* pp = PREV + ((size_t)((b * 4 + h) * 128 + c) * 128 + r) * 64 + hh * 8;
#pragma unroll
          for (int eb = 0; eb < 4; ++eb) {
#pragma unroll
              for (int i = 0; i < 16; ++i) acc[eb][i] = 0.f;
#pragma unroll
              for (int ds = 0; ds < 4; ++ds) { const bf16x8 pf = *(const bf16x8*)(pp + (size_t)(32 * eb) * 64 + 16 * ds); acc[eb] = __builtin_amdgcn_mfma_f32_32x32x16_bf16(qf[ds], pf, acc[eb], 0, 0, 0); } } }
#pragma unroll
        for (int i = 0; i < 16; ++i) { const float qd = __builtin_amdgcn_exp2f((float)(32 * lb + crow(i, hh) + 1) * lg);
#pragma unroll
            for (int eb = 0; eb < 4; ++eb) acc[eb][i] *= qd; }
        __syncthreads();
        for (int mb = 0; mb <= lb; ++mb) {
            f32x16 s;
#pragma unroll
            for (int i = 0; i < 16; ++i) s[i] = 0.f;
#pragma unroll
            for (int ds = 0; ds < 4; ++ds) { const bf16x8 kf = *(const LAS bf16x8*)(lds + (32 * mb + r) * KSTR + (h * 64 + 16 * ds + 8 * hh) * 2); s = __builtin_amdgcn_mfma_f32_32x32x16_bf16(kf, qf[ds], s, 0, 0, 0); }
            const int dbase = 32 * lb + r - 32 * mb - 4 * hh;
#pragma unroll
            for (int i = 0; i < 16; ++i) { const int df = dbase - ((i & 3) + 8 * (i >> 2)); const float w = 0.125f * __builtin_amdgcn_exp2f((float)df * lg); s[i] = df >= 0 ? s[i] * w : 0.f; }
#pragma unroll
            for (int sx = 0; sx < 2; ++sx) { u32x4 w; w.x = pk2(s[8 * sx + 0], s[8 * sx + 1]); w.y = pk2(s[8 * sx + 2], s[8 * sx + 3]); w.z = pk2(s[8 * sx + 4], s[8 * sx + 5]); w.w = pk2(s[8 * sx + 6], s[8 * sx + 7]);
                const bf16x8 pa = __builtin_bit_cast(bf16x8, w);
#pragma unroll
                for (int eb = 0; eb < 4; ++eb) { const bf16x8 vf = trpair(lds + vlane + (32 * mb + 16 * sx) * VSTR + eb * 64, 8 * VSTR); acc[eb] = __builtin_amdgcn_mfma_f32_32x32x16_bf16(pa, vf, acc[eb], 0, 0, 0); } }
        }
        float mu[16], rs[16];
#pragma unroll
        for (int i = 0; i < 16; ++i) { float s1 = (acc[0][i] + acc[1][i]) + (acc[2][i] + acc[3][i]);
#pragma unroll
            for (int o = 1; o < 32; o <<= 1) s1 += __shfl_xor(s1, o);
            const float m = s1 * (1.f / 128.f); float s2 = 0.f;
#pragma unroll
            for (int eb = 0; eb < 4; ++eb) { const float d = acc[eb][i] - m; s2 += d * d; }
#pragma unroll
            for (int o = 1; o < 32; o <<= 1) s2 += __shfl_xor(s2, o);
            mu[i] = m; rs[i] = rsqrtf(s2 * (1.f / 128.f) + LN_EPS); }
        const bf16_t* gp = HP + tok0 * IN_ODD + 1024; bf16_t* mp = MC + tok0 * DM;
#pragma unroll
        for (int eb = 0; eb < 4; ++eb) { const int col = h * 128 + 32 * eb + r; const float gg = gng[col], bb = gnb[col];
            const bf16_t* gq = gp + (32 * lb + 4 * hh) * IN_ODD + col; bf16_t* mq = mp + (32 * lb + 4 * hh) * DM + col;
#pragma unroll
            for (int i = 0; i < 16; ++i) { const float gt = bf2f(*gq);
                const float y = (acc[eb][i] - mu[i]) * rs[i] * gg + bb; *mq = f2bf(y * pg8::e_silu(gt));
                const int step = (i & 3) == 3 ? 5 : 1; gq += step * IN_ODD; mq += step * DM; asm volatile("" : "+v"(gq), "+v"(mq)); } }
        __syncthreads();
    }
}

DEV void sgu_phase(LAS unsigned char* lds, const bf16_t* __restrict__ HP, const bf16_t* __restrict__ WSB, const float* __restrict__ lng, const float* __restrict__ lnb, const float* __restrict__ bs, bf16_t* __restrict__ MC, int vcu, int G, int tid) {
    constexpr int TSTR = 320, TOFF = 1024;
    const int lane = tid & 63, wave = __builtin_amdgcn_readfirstlane(tid >> 6), r = lane & 31, hh = lane >> 5, p15 = lane & 15, g4 = lane >> 4;
    LAS float* stats = (LAS float*)lds;
    const int cb = wave & 3, whalf = wave >> 2;
    for (int u = vcu; u < MTOK / 128; u += G) { const size_t tok0 = (size_t)u * 128;
        const bf16_t* up = HP + tok0 * IN_ODD + 1536; bf16_t* mp = MC + tok0 * DM + 512;
        for (int i = 0; i < 16; ++i) { const int row = 16 * wave + i; const u32x4 v = *(const u32x4*)(HP + (tok0 + row) * IN_ODD + 2048 + lane * 8);
            float x[8] = {__uint_as_float(v.x << 16), __uint_as_float(v.x & 0xffff0000u), __uint_as_float(v.y << 16), __uint_as_float(v.y & 0xffff0000u), __uint_as_float(v.z << 16), __uint_as_float(v.z & 0xffff0000u), __uint_as_float(v.w << 16), __uint_as_float(v.w & 0xffff0000u)};
            float s1 = 0.f;
#pragma unroll
            for (int j = 0; j < 8; ++j) s1 += x[j];
            const float m = wave_sum(s1) * (1.f / 512.f); float s2 = 0.f;
#pragma unroll
            for (int j = 0; j < 8; ++j) { const float d = x[j] - m; s2 += d * d; }
            const float rstd = rsqrtf(wave_sum(s2) * (1.f / 512.f) + LN_EPS);
            if (lane == 0) { stats[2 * row] = m; stats[2 * row + 1] = rstd; } }
        __syncthreads();
        for (int g = 0; g < 4; ++g) {
#pragma unroll
            for (int i = 0; i < 4; ++i) { const int ck = tid + NTHR * i, row = ck >> 4, cc = ck & 15; const int ch = g * 128 + cc * 8;
                const u32x4 v = *(const u32x4*)(HP + (tok0 + row) * IN_ODD + 2048 + ch);
                const float m = stats[2 * row], rstd = stats[2 * row + 1];
                const f32x4 g0 = *(const f32x4*)(lng + ch), g1 = *(const f32x4*)(lng + ch + 4), b0 = *(const f32x4*)(lnb + ch), b1 = *(const f32x4*)(lnb + ch + 4);
                u32x4 w;
                w.x = pk2((__uint_as_float(v.x << 16) - m) * rstd * g0.x + b0.x, (__uint_as_float(v.x & 0xffff0000u) - m) * rstd * g0.y + b0.y);
                w.y = pk2((__uint_as_float(v.y << 16) - m) * rstd * g0.z + b0.z, (__uint_as_float(v.y & 0xffff0000u) - m) * rstd * g0.w + b0.w);
                w.z = pk2((__uint_as_float(v.z << 16) - m) * rstd * g1.x + b1.x, (__uint_as_float(v.z & 0xffff0000u) - m) * rstd * g1.y + b1.y);
                w.w = pk2((__uint_as_float(v.w << 16) - m) * rstd * g1.z + b1.z, (__uint_as_float(v.w & 0xffff0000u) - m) * rstd * g1.w + b1.w);
                *(LAS u32x4*)(lds + TOFF + row * TSTR + cc * 16) = w; }
            __syncthreads();
#pragma unroll
            for (int j = 0; j < 2; ++j) { const int tb = whalf == 0 ? (j == 0 ? 0 : 3) : (j == 0 ? 1 : 2);
                f32x16 acc;
#pragma unroll
                for (int i = 0; i < 16; ++i) acc[i] = 0.f;
                const bf16_t* wp = WSB + ((size_t)g * 128 + 32 * tb + r) * 128 + hh * 8;
                for (int ks = 0; ks < 2 * (tb + 1); ++ks) {
                    const bf16x8 wf = *(const bf16x8*)(wp + 16 * ks);
                    const bf16x8 vf = trpair(lds + TOFF + (16 * ks + 8 * hh + (p15 >> 2)) * TSTR + (32 * cb + 16 * (g4 & 1) + 4 * (p15 & 3)) * 2, 4 * TSTR);
                    acc = __builtin_amdgcn_mfma_f32_32x32x16_bf16(wf, vf, acc, 0, 0, 0);
                }
                const int col = g * 128 + 32 * cb + r;
                const bf16_t* uq = up + (32 * tb + 4 * hh) * IN_ODD + col; bf16_t* mq = mp + (32 * tb + 4 * hh) * DM + col; const float* bq = bs + g * 128 + 32 * tb + 4 * hh;
#pragma unroll
                for (int i = 0; i < 16; ++i) { const float uu = bf2f(*uq); *mq = f2bf(uu * (acc[i] + *bq));
                    const int step = (i & 3) == 3 ? 5 : 1; uq += step * IN_ODD; mq += step * DM; bq += step; asm volatile("" : "+v"(uq), "+v"(mq), "+v"(bq)); }
            }
            __syncthreads();
        }
    }
}
}

#define XB_TMO      128
#define XB_XCNT(j)  (256  + 64 * (j))
#define XB_XSUB(j)  (1280 + 64 * (j))
#define XB_XGEN(j)  (2304 + 64 * (j))
#define XB_TOP      3328
#define XB_TOPGEN   3392
#define XCD_BAR_WORDS 3456
#define XB_SPIN_CAP (1u << 18)

__device__ __forceinline__ unsigned xb_ld(unsigned* p)              { return __hip_atomic_load(p, __ATOMIC_RELAXED, __HIP_MEMORY_SCOPE_AGENT); }
__device__ __forceinline__ unsigned xb_add(unsigned* p, unsigned v) { return __hip_atomic_fetch_add(p, v, __ATOMIC_RELAXED, __HIP_MEMORY_SCOPE_AGENT); }
__device__ __forceinline__ unsigned xb_xcc_id() { return (unsigned)__builtin_amdgcn_s_getreg((3 << 11) | 20) & 0xFu; }
#define XB_SPIN(cond, bar) do { unsigned _sp = 0; while (cond) { __builtin_amdgcn_s_sleep(1); \
    if ((++_sp & 255u) == 0u) { if (xb_ld(&(bar)[XB_TMO])) break; if (_sp > XB_SPIN_CAP) { atomicAdd(&(bar)[XB_TMO], 1u); break; } } } } while (0)

struct XcdBarrier {
    unsigned* bar; unsigned x;
    volatile LAS unsigned* st;
};

__device__ __forceinline__ XcdBarrier xcd_barrier_post(unsigned* bar, volatile LAS unsigned* st) {
    XcdBarrier b; b.bar = bar; b.x = xb_xcc_id(); b.st = st;
    if (threadIdx.x == 0) (void)xb_add(&bar[XB_XCNT(b.x)], 1u);
    return b;
}
__device__ __forceinline__ void xcd_barrier_complete(unsigned* bar, unsigned x, unsigned& nloc, unsigned& nx) {
    const unsigned G = gridDim.x * gridDim.y * gridDim.z;
    unsigned sum, cnt, mine, sp = 0u;
    for (;;) {
        sum = 0u; cnt = 0u; mine = 0u;
#pragma unroll
        for (unsigned j = 0; j < 16; ++j) { const unsigned c = xb_ld(&bar[XB_XCNT(j)]); sum += c; cnt += (c > 0u) ? 1u : 0u; mine = (j == x) ? c : mine; }
        if (sum == G) break;
        __builtin_amdgcn_s_sleep(1);
        if ((++sp & 255u) == 0u) { if (xb_ld(&bar[XB_TMO])) break; if (sp > XB_SPIN_CAP) { atomicAdd(&bar[XB_TMO], 1u); break; } }
    }
    nloc = mine > 0u ? mine : 1u; nx = cnt > 0u ? cnt : 1u;
}

__device__ __forceinline__ void xcd_barrier(const XcdBarrier& b) {
    asm volatile("s_waitcnt vmcnt(0)" ::: "memory");
    __syncthreads();
    if (threadIdx.x == 0) {
        unsigned* bar = b.bar;
        __builtin_amdgcn_s_waitcnt(0);
        unsigned nloc = b.st[0], nx = b.st[1];
        if (nloc == 0u) { xcd_barrier_complete(bar, b.x, nloc, nx); b.st[0] = nloc; b.st[1] = nx; }
        const unsigned old = xb_add(&bar[XB_XSUB(b.x)], 1u);
        const unsigned gen = old / nloc;
        if (old + 1u == (gen + 1u) * nloc) {
            __builtin_amdgcn_fence(__ATOMIC_RELEASE, "agent");
            asm volatile("s_waitcnt vmcnt(0)" ::: "memory");
            const unsigned og = xb_add(&bar[XB_TOP], 1u);
            const unsigned tg = og / nx;
            if (og + 1u == (tg + 1u) * nx) xb_add(&bar[XB_TOPGEN], 1u);
            else XB_SPIN(xb_ld(&bar[XB_TOPGEN]) == tg, bar);
            __builtin_amdgcn_fence(__ATOMIC_ACQUIRE, "agent");
            xb_add(&bar[XB_XGEN(b.x)], 1u);
            asm volatile("s_waitcnt vmcnt(0)" ::: "memory");
        } else {
            XB_SPIN(xb_ld(&bar[XB_XGEN(b.x)]) == gen, bar);
            __builtin_amdgcn_fence(__ATOMIC_ACQUIRE, "agent");
            asm volatile("s_waitcnt vmcnt(0)" ::: "memory");
        }
    }
    __syncthreads();
}

__global__ void __launch_bounds__(NTHR, 2) mk_fwd(Args a) {
    extern __shared__ __attribute__((aligned(16))) unsigned char lds_raw[];
    LAS unsigned char* lds = (LAS unsigned char*)lds_raw;
    volatile LAS unsigned* MISC = (volatile LAS unsigned*)(lds + LDS_BYTES - 64);
    if (threadIdx.x < 16) MISC[threadIdx.x] = 0u;
    __syncthreads();
    XcdBarrier bar; bar.bar = nullptr; bar.x = 0; bar.st = nullptr;
    bar = xcd_barrier_post((unsigned*)(a.ws + WS_CTL) + 1024, MISC + 8);
    for (int ph = a.ph_lo; ph < a.ph_hi; ++ph)
    for (int rep = 0; rep < 1 + (int)((PROBE_DUP >> ph) & 1u); ++rep) {
        int tid = threadIdx.x; asm volatile("" : "+v"(tid));
        kptr_t kp = (kptr_t)__builtin_amdgcn_kernarg_segment_ptr(); asm volatile("" : "+s"(kp));
        unsigned char* ws = kws(kp);
        const int lane = tid & 63, wave = __builtin_amdgcn_readfirstlane(tid >> 6);
        const int G = gridDim.x, bx = blockIdx.x;
        const int vcu = (G % 8 == 0) ? (bx % 8) * (G / 8) + bx / 8 : bx;
        const int gw = vcu * NWAVES + wave, NGW = G * NWAVES;
        bf16_t* XB = (bf16_t*)(ws + WS_XB); bf16_t* HP = (bf16_t*)(ws + WS_HP); bf16_t* MC = (bf16_t*)(ws + WS_MC); float* Y = (float*)(ws + WS_Y); float* XF = kout(kp);
        const int L = ph >= 8 ? 1 : 0;
        switch (ph) {
        case 0: p0_prologue(kp, lds, gw, NGW, wave, lane); break;
        case 1: case 8: {
            const int N = L ? IN_ODD : IN_EVEN;
            pg8::Gemm g{XB, (const bf16_t*)(ws + (L ? WS_WINO : WS_WINE)), MTOK, N, DM}; pg8::StaticOrder S; S.init(MTOK, N, G, bx);
            pg8::EpiBf16G E{HP, N, L ? 6 : (1 << 30)};
            pg8::gemm_phase<pg8::EpiBf16G, pg8::StaticOrder, true, true>(lds, g, S, E, tid);
        } break;
        case 3: case 12: case 6: case 15: {
            const bool dn = (ph == 6 || ph == 15);
            const bf16_t* A = dn ? HP : MC; const int K = dn ? DFF : DM;
            const bf16_t* Bt = (const bf16_t*)(ws + (dn ? (L ? WS_WDN1 : WS_WDN0) : (L ? WS_WOUTO : WS_WOUTE)));
            const float* R = (ph == 3) ? kin(kp, 0) : XF;
            pg8::Gemm g{A, Bt, MTOK, DM, K}; pg8::StaticOrder S; S.init(MTOK, DM, G, bx);
            pg8::EpiResid E{R, Y, DM, ALPHA};
            pg8::gemm_phase<pg8::EpiResid, pg8::StaticOrder, true, true>(lds, g, S, E, tid);
        } break;
        case 4: case 7: case 13: case 16: {
            const bool ffn = (ph == 7 || ph == 16);
            ln_phase(Y, kin(kp, ffn ? 22 : 17) + L * DM, kin(kp, ffn ? 23 : 18) + L * DM, XF, XB, gw, NGW, lane);
        } break;
        case 5: case 14: {
            pg8::Gemm g{XB, (const bf16_t*)(ws + (L ? WS_WGU1 : WS_WGU0)), MTOK, 2 * DFF, DM}; pg8::StaticOrder S; S.init(MTOK, 2 * DFF, G, bx);
            pg8::EpiSwiglu E{HP, DFF};
            pg8::gemm_phase<pg8::EpiSwiglu, pg8::StaticOrder, true, true>(lds, g, S, E, tid);
        } break;
        case 2: { float* KN2 = (float*)(ws + WS_KN2);
                  att::knorm_phase(HP, KN2, gw, NGW, lane); xcd_barrier(bar);
                  att::attn_phase(lds, kp, HP, MC, KN2, (unsigned*)(ws + WS_CTL) + 64 + 64 * rep, tid); } break;
        case 9: mix1::ret_kv_phase(lds, HP, (float*)(ws + WS_Y), vcu, G, tid);
                mix1::sgu_phase(lds, HP, (const bf16_t*)(ws + WS_SGUW), kin(kp, 12), kin(kp, 13), kin(kp, 15), MC, vcu, G, tid); break;
        case 10: mix1::ret_scan_phase((const float*)(ws + WS_Y), (bf16_t*)(ws + WS_Y + 64 * MiB), vcu, G, tid); break;
        case 11: mix1::ret_out_phase(lds, HP, (const bf16_t*)(ws + WS_Y + 64 * MiB), kin(kp, 10), kin(kp, 11), MC, vcu, G, tid); break;
        default: break;
        }
        if (ph + 1 < a.ph_hi || rep < (int)((PROBE_DUP >> ph) & 1u)) xcd_barrier(bar);
    }
    if (ATT_TIMING && threadIdx.x == 0 && blockIdx.x == 0) { const unsigned n = MISC[ATT_TIMING - 1]; const unsigned long long t0 = __builtin_amdgcn_s_memtime(); while (__builtin_amdgcn_s_memtime() - t0 < (unsigned long long)n) __builtin_amdgcn_s_sleep(4); }
}
extern "C" void kernel_launch(void* const* d_in, const int* in_sizes, int n_in, void* d_out, int out_size, void* d_ws, size_t ws_size, hipStream_t stream) {
    static int grid = 0;
    if (grid == 0) {
        if (n_in != 24 || ws_size < WS_END || out_size != MTOK * DM) { fprintf(stderr, "kernel_launch: unexpected shapes (n_in %d ws %zu out %d)\n", n_in, ws_size, out_size); grid = -1; return; }
        int dev = 0, cus = 0, per_cu = 0;
        hipGetDevice(&dev); hipDeviceGetAttribute(&cus, hipDeviceAttributeMultiprocessorCount, dev);
        if (hipFuncSetAttribute((const void*)mk_fwd, hipFuncAttributeMaxDynamicSharedMemorySize, LDS_BYTES) != hipSuccess) { fprintf(stderr, "hipFuncSetAttribute failed\n"); grid = -1; return; }
        hipOccupancyMaxActiveBlocksPerMultiprocessor(&per_cu, (const void*)mk_fwd, NTHR, LDS_BYTES);
        if (per_cu < 1) { fprintf(stderr, "occupancy query says %d blocks/CU\n", per_cu); }
        (void)hipGetLastError();
        grid = cus;
    }
    if (grid < 0) return;
    const float* const* in = (const float* const*)d_in;
    unsigned char* ws = (unsigned char*)d_ws;
    bf16_t* HP = (bf16_t*)(ws + WS_HP); bf16_t* MC = (bf16_t*)(ws + WS_MC); float* Y = (float*)(ws + WS_Y);
    Args a{};
    for (int i = 0; i < 24; ++i) a.in[i] = in[i];
    a.out = (float*)d_out; a.ws = ws;
    auto run = [&](int lo, int hi) { a.ph_lo = lo; a.ph_hi = hi; hipLaunchKernelGGL(mk_fwd, dim3(grid), dim3(NTHR), LDS_BYTES, stream, a); };
    hipMemsetAsync(ws + WS_CTL, 0, 65536, stream);
    run(0, NPHASE);
}
```
